# Optimizing an MI355X kernel written in HIP

```python
import math
import jax, jax.numpy as jnp
from jax import lax
import numpy as np

D_MODEL = 1024
BATCH = 8
SEQ = 2048
DEPTH = 4

MEM_LEN = 256
EPS = 1e-6
SSM_HEADS = 16
SSM_HEAD_DIM = 64
D_SSM = SSM_HEADS * SSM_HEAD_DIM
SSM_GROUPS = 4
SSM_STATE = 128
SSM_CONV = 4
SSM_CHUNK = 128
CONV_CH = D_SSM + 2 * SSM_GROUPS * SSM_STATE
MLA_HEADS = 16
QK_NOPE = 64
QK_ROPE = 32
V_DIM = 64
Q_LORA = 384
KV_LORA = 256
D_ATTN = MLA_HEADS * V_DIM
ROPE_THETA = 10000.0
Q_BLOCK = 128
D_MIX = D_SSM + D_ATTN
_O1 = D_SSM
_O2 = _O1 + CONV_CH
_O3 = _O2 + SSM_HEADS
_O4 = _O3 + Q_LORA
_O5 = _O4 + KV_LORA
D_IN = _O5 + QK_ROPE
IN_SPLITS = (_O1, _O2, _O3, _O4, _O5)
MEM_HEADS = 4
MEM_HEAD_DIM = D_MODEL // MEM_HEADS
D_FF = 2816
FFN_CONV = 3

kernel_name = "hymba_ssd_mla_memxattn_convffn"


def rmsnorm(x, g):
    xf = x.astype(jnp.float32)
    var = jnp.mean(xf * xf, axis=-1, keepdims=True)
    return (xf * lax.rsqrt(var + EPS) * g.astype(jnp.float32)).astype(x.dtype)


def causal_dwconv(x, w, b):
    k = w.shape[0]
    s = x.shape[1]
    xp = jnp.pad(x, ((0, 0), (k - 1, 0), (0, 0)))
    y = xp[:, 0:s] * w[0]
    for j in range(1, k):
        y = y + xp[:, j:j + s] * w[j]
    return y + b


def rope_tables(positions):
    inv_freq = 1.0 / (ROPE_THETA ** (jnp.arange(0, QK_ROPE, 2, dtype=jnp.float32) / QK_ROPE))
    ang = positions.astype(jnp.float32)[..., None] * inv_freq
    return jnp.cos(ang), jnp.sin(ang)


def apply_rope(t, cos, sin):
    half = t.shape[-1] // 2
    t1, t2 = t[..., :half], t[..., half:]
    out = jnp.concatenate([t1 * cos - t2 * sin, t2 * cos + t1 * sin], axis=-1)
    return out.astype(t.dtype)


def segsum_exp(a):
    t = a.shape[-1]
    cs = jnp.cumsum(a, axis=-1)
    diff = cs[..., :, None] - cs[..., None, :]
    mask = jnp.tril(jnp.ones((t, t), dtype=bool))
    return jnp.exp(jnp.where(mask, diff, -jnp.inf))


def ssd_scan(x, dt, a, bm, cm):
    out_dtype = x.dtype
    x = x.astype(jnp.float32)
    bm = bm.astype(jnp.float32)
    cm = cm.astype(jnp.float32)
    b, l, h, p = x.shape
    g, n = bm.shape[-2:]
    r = h // g
    c = l // SSM_CHUNK
    xd = (x * dt[..., None]).reshape(b, c, SSM_CHUNK, g, r, p)
    ad = jnp.moveaxis((dt * a).reshape(b, c, SSM_CHUNK, g, r), 2, -1)
    a_cs = jnp.cumsum(ad, axis=-1)
    bc = bm.reshape(b, c, SSM_CHUNK, g, n)
    cc = cm.reshape(b, c, SSM_CHUNK, g, n)
    lmat = segsum_exp(ad)
    cb = jnp.einsum('bclgn,bcsgn->bcgls', cc, bc)
    y_diag = jnp.einsum('bcgls,bcgrls,bcsgrp->bclgrp', cb, lmat, xd)
    decay_states = jnp.exp(a_cs[..., -1:] - a_cs)
    states = jnp.einsum('bclgn,bcgrl,bclgrp->bcgrpn', bc, decay_states, xd)
    chunk_decay = jnp.exp(a_cs[..., -1])

    def step(prev, inp):
        st, dec = inp
        return prev * dec[..., None, None] + st, prev

    init = jnp.zeros((b, g, r, p, n), jnp.float32)
    _, prev_states = lax.scan(step, init, (jnp.moveaxis(states, 1, 0), jnp.moveaxis(chunk_decay, 1, 0)))
    prev_states = jnp.moveaxis(prev_states, 0, 1)
    y_off = jnp.einsum('bclgn,bcgrpn,bcgrl->bclgrp', cc, prev_states, jnp.exp(a_cs))
    return (y_diag + y_off).reshape(b, l, h, p).astype(out_dtype)


def mla_attention(c_q, c_kv, k_rope, q_norm, w_uq, kv_norm, w_ukv, cos, sin):
    b, s, _ = c_q.shape
    q = (rmsnorm(c_q, q_norm) @ w_uq).reshape(b, s, MLA_HEADS, QK_NOPE + QK_ROPE)
    q_nope = q[..., :QK_NOPE]
    q_pe = apply_rope(q[..., QK_NOPE:], cos[:, :, None, :], sin[:, :, None, :])
    kv = (rmsnorm(c_kv, kv_norm) @ w_ukv).reshape(b, s, MLA_HEADS, QK_NOPE + V_DIM)
    k_nope, v = kv[..., :QK_NOPE], kv[..., QK_NOPE:]
    k_pe = apply_rope(k_rope, cos, sin)
    scale = (QK_NOPE + QK_ROPE) ** -0.5
    outs = []
    for i in range(s // Q_BLOCK):
        q0 = i * Q_BLOCK
        kend = q0 + Q_BLOCK
        sc = (jnp.einsum('bqhd,bkhd->bhqk', q_nope[:, q0:kend], k_nope[:, :kend])
              + jnp.einsum('bqhr,bkr->bhqk', q_pe[:, q0:kend], k_pe[:, :kend]))
        sc = sc.astype(jnp.float32) * scale
        mask = (q0 + jnp.arange(Q_BLOCK))[:, None] >= jnp.arange(kend)[None, :]
        pr = jax.nn.softmax(jnp.where(mask, sc, -jnp.inf), axis=-1).astype(v.dtype)
        outs.append(jnp.einsum('bhqk,bkhd->bqhd', pr, v[:, :kend]))
    return jnp.concatenate(outs, axis=1).reshape(b, s, D_ATTN)


def memory_attention(h, m, w_q, w_k, w_v, w_o):
    b, s, _ = h.shape
    ml = m.shape[1]
    q = (h @ w_q).reshape(b, s, MEM_HEADS, MEM_HEAD_DIM)
    k = (m @ w_k).reshape(b, ml, MEM_HEADS, MEM_HEAD_DIM)
    v = (m @ w_v).reshape(b, ml, MEM_HEADS, MEM_HEAD_DIM)
    sc = jnp.einsum('bqhd,bkhd->bhqk', q, k).astype(jnp.float32) * (MEM_HEAD_DIM ** -0.5)
    pr = jax.nn.softmax(sc, axis=-1).astype(v.dtype)
    o = jnp.einsum('bhqk,bkhd->bqhd', pr, v).reshape(b, s, D_MODEL)
    return o @ w_o


def conv_glu_ffn(h, w_up, conv_w, conv_b, w_down):
    u = causal_dwconv(h @ w_up, conv_w, conv_b)
    gate, val = u[..., :D_FF], u[..., D_FF:]
    return (jax.nn.silu(gate) * val) @ w_down


def setup_inputs(seed: int = 0) -> dict:
    key = jax.random.key(seed)
    ks = iter(jax.random.split(key, 64))

    def nrm(shape, scale):
        return jax.random.normal(next(ks), shape, jnp.float32) * scale

    def gain(shape):
        return 1.0 + nrm(shape, 0.02)

    L = DEPTH
    dt0 = jnp.exp(jax.random.uniform(next(ks), (L, SSM_HEADS), jnp.float32,
                                     math.log(1e-3), math.log(1e-1)))
    dt_bias = dt0 + jnp.log(-jnp.expm1(-dt0))
    a_log = jnp.log(jax.random.uniform(next(ks), (L, SSM_HEADS), jnp.float32, 1.0, 16.0))
    offsets = jax.random.randint(next(ks), (BATCH, 1), 0, 1024, dtype=jnp.int32)
    positions = offsets + jnp.arange(SEQ, dtype=jnp.int32)[None, :]
    return {
        "x": nrm((BATCH, SEQ, D_MODEL), 1.0),
        "mem": nrm((BATCH, MEM_LEN, D_MODEL), 1.0),
        "positions": positions,
        "norm_mix": gain((L, D_MODEL)),
        "w_in": nrm((L, D_MODEL, D_IN), D_MODEL ** -0.5),
        "ssm_conv_w": nrm((L, SSM_CONV, CONV_CH), SSM_CONV ** -0.5),
        "ssm_conv_b": nrm((L, CONV_CH), 0.02),
        "dt_bias": dt_bias,
        "a_log": a_log,
        "d_skip": 1.0 + nrm((L, SSM_HEADS), 0.1),
        "ssm_norm": gain((L, D_SSM)),
        "q_norm": gain((L, Q_LORA)),
        "w_uq": nrm((L, Q_LORA, MLA_HEADS * (QK_NOPE + QK_ROPE)), Q_LORA ** -0.5),
        "kv_norm": gain((L, KV_LORA)),
        "w_ukv": nrm((L, KV_LORA, MLA_HEADS * (QK_NOPE + V_DIM)), KV_LORA ** -0.5),
        "attn_out_norm": gain((L, D_ATTN)),
        "w_out": nrm((L, D_MIX, D_MODEL), D_MIX ** -0.5),
        "norm_mem_q": gain((L, D_MODEL)),
        "norm_mem_kv": gain((L, D_MODEL)),
        "w_mq": nrm((L, D_MODEL, D_MODEL), D_MODEL ** -0.5),
        "w_mk": nrm((L, D_MODEL, D_MODEL), D_MODEL ** -0.5),
        "w_mv": nrm((L, D_MODEL, D_MODEL), D_MODEL ** -0.5),
        "w_mo": nrm((L, D_MODEL, D_MODEL), D_MODEL ** -0.5),
        "norm_ffn": gain((L, D_MODEL)),
        "w_up": nrm((L, D_MODEL, 2 * D_FF), D_MODEL ** -0.5),
        "ffn_conv_w": nrm((L, FFN_CONV, 2 * D_FF), FFN_CONV ** -0.5),
        "ffn_conv_b": nrm((L, 2 * D_FF), 0.02),
        "w_down": nrm((L, D_FF, D_MODEL), D_FF ** -0.5),
        "final_norm": gain((D_MODEL,)),
    }


def reference(x, mem, positions, norm_mix, w_in, ssm_conv_w, ssm_conv_b, dt_bias, a_log,
              d_skip, ssm_norm, q_norm, w_uq, kv_norm, w_ukv, attn_out_norm, w_out,
              norm_mem_q, norm_mem_kv, w_mq, w_mk, w_mv, w_mo, norm_ffn, w_up,
              ffn_conv_w, ffn_conv_b, w_down, final_norm):
    b, s, _ = x.shape
    cos, sin = rope_tables(positions)
    for i in range(DEPTH):
        h = rmsnorm(x, norm_mix[i])
        proj = h @ w_in[i]
        z, xbc, dt_raw, c_q, c_kv, k_rope = jnp.split(proj, IN_SPLITS, axis=-1)
        xbc = jax.nn.silu(causal_dwconv(xbc, ssm_conv_w[i], ssm_conv_b[i]))
        xs = xbc[..., :D_SSM].reshape(b, s, SSM_HEADS, SSM_HEAD_DIM)
        bm = xbc[..., D_SSM:D_SSM + SSM_GROUPS * SSM_STATE].reshape(b, s, SSM_GROUPS, SSM_STATE)
        cm = xbc[..., D_SSM + SSM_GROUPS * SSM_STATE:].reshape(b, s, SSM_GROUPS, SSM_STATE)
        dt = jax.nn.softplus(dt_raw.astype(jnp.float32) + dt_bias[i].astype(jnp.float32))
        a = -jnp.exp(a_log[i].astype(jnp.float32))
        y = ssd_scan(xs, dt, a, bm, cm) + xs * d_skip[i][:, None]
        y_ssm = rmsnorm(y.reshape(b, s, D_SSM) * jax.nn.silu(z), ssm_norm[i])
        y_att = mla_attention(c_q, c_kv, k_rope, q_norm[i], w_uq[i], kv_norm[i], w_ukv[i], cos, sin)
        y_att = rmsnorm(y_att, attn_out_norm[i])
        x = x + jnp.concatenate([y_ssm, y_att], axis=-1) @ w_out[i]
        x = x + memory_attention(rmsnorm(x, norm_mem_q[i]), rmsnorm(mem, norm_mem_kv[i]),
                                 w_mq[i], w_mk[i], w_mv[i], w_mo[i])
        x = x + conv_glu_ffn(rmsnorm(x, norm_ffn[i]), w_up[i], ffn_conv_w[i], ffn_conv_b[i], w_down[i])
    return rmsnorm(x, final_norm)
```

```cpp
#include <hip/hip_runtime.h>
#include <cstdio>
#include <cstdint>
namespace pg8 {
#define PG8_LAS __attribute__((address_space(3)))
typedef unsigned short bf16_t;
typedef short bf16x8 __attribute__((ext_vector_type(8)));
typedef float f32x4 __attribute__((ext_vector_type(4)));
typedef unsigned u32x4 __attribute__((ext_vector_type(4)));
constexpr int BM = 256, BK = 64, HALF = 128, HTB = HALF * BK * 2  , STAGE_BYTES = 8 * HTB, NXCD = 8, WGM = 8;

__host__ __device__ __forceinline__ int lds_byte(int r, int c) { const int st = (r >> 4) * 2 + (c >> 5), rr = r & 15, cc = c & 31, ob = rr * 64 + cc * 2; return st * 1024 + (ob ^ (((ob >> 9) & 1) << 5)); }
__host__ __device__ __forceinline__ void stage_rc(int b, int& R, int& C) { const int st = b / 1024, sb = b % 1024, swz = sb ^ (((sb >> 9) & 1) << 5); R = (st >> 1) * 16 + swz / 64; C = (st & 1) * 32 + (swz % 64) / 2; }
__host__ __device__ __forceinline__ int perm32(int rho) { const int n = rho >> 4, i = rho & 15; return 8 * (i >> 2) + 4 * n + (i & 3); }

struct Unit { int pm, pn; };
struct Gemm { const bf16_t* A; const bf16_t* Bt; int M, N, K; };

struct StaticOrder {
    int nM, nN, nwg, G, c;
    __host__ __device__ void init(int M, int N, int G_, int c_) { nM = M / BM; nN = N / BM; nwg = nM * nN; G = G_; c = c_; }
    __host__ __device__ bool next(int i, Unit& u) const {
        const long L = (long)i * G + c; if (L >= nwg) return false;
        int wgid = (int)L; { const int q = nwg / NXCD, r = nwg % NXCD, xcd = wgid % NXCD, off = wgid / NXCD; wgid = (xcd < r ? xcd * (q + 1) : r * (q + 1) + (xcd - r) * q) + off; }
        const int nig = WGM * nN, gid = wgid / nig, fm = gid * WGM, gsz = (nM - fm) < WGM ? (nM - fm) : WGM;
        u.pm = fm + ((wgid % nig) % gsz); u.pn = (wgid % nig) / gsz; return true;
    }
    __device__ __forceinline__ void a_ready(const Unit&) const {}
    __device__ __forceinline__ void done(const Unit&) const {}
};

__device__ __forceinline__ unsigned cvt_pk_bf16(float lo, float hi) { unsigned r; asm volatile("v_cvt_pk_bf16_f32 %0, %1, %2" : "=v"(r) : "v"(lo), "v"(hi)); return r; }
typedef float f32x2 __attribute__((ext_vector_type(2)));
__device__ __forceinline__ f32x2 gelu_pk(f32x2 v) {
    const f32x2 av = __builtin_elementwise_abs(v), d = av * 0.2316418882f + 1.0f;
    f32x2 t; t.x = __builtin_amdgcn_rcpf(d.x); t.y = __builtin_amdgcn_rcpf(d.y);
    f32x2 q = t * 0.5307027145f + (-0.7265760135f); q = q * t + 0.7107068705f; q = q * t + (-0.142248368f); q = q * t + 0.127414796f; q = q * t;
    const f32x2 s = (v * v) * (-0.72134752044f);
    f32x2 e; e.x = __builtin_amdgcn_exp2f(s.x); e.y = __builtin_amdgcn_exp2f(s.y);
    const f32x2 m = v * (q * e), r = v - m;
    f32x2 o; o.x = v.x < 0.f ? m.x : r.x; o.y = v.y < 0.f ? m.y : r.y; return o;
}

template <int ACT  > struct EpiBf16 {
    static constexpr bool PERM = true, AFTER_DRAIN = false; static_assert(ACT == 0 || ACT == 1, "EpiBf16: ACT is 0 (none) or 1 (gelu_pk)");
    bf16_t* O; int ldc; const float* bias; int split_cols; size_t split_stride; float scale0;
    __device__ __forceinline__ void operator()(const f32x4 (&acc)[2][2][4][2], const Unit& u, int wr, int wc, int fr, int fq) const {
        const int row0 = u.pm * BM + wr * 64 + fr; int colt = u.pn * BM; bf16_t* base = O;
        float sc = 1.f; if (split_cols) { const int t = colt / split_cols; base += (size_t)t * split_stride; colt -= t * split_cols; if (t == 0) sc = scale0; }
        const int col0 = colt + wc * 32 + 8 * fq, bcol0 = u.pn * BM + wc * 32 + 8 * fq;
        f32x4 bv[2][2];
#pragma unroll
        for (int bj = 0; bj < 2; ++bj)
#pragma unroll
            for (int n = 0; n < 2; ++n) bv[bj][n] = bias ? *(const f32x4*)(bias + bcol0 + bj * HALF + 4 * n) : (f32x4){0.f, 0.f, 0.f, 0.f};
#pragma unroll
        for (int ai = 0; ai < 2; ++ai)
#pragma unroll
            for (int m = 0; m < 4; ++m) { bf16_t* rowp = base + (size_t)(row0 + ai * HALF + m * 16) * ldc + col0;
#pragma unroll
                for (int bj = 0; bj < 2; ++bj) { f32x4 v0 = acc[ai][bj][m][0] + bv[bj][0], v1 = acc[ai][bj][m][1] + bv[bj][1];
                    if (ACT == 1) { f32x2 a = gelu_pk((f32x2){v0[0], v0[1]}), b = gelu_pk((f32x2){v0[2], v0[3]}), c = gelu_pk((f32x2){v1[0], v1[1]}), d = gelu_pk((f32x2){v1[2], v1[3]});
                        v0 = (f32x4){a.x, a.y, b.x, b.y}; v1 = (f32x4){c.x, c.y, d.x, d.y}; }
                    v0 = v0 * sc; v1 = v1 * sc; u32x4 w; w.x = cvt_pk_bf16(v0[0], v0[1]); w.y = cvt_pk_bf16(v0[2], v0[3]); w.z = cvt_pk_bf16(v1[0], v1[1]); w.w = cvt_pk_bf16(v1[2], v1[3]);
                    *(u32x4*)(rowp + bj * HALF) = w; } }
    }
};

struct PanelStats {
    unsigned* xbuf;
    unsigned* cnt;
    unsigned* tmo;
    int ntn; float eps;
    unsigned code;
    __device__ __forceinline__ bool run(const f32x4 (&v)[2][2][4][2], const Unit& u, int wr, int wc, int fr, int fq, PG8_LAS unsigned char* lds, int wid, int lane) const {
        typedef float f32x2v __attribute__((ext_vector_type(2)));
        PG8_LAS f32x2v* P = (PG8_LAS f32x2v*)lds;
        PG8_LAS f32x2v* S = (PG8_LAS f32x2v*)(lds + 8192);
        PG8_LAS unsigned* flag = (PG8_LAS unsigned*)(lds + 8192 + 2048);
#pragma unroll
        for (int ai = 0; ai < 2; ++ai)
#pragma unroll
            for (int m = 0; m < 4; ++m) {
                float s = 0.f;
#pragma unroll
                for (int bj = 0; bj < 2; ++bj)
#pragma unroll
                    for (int n = 0; n < 2; ++n) { const f32x4 x = v[ai][bj][m][n]; s += (x[0] + x[1]) + (x[2] + x[3]); }
                s += __shfl_xor(s, 16); s += __shfl_xor(s, 32);
                const float mw = s * (1.0f / 64.0f); float q = 0.f;
#pragma unroll
                for (int bj = 0; bj < 2; ++bj)
#pragma unroll
                    for (int n = 0; n < 2; ++n) { const f32x4 d = v[ai][bj][m][n] - mw; q += (d[0] * d[0] + d[1] * d[1]) + (d[2] * d[2] + d[3] * d[3]); }
                q += __shfl_xor(q, 16); q += __shfl_xor(q, 32);
                if (fq == 0) P[(ai * HALF + wr * 64 + m * 16 + fr) * 4 + wc] = (f32x2v){mw, q};
            }
        asm volatile("s_waitcnt lgkmcnt(0)" ::: "memory"); __builtin_amdgcn_s_barrier(); asm volatile("" ::: "memory");
#if defined(BROKEN_EXCHANGE_NO_WAIT)
#warning BROKEN CONTROL BUILD: the row-statistics exchange does not wait; results are wrong by design
        if (blockIdx.x >= 64) { const long long t0_ = clock64(); while (clock64() - t0_ < 60000) __builtin_amdgcn_s_sleep(8); }
#endif
        const int row = wid * 32 + (lane & 31);
        if (lane < 32) {
            const f32x2v a = P[row * 4 + 0], b = P[row * 4 + 1], c = P[row * 4 + 2], d = P[row * 4 + 3];
            const float mt = (a.x + b.x + c.x + d.x) * 0.25f;
            const float da = a.x - mt, db = b.x - mt, dc = c.x - mt, dd = d.x - mt;
            const float m2 = (a.y + b.y) + (c.y + d.y) + 64.0f * ((da * da + db * db) + (dc * dc + dd * dd));
            unsigned long long* slot = (unsigned long long*)xbuf + ((size_t)(u.pm * BM + row) * 4 + u.pn);
            __hip_atomic_store(slot, ((unsigned long long)__float_as_uint(m2) << 32) | __float_as_uint(mt), __ATOMIC_RELAXED, __HIP_MEMORY_SCOPE_AGENT);
        }
        asm volatile("s_waitcnt vmcnt(0)" ::: "memory");
        if (lane == 0) __hip_atomic_fetch_add(cnt + 64 * u.pm, 1u, __ATOMIC_RELAXED, __HIP_MEMORY_SCOPE_AGENT);
        if (wid == 0) {
            bool dead = false; const unsigned long long t0 = __builtin_amdgcn_s_memrealtime(); const unsigned want = 8u * (unsigned)ntn;
            for (;;) {
#if defined(BROKEN_EXCHANGE_NO_WAIT)
                break;
#endif
                if ((unsigned)__builtin_amdgcn_readfirstlane(__hip_atomic_load(cnt + 64 * u.pm, __ATOMIC_RELAXED, __HIP_MEMORY_SCOPE_AGENT)) >= want) break;
                if (__builtin_amdgcn_s_memrealtime() - t0 > 2000000ull) {
                    if (lane == 0) { unsigned expect = 0u; __hip_atomic_compare_exchange_strong(tmo + 1, &expect, code | (unsigned)(u.pm & 0xff), __ATOMIC_RELAXED, __ATOMIC_RELAXED, __HIP_MEMORY_SCOPE_AGENT);
                                     __hip_atomic_store(tmo, 1u, __ATOMIC_RELAXED, __HIP_MEMORY_SCOPE_AGENT); }
                    dead = true; break; }
                __builtin_amdgcn_s_sleep(2);
            }
            __builtin_amdgcn_fence(__ATOMIC_ACQUIRE, "agent");
            if (lane == 0) flag[0] = dead ? 1u : 0u;
        }
        asm volatile("s_waitcnt vmcnt(0) lgkmcnt(0)" ::: "memory"); __builtin_amdgcn_s_barrier(); asm volatile("" ::: "memory");
        const bool bad = flag[0] != 0u;
        if (lane < 32) {
            const unsigned long long* slot = (const unsigned long long*)xbuf + (size_t)(u.pm * BM + row) * 4; float mt[4], m2[4]; float ms = 0.f;
#pragma unroll
            for (int t = 0; t < 4; ++t) { if (t < ntn) { const unsigned long long w = __hip_atomic_load(slot + t, __ATOMIC_RELAXED, __HIP_MEMORY_SCOPE_AGENT); mt[t] = __uint_as_float((unsigned)w); m2[t] = __uint_as_float((unsigned)(w >> 32)); } else { mt[t] = 0.f; m2[t] = 0.f; } ms += mt[t]; }
            const float mean = ms / (float)ntn; float q = 0.f;
#pragma unroll
            for (int t = 0; t < 4; ++t) if (t < ntn) { const float dm = mt[t] - mean; q += m2[t] + 256.0f * dm * dm; }
            S[row] = (f32x2v){mean, 1.0f / sqrtf(q / (256.0f * (float)ntn) + eps)};
        }
        asm volatile("s_waitcnt lgkmcnt(0)" ::: "memory"); __builtin_amdgcn_s_barrier(); asm volatile("" ::: "memory");
        return bad;
    }
};
struct EpiLnRes {
    static constexpr bool PERM = false, AFTER_DRAIN = true;
    const float* base; float* out; int ldc; const float* bias; PanelStats st; unsigned poison;
    __device__ __forceinline__ void fused(f32x4 (&acc)[2][2][4][2], const Unit& u, int wr, int wc, int fr, int fq, PG8_LAS unsigned char* lds, int wid, int lane) const {
        typedef float f32x2v __attribute__((ext_vector_type(2)));
        const PG8_LAS f32x2v* S = (const PG8_LAS f32x2v*)(lds + 8192);
        const int col0 = u.pn * BM + wc * 32 + 4 * fq;
#pragma unroll
        for (int bj = 0; bj < 2; ++bj)
#pragma unroll
            for (int n = 0; n < 2; ++n) { const f32x4 bv = bias ? *(const f32x4*)(bias + col0 + bj * HALF + n * 16) : (f32x4){0.f, 0.f, 0.f, 0.f};
#pragma unroll
                for (int ai = 0; ai < 2; ++ai)
#pragma unroll
                    for (int m = 0; m < 4; ++m) acc[ai][bj][m][n] += bv; }
        f32x4 pre[4][2][2];
#pragma unroll
        for (int m = 0; m < 4; ++m) { const size_t off = (size_t)(u.pm * BM + wr * 64 + m * 16 + fr) * ldc + col0;
#pragma unroll
            for (int bj = 0; bj < 2; ++bj)
#pragma unroll
                for (int n = 0; n < 2; ++n) pre[m][bj][n] = *(const f32x4*)(base + off + bj * HALF + n * 16); }
        const bool bad = st.run(acc, u, wr, wc, fr, fq, lds, wid, lane) || poison != 0u;
        const float qnan = __builtin_nanf("");
#pragma unroll
        for (int ai = 0; ai < 2; ++ai)
#pragma unroll
            for (int m = 0; m < 4; ++m) { const int r = ai * HALF + wr * 64 + m * 16 + fr; const f32x2v sr = S[r]; const size_t off = (size_t)(u.pm * BM + r) * ldc + col0;
#pragma unroll
                for (int bj = 0; bj < 2; ++bj)
#pragma unroll
                    for (int n = 0; n < 2; ++n) { const f32x4 bs = ai == 0 ? pre[m][bj][n] : *(const f32x4*)(base + off + bj * HALF + n * 16); f32x4 o = bs + (acc[ai][bj][m][n] - sr.x) * sr.y;
                        if (bad) o = (f32x4){qnan, qnan, qnan, qnan}; *(f32x4*)(out + off + bj * HALF + n * 16) = o; }
                if (m & 1) asm volatile("" ::: "memory"); }
    }
};
struct EpiLnResLn {
    static constexpr bool PERM = false, AFTER_DRAIN = true;
    const float* base; float* out; bf16_t* xn; int ldc; const float* bias; PanelStats st1, st2; unsigned poison;
    __device__ __forceinline__ void fused(f32x4 (&acc)[2][2][4][2], const Unit& u, int wr, int wc, int fr, int fq, PG8_LAS unsigned char* lds, int wid, int lane) const {
        typedef float f32x2v __attribute__((ext_vector_type(2))); typedef unsigned u32x2v __attribute__((ext_vector_type(2)));
        const PG8_LAS f32x2v* S = (const PG8_LAS f32x2v*)(lds + 8192);
        const int col0 = u.pn * BM + wc * 32 + 4 * fq;
#pragma unroll
        for (int bj = 0; bj < 2; ++bj)
#pragma unroll
            for (int n = 0; n < 2; ++n) { const f32x4 bv = bias ? *(const f32x4*)(bias + col0 + bj * HALF + n * 16) : (f32x4){0.f, 0.f, 0.f, 0.f};
#pragma unroll
                for (int ai = 0; ai < 2; ++ai)
#pragma unroll
                    for (int m = 0; m < 4; ++m) acc[ai][bj][m][n] += bv; }
        bool bad = st1.run(acc, u, wr, wc, fr, fq, lds, wid, lane) || poison != 0u;
        const float qnan = __builtin_nanf("");
#pragma unroll
        for (int ai = 0; ai < 2; ++ai)
#pragma unroll
            for (int m = 0; m < 4; ++m) { const int r = ai * HALF + wr * 64 + m * 16 + fr; const f32x2v sr = S[r]; const size_t off = (size_t)(u.pm * BM + r) * ldc + col0;
#pragma unroll
                for (int bj = 0; bj < 2; ++bj)
#pragma unroll
                    for (int n = 0; n < 2; ++n) { const f32x4 bs = *(const f32x4*)(base + off + bj * HALF + n * 16); acc[ai][bj][m][n] = bs + (acc[ai][bj][m][n] - sr.x) * sr.y; }
                asm volatile("" : "+v"(acc[ai][0][m][0]), "+v"(acc[ai][0][m][1]), "+v"(acc[ai][1][m][0]), "+v"(acc[ai][1][m][1]));
                if (m & 1) asm volatile("" ::: "memory"); }
        const bool bad1 = bad;
        bad = st2.run(acc, u, wr, wc, fr, fq, lds, wid, lane) || bad;
#pragma unroll
        for (int ai = 0; ai < 2; ++ai)
#pragma unroll
            for (int m = 0; m < 4; ++m) { const int r = ai * HALF + wr * 64 + m * 16 + fr; const f32x2v sr = S[r]; const size_t off = (size_t)(u.pm * BM + r) * ldc + col0;
#pragma unroll
                for (int bj = 0; bj < 2; ++bj)
#pragma unroll
                    for (int n = 0; n < 2; ++n) { const f32x4 x1 = acc[ai][bj][m][n]; *(f32x4*)(out + off + bj * HALF + n * 16) = bad1 ? (f32x4){qnan, qnan, qnan, qnan} : x1;
                        const f32x4 o = (x1 - sr.x) * sr.y; u32x2v w; w.x = cvt_pk_bf16(o[0], o[1]); w.y = cvt_pk_bf16(o[2], o[3]);
                        if (bad) { w.x = 0x7fc07fc0u; w.y = 0x7fc07fc0u; } *(u32x2v*)(xn + off + bj * HALF + n * 16) = w; }
                asm volatile("" ::: "memory"); }
    }
};

template <class Epi, class Sched, bool ALIGN_EPI = false, bool SP2 = false>
__device__ __forceinline__ void gemm_phase(PG8_LAS unsigned char* lds, const Gemm g, const Sched& S, const Epi& E) {
    int tid_ = threadIdx.x; asm volatile("" : "+v"(tid_));
    const int tid = tid_, wid = __builtin_amdgcn_readfirstlane(tid >> 6), lane = tid & 63, wr = wid >> 2, wc = wid & 3, fr = lane & 15, fq = lane >> 4;
    const int K = g.K, nt = K / BK;
    unsigned voffA[2], voffB[2];
#pragma unroll
    for (int i = 0; i < 2; ++i) { int R, C; stage_rc(tid * 16 + i * 8192, R, C); const int Rb = Epi::PERM ? ((R & ~31) + perm32(R & 31)) : R;
        voffA[i] = (unsigned)(R * K + C) * 2u; voffB[i] = (unsigned)(Rb * K + C) * 2u; }
    const size_t kstep = (size_t)(BK * 2);
    const size_t hstep = (size_t)HALF * K * 2;
    const size_t tstep = 2 * hstep;
    const unsigned ldsw = (unsigned)wid * 1024u;
    const int aoff = lds_byte(wr * 64 + fr, fq * 8), boff = lds_byte(wc * 32 + fr, fq * 8);
#define PG8_SA(b, h) (((b) * 2 + (h)) * HTB)
#define PG8_SB(b, h) ((4 + (b) * 2 + (h)) * HTB)
#define PG8_STAGE(bufoff, gbase, voff) do { _Pragma("unroll") for (int _i = 0; _i < 2; ++_i) \
        __builtin_amdgcn_global_load_lds((const unsigned*)((const char*)(gbase) + (voff)[_i]), (PG8_LAS unsigned*)(lds + (bufoff) + ldsw + _i * 8192), 16, 0, 0); } while (0)
#define PG8_LDA(dst, b, h) do { _Pragma("unroll") for (int m = 0; m < 4; ++m) _Pragma("unroll") for (int k = 0; k < 2; ++k) dst[m][k] = *(const PG8_LAS bf16x8*)(lds + PG8_SA(b, h) + aoff + m * 2048 + k * 1024); } while (0)
#define PG8_LDB(dst, b, h) do { _Pragma("unroll") for (int n = 0; n < 2; ++n) _Pragma("unroll") for (int k = 0; k < 2; ++k) dst[n][k] = *(const PG8_LAS bf16x8*)(lds + PG8_SB(b, h) + boff + n * 2048 + k * 1024); } while (0)
#define PG8_MMA(ai, bj, At, Bt) do { __builtin_amdgcn_s_setprio(1); _Pragma("unroll") for (int m = 0; m < 4; ++m) _Pragma("unroll") for (int n = 0; n < 2; ++n) _Pragma("unroll") for (int k = 0; k < 2; ++k) \
        acc[ai][bj][m][n] = __builtin_amdgcn_mfma_f32_16x16x32_bf16(Bt[n][k], At[m][k], acc[ai][bj][m][n], 0, 0, 0); __builtin_amdgcn_s_setprio(0); } while (0)
#define PG8_WAIT_V(n) asm volatile("s_waitcnt vmcnt(" #n ")" ::: "memory")
#define PG8_WAIT_L(n) asm volatile("s_waitcnt lgkmcnt(" #n ")" ::: "memory")
#define PG8_BAR __builtin_amdgcn_s_barrier()
#define PG8_SCHED __builtin_amdgcn_sched_barrier(0)
    Unit cur, nxt; int ui = 0;
    if (!S.next(0, cur)) return;
    f32x4 acc[2][2][4][2];
#pragma unroll
    for (int a = 0; a < 2; ++a)
#pragma unroll
        for (int b = 0; b < 2; ++b)
#pragma unroll
            for (int m = 0; m < 4; ++m)
#pragma unroll
                for (int n = 0; n < 2; ++n) acc[a][b][m][n] = (f32x4){0.f, 0.f, 0.f, 0.f};
    bf16x8 At[4][2], B0[2][2], B1[2][2];
    const char* cA = (const char*)g.A + (size_t)cur.pm * tstep; const char* cB = (const char*)g.Bt + (size_t)cur.pn * tstep;
    S.a_ready(cur);
    if constexpr (SP2) {
        PG8_STAGE(PG8_SB(0, 0), cB, voffB); PG8_STAGE(PG8_SB(0, 1), cB + hstep, voffB); PG8_STAGE(PG8_SA(0, 0), cA, voffA); PG8_STAGE(PG8_SA(0, 1), cA + hstep, voffA);
        if (wr == 1) PG8_BAR;
        PG8_WAIT_V(2); PG8_BAR;
        PG8_STAGE(PG8_SB(1, 0), cB + kstep, voffB); PG8_STAGE(PG8_SA(1, 0), cA + kstep, voffA); PG8_STAGE(PG8_SB(1, 1), cB + hstep + kstep, voffB);
        PG8_WAIT_V(6); PG8_BAR;
    } else {
        PG8_STAGE(PG8_SB(0, 0), cB, voffB); PG8_STAGE(PG8_SA(0, 0), cA, voffA); PG8_STAGE(PG8_SB(0, 1), cB + hstep, voffB); PG8_STAGE(PG8_SA(0, 1), cA + hstep, voffA);
        if (wr == 1) PG8_BAR;
        PG8_WAIT_V(4); PG8_BAR;
        PG8_STAGE(PG8_SB(1, 0), cB + kstep, voffB); PG8_STAGE(PG8_SA(1, 0), cA + kstep, voffA); PG8_STAGE(PG8_SB(1, 1), cB + hstep + kstep, voffB);
        PG8_WAIT_V(6); PG8_BAR;
    }
    for (;;) {
        const bool has_next = S.next(ui + 1, nxt);
        const char* nA = has_next ? (const char*)g.A + (size_t)nxt.pm * tstep : cA; const char* nB = has_next ? (const char*)g.Bt + (size_t)nxt.pn * tstep : cB;
        for (int t = 0; t < nt; t += 2) {
            const bool last = (t == nt - 2);
            const char* a1 = cA + (size_t)(t + 1) * kstep;
            const char* a2 = last ? nA : cA + (size_t)(t + 2) * kstep; const char* b2 = last ? nB : cB + (size_t)(t + 2) * kstep;
            const char* a3 = a2 + kstep; const char* b3 = b2 + kstep;
            if (last && has_next) S.a_ready(nxt);
            if constexpr (SP2) {
            PG8_LDB(B0, 0, 0); PG8_LDB(B1, 0, 1); PG8_SCHED; PG8_LDA(At, 0, 0); PG8_STAGE(PG8_SA(1, 1), a1 + hstep, voffA);
            PG8_WAIT_V(8); PG8_WAIT_L(0); PG8_BAR; PG8_MMA(0, 0, At, B0); PG8_MMA(0, 1, At, B1); PG8_BAR; PG8_SCHED;
            PG8_LDA(At, 0, 1); PG8_STAGE(PG8_SB(0, 0), b2, voffB); PG8_STAGE(PG8_SB(0, 1), b2 + hstep, voffB); PG8_STAGE(PG8_SA(0, 0), a2, voffA);
            PG8_WAIT_V(8); PG8_WAIT_L(0); PG8_BAR; PG8_MMA(1, 0, At, B0); PG8_MMA(1, 1, At, B1); PG8_BAR; PG8_SCHED;
            PG8_LDB(B0, 1, 0); PG8_LDB(B1, 1, 1); PG8_SCHED; PG8_LDA(At, 1, 0); PG8_STAGE(PG8_SA(0, 1), a2 + hstep, voffA);
            PG8_WAIT_V(8); PG8_WAIT_L(0); PG8_BAR; PG8_MMA(0, 0, At, B0); PG8_MMA(0, 1, At, B1); PG8_BAR; PG8_SCHED;
            PG8_LDA(At, 1, 1); PG8_STAGE(PG8_SB(1, 0), b3, voffB); PG8_STAGE(PG8_SB(1, 1), b3 + hstep, voffB); PG8_STAGE(PG8_SA(1, 0), a3, voffA);
            PG8_WAIT_V(8); PG8_WAIT_L(0); PG8_BAR; PG8_MMA(1, 0, At, B0); PG8_MMA(1, 1, At, B1); PG8_BAR; PG8_SCHED;
            } else {
            PG8_LDB(B0, 0, 0); PG8_SCHED; PG8_LDA(At, 0, 0); PG8_STAGE(PG8_SA(1, 1), a1 + hstep, voffA);
            PG8_WAIT_L(8); PG8_BAR; PG8_WAIT_L(0); PG8_MMA(0, 0, At, B0); PG8_BAR; PG8_SCHED;
            PG8_LDB(B1, 0, 1); PG8_STAGE(PG8_SB(0, 0), b2, voffB);
            PG8_BAR; PG8_WAIT_L(0); PG8_MMA(0, 1, At, B1); PG8_BAR;
            PG8_LDA(At, 0, 1); PG8_STAGE(PG8_SA(0, 0), a2, voffA);
            PG8_BAR; PG8_WAIT_L(0); PG8_MMA(1, 0, At, B0); PG8_BAR; PG8_SCHED;
            PG8_STAGE(PG8_SB(0, 1), b2 + hstep, voffB);
            PG8_WAIT_V(6); PG8_BAR; PG8_MMA(1, 1, At, B1); PG8_BAR;
            PG8_LDB(B0, 1, 0); PG8_SCHED; PG8_LDA(At, 1, 0); PG8_STAGE(PG8_SA(0, 1), a2 + hstep, voffA);
            PG8_WAIT_L(8); PG8_BAR; PG8_WAIT_L(0); PG8_MMA(0, 0, At, B0); PG8_BAR; PG8_SCHED;
            PG8_LDB(B1, 1, 1); PG8_STAGE(PG8_SB(1, 0), b3, voffB);
            PG8_BAR; PG8_WAIT_L(0); PG8_MMA(0, 1, At, B1); PG8_BAR;
            PG8_LDA(At, 1, 1); PG8_STAGE(PG8_SA(1, 0), a3, voffA);
            PG8_BAR; PG8_WAIT_L(0); PG8_MMA(1, 0, At, B0); PG8_BAR; PG8_SCHED;
            PG8_STAGE(PG8_SB(1, 1), b3 + hstep, voffB);
            PG8_WAIT_V(6); PG8_BAR; PG8_MMA(1, 1, At, B1); PG8_BAR;
            }
        }
        if constexpr (ALIGN_EPI) { if (wr == 0) PG8_BAR; }
        if constexpr (!Epi::AFTER_DRAIN) { E(acc, cur, wr, wc, fr, fq); S.done(cur); }
        if (!has_next) break;
#pragma unroll
        for (int a = 0; a < 2; ++a)
#pragma unroll
            for (int b = 0; b < 2; ++b)
#pragma unroll
                for (int m = 0; m < 4; ++m)
#pragma unroll
                    for (int n = 0; n < 2; ++n) acc[a][b][m][n] = (f32x4){0.f, 0.f, 0.f, 0.f};
        cur = nxt; cA = nA; cB = nB; ++ui;
        if constexpr (ALIGN_EPI) { if (wr == 1) PG8_BAR; }
    }
    PG8_WAIT_V(0);
    if constexpr (!ALIGN_EPI) { if (wr == 0) PG8_BAR; }
    PG8_BAR;
    if constexpr (Epi::AFTER_DRAIN) { E.fused(acc, cur, wr, wc, fr, fq, lds, wid, lane); S.done(cur); }
#undef PG8_SA
#undef PG8_SB
#undef PG8_STAGE
#undef PG8_LDA
#undef PG8_LDB
#undef PG8_MMA
#undef PG8_WAIT_V
#undef PG8_WAIT_L
#undef PG8_BAR
#undef PG8_SCHED
}
}

#include <hip/hip_cooperative_groups.h>
namespace cg = cooperative_groups;
#define LAS __attribute__((address_space(3)))
typedef unsigned short bf16_t;
using pg8::f32x4; using pg8::bf16x8; using pg8::u32x4;
typedef float f32x2_t __attribute__((ext_vector_type(2))); typedef __bf16 bf16x2_t __attribute__((ext_vector_type(2)));
__device__ __forceinline__ unsigned cvt_pk_bf16(float lo, float hi) { f32x2_t v = {lo, hi}; bf16x2_t b = __builtin_convertvector(v, bf16x2_t); return __builtin_bit_cast(unsigned, b); }
typedef float f32x16 __attribute__((ext_vector_type(16)));
typedef short s16x4 __attribute__((ext_vector_type(4)));
typedef unsigned u32x2 __attribute__((ext_vector_type(2)));

constexpr int M = 16384, DM = 1024, SEQ = 2048, NB = 8, DEPTH = 4;
constexpr int NIN = 3840;
constexpr int DFF = 2816;
constexpr float EPS = 1e-6f;
constexpr float LOG2E = 1.4426950408889634f;
constexpr int LDS_BYTES = 147456;

struct P {
    const float *x, *mem; const int* pos;
    const float *norm_mix, *w_in, *ssm_conv_w, *ssm_conv_b, *dt_bias, *a_log, *d_skip, *ssm_norm, *q_norm, *w_uq, *kv_norm, *w_ukv, *attn_out_norm, *w_out,
                *norm_mem_q, *norm_mem_kv, *w_mq, *w_mk, *w_mv, *w_mo, *norm_ffn, *w_up, *ffn_conv_w, *ffn_conv_b, *w_down, *final_norm;
    float* out; unsigned char* ws;
};

constexpr size_t KiB = 1024, MiB = 1024 * 1024;
constexpr size_t WS_RSS = 0, WS_COS = 1 * MiB, WS_SIN = 2 * MiB, WS_DT = 3 * MiB, WS_KPE = 4 * MiB;
constexpr size_t WS_WIN = 6144 * KiB, WS_WUQ = 13824 * KiB, WS_WUKV = 14976 * KiB, WS_WOUT = 16000 * KiB, WS_WMQ = 20096 * KiB, WS_WMO = 22144 * KiB,
                 WS_WUP = 24192 * KiB, WS_WDN0 = 35456 * KiB, WS_WDN1 = 41088 * KiB;
constexpr size_t WS_WMKV = 46 * MiB, WS_KMVM = 62 * MiB, WS_MEMN = 94 * MiB, WS_XB = 98 * MiB, WS_VB = 98 * MiB;
constexpr size_t WS_Z = 130 * MiB, WS_KN = 130 * MiB, WS_QM = 130 * MiB, WS_U = 130 * MiB;
constexpr size_t WS_XBCPRE = 162 * MiB, WS_YC = 162 * MiB, WS_OM = 162 * MiB;
constexpr size_t WS_ACT = 218 * MiB;
constexpr size_t WS_SM = 226 * MiB, WS_XBC = 250 * MiB, WS_QB = 250 * MiB, WS_CQN = 314 * MiB, WS_CKVN = 326 * MiB, WS_RSP = 334 * MiB, WS_END = 337 * MiB;

__device__ __forceinline__ float bflo(unsigned w) { return __uint_as_float(w << 16); }
__device__ __forceinline__ float bfhi(unsigned w) { return __uint_as_float(w & 0xffff0000u); }
__device__ __forceinline__ float bf1(bf16_t h) { return __uint_as_float((unsigned)h << 16); }
__device__ __forceinline__ bf16_t tobf(float f) { return (bf16_t)(cvt_pk_bf16(f, 0.f) & 0xffffu); }
__device__ __forceinline__ float wave_sum(float v) {
#pragma unroll
    for (int o = 1; o < 64; o <<= 1) v += __shfl_xor(v, o);
    return v;
}
__device__ __forceinline__ float silu_f(float v) { return v / (1.f + __expf(-v)); }
__device__ __forceinline__ int crow(int r, int hi) { return (r & 3) + 8 * (r >> 2) + 4 * hi; }
#define LDS_WAIT() asm volatile("s_waitcnt lgkmcnt(0)" ::: "memory")
__device__ __forceinline__ int fresh_tid() { int t = threadIdx.x; asm volatile("" : "+v"(t)); return t; }
__device__ __forceinline__ float rss16(const float* rsp, int row) { const f32x4 a = *(const f32x4*)(rsp + (size_t)row * 4), b = *(const f32x4*)(rsp + (size_t)M * 4 + (size_t)row * 4), c = *(const f32x4*)(rsp + (size_t)M * 8 + (size_t)row * 4), d = *(const f32x4*)(rsp + (size_t)M * 12 + (size_t)row * 4);
    return (((a[0] + a[1]) + (a[2] + a[3])) + ((b[0] + b[1]) + (b[2] + b[3]))) + (((c[0] + c[1]) + (c[2] + c[3])) + ((d[0] + d[1]) + (d[2] + d[3]))); }

struct EpiRoute {
    static constexpr bool PERM = true, AFTER_DRAIN = false;
    bf16_t *b0, *b1, *b2; int ld0, ld1, ld2, t1, t2; const float* rss; float invk, mul;
    __device__ __forceinline__ void operator()(const f32x4 (&acc)[2][2][4][2], const pg8::Unit& u, int wr_, int wc_, int fr_, int fq_) const {
        const int t_ = fresh_tid(), wid_ = __builtin_amdgcn_readfirstlane(t_ >> 6), wr = wid_ >> 2, wc = wid_ & 3, fr = t_ & 15, fq = (t_ >> 4) & 3;
        bf16_t* base; int ld, colt;
        if (u.pn < t1) { base = b0; ld = ld0; colt = u.pn * 256; } else if (u.pn < t2) { base = b1; ld = ld1; colt = (u.pn - t1) * 256; } else { base = b2; ld = ld2; colt = (u.pn - t2) * 256; }
        const int col0 = colt + wc * 32 + 8 * fq;
#pragma unroll
        for (int ai = 0; ai < 2; ++ai)
#pragma unroll
            for (int m = 0; m < 4; ++m) {
                const int row = u.pm * 256 + ai * 128 + wr * 64 + m * 16 + fr;
                float s = mul; if (rss) s *= rsqrtf(rss16(rss, row) * invk + EPS);
                bf16_t* rowp = base + (size_t)row * ld + col0;
#pragma unroll
                for (int bj = 0; bj < 2; ++bj) { const f32x4 v0 = acc[ai][bj][m][0] * s, v1 = acc[ai][bj][m][1] * s;
                    u32x4 w; w.x = cvt_pk_bf16(v0[0], v0[1]); w.y = cvt_pk_bf16(v0[2], v0[3]); w.z = cvt_pk_bf16(v1[0], v1[1]); w.w = cvt_pk_bf16(v1[2], v1[3]);
                    *(u32x4*)(rowp + bj * 128) = w; }
                asm volatile("" ::: "memory");
            }
    }
};
struct EpiRope {
    static constexpr bool PERM = false, AFTER_DRAIN = false;
    bf16_t* O; const float* cs; const float* sn; float mul;
    __device__ __forceinline__ void operator()(const f32x4 (&acc)[2][2][4][2], const pg8::Unit& u, int wr_, int wc_, int fr_, int fq_) const {
        const int t_ = fresh_tid(), wid_ = __builtin_amdgcn_readfirstlane(t_ >> 6), wr = wid_ >> 2, wc = wid_ & 3, fr = t_ & 15, fq = (t_ >> 4) & 3;
#pragma unroll
        for (int ai = 0; ai < 2; ++ai)
#pragma unroll
            for (int m = 0; m < 4; ++m) {
                const int row = u.pm * 256 + ai * 128 + wr * 64 + m * 16 + fr;
                const f32x4 c = *(const f32x4*)(cs + (size_t)row * 16 + 4 * fq), s = *(const f32x4*)(sn + (size_t)row * 16 + 4 * fq);
#pragma unroll
                for (int bj = 0; bj < 2; ++bj) { const int gb = u.pn * 256 + bj * 128 + wc * 32; const bool rope = (gb % 96) == 64;
                    f32x4 a = acc[ai][bj][m][0], b = acc[ai][bj][m][1];
                    if (rope) { const f32x4 a2 = a * c - b * s, b2 = b * c + a * s; a = a2; b = b2; }
                    a = a * mul; b = b * mul;
                    bf16_t* dst = O + (size_t)row * 1536 + gb + 4 * fq;
                    u32x2 w0, w1; w0.x = cvt_pk_bf16(a[0], a[1]); w0.y = cvt_pk_bf16(a[2], a[3]); w1.x = cvt_pk_bf16(b[0], b[1]); w1.y = cvt_pk_bf16(b[2], b[3]);
                    *(u32x2*)dst = w0; *(u32x2*)(dst + 16) = w1; }
                asm volatile("" ::: "memory");
            }
    }
};
struct EpiRes {
    static constexpr bool PERM = false, AFTER_DRAIN = false;
    const float* xin; float* xout; bf16_t* xb; float* rss;
    __device__ __forceinline__ void operator()(const f32x4 (&acc)[2][2][4][2], const pg8::Unit& u, int wr_, int wc_, int fr_, int fq_) const {
        const int t_ = fresh_tid(), wid_ = __builtin_amdgcn_readfirstlane(t_ >> 6), wr = wid_ >> 2, wc = wid_ & 3, fr = t_ & 15, fq = (t_ >> 4) & 3;
#pragma unroll
        for (int ai = 0; ai < 2; ++ai)
#pragma unroll
            for (int m = 0; m < 4; ++m) {
                const int row = u.pm * 256 + ai * 128 + wr * 64 + m * 16 + fr; float ss = 0.f;
#pragma unroll
                for (int bj = 0; bj < 2; ++bj)
#pragma unroll
                    for (int n = 0; n < 2; ++n) { const size_t off = (size_t)row * 1024 + u.pn * 256 + bj * 128 + wc * 32 + 16 * n + 4 * fq;
                        const f32x4 v = *(const f32x4*)(xin + off) + acc[ai][bj][m][n];
                        *(f32x4*)(xout + off) = v; u32x2 w; w.x = cvt_pk_bf16(v[0], v[1]); w.y = cvt_pk_bf16(v[2], v[3]); *(u32x2*)(xb + off) = w;
                        ss += (v[0] * v[0] + v[1] * v[1]) + (v[2] * v[2] + v[3] * v[3]); }
                ss += __shfl_xor(ss, 16); ss += __shfl_xor(ss, 32);
                if (fq == 0) rss[(size_t)u.pn * M * 4 + (size_t)row * 4 + wc] = ss;
                asm volatile("" ::: "memory");
            }
    }
};

template <class Epi>
__device__ __forceinline__ void run_gemm(LAS unsigned char* lds, const bf16_t* A, const bf16_t* Bt, int m, int n, int k, const Epi& E) {
    pg8::Gemm g{A, Bt, m, n, k}; pg8::StaticOrder S; S.init(m, n, (int)gridDim.x, (int)blockIdx.x);
    pg8::gemm_phase<Epi, pg8::StaticOrder, true, true>(lds, g, S, E);
}

template <class SrcCol, class Gain>
__device__ __forceinline__ void tr_item(const float* W, int K, int Nsrc, bf16_t* WT, int nblk, LAS float* scr, int item, int lane, SrcCol srccol, Gain gain) {
    const int kb = item / nblk, nb = item % nblk, k0 = 64 * kb, n0 = 32 * nb;
    const int sc = srccol(n0 + (lane & 31));
#pragma unroll 8
    for (int i = 0; i < 32; ++i) { const int kk = 2 * i + (lane >> 5);
        float v = 0.f; if (sc >= 0) v = W[(size_t)(k0 + kk) * Nsrc + sc] * gain(k0 + kk);
        scr[kk * 33 + (lane & 31)] = v; }
    LDS_WAIT(); asm volatile("" ::: "memory");
    const int c = lane & 7;
#pragma unroll
    for (int j = 0; j < 4; ++j) { const int n = (lane >> 3) + 8 * j; const LAS float* s = scr + (8 * c) * 33 + n;
        u32x4 o; o.x = cvt_pk_bf16(s[0 * 33], s[1 * 33]); o.y = cvt_pk_bf16(s[2 * 33], s[3 * 33]); o.z = cvt_pk_bf16(s[4 * 33], s[5 * 33]); o.w = cvt_pk_bf16(s[6 * 33], s[7 * 33]);
        *(u32x4*)(WT + (size_t)(n0 + n) * K + k0 + 8 * c) = o; }
    LDS_WAIT(); asm volatile("" ::: "memory");
}

__device__ __forceinline__ void convert_layer(const P& p, int L, LAS float* scr, int gw, int NGW, int lane_unused) {
    const int lane = fresh_tid() & 63;
    unsigned char* ws = p.ws; asm volatile("" : "+s"(ws));
    constexpr int I_IN = 16 * 120, I_UQ = 6 * 48, I_UKV = 4 * 64, I_OUT = 32 * 32, I_MQ = 16 * 32, I_MO = 16 * 32, I_UP = 16 * 176, I_DN = 44 * 32;
    constexpr int NIT = I_IN + I_UQ + I_UKV + I_OUT + I_MQ + I_MO + I_UP + I_DN;
    for (int it = gw; it < NIT; it += NGW) {
        int r = it;
        if (r < I_IN) { const float* g = p.norm_mix + L * 1024;
            tr_item(p.w_in + (size_t)L * 1024 * 3760, 1024, 3760, (bf16_t*)(ws + WS_WIN), 120, scr, r, lane,
                    [](int n) { return n < 3072 ? n : (n < 3744 ? n + 16 : (n < 3760 ? n - 672 : -1)); }, [g](int k) { return g[k]; }); continue; } r -= I_IN;
        if (r < I_UQ) { const float* g = p.q_norm + L * 384;
            tr_item(p.w_uq + (size_t)L * 384 * 1536, 384, 1536, (bf16_t*)(ws + WS_WUQ), 48, scr, r, lane, [](int n) { return n; }, [g](int k) { return g[k]; }); continue; } r -= I_UQ;
        if (r < I_UKV) { const float* g = p.kv_norm + L * 256;
            tr_item(p.w_ukv + (size_t)L * 256 * 2048, 256, 2048, (bf16_t*)(ws + WS_WUKV), 64, scr, r, lane,
                    [](int n) { return n < 1024 ? 128 * (n >> 6) + (n & 63) : 128 * ((n - 1024) >> 6) + 64 + (n & 63); }, [g](int k) { return g[k]; }); continue; } r -= I_UKV;
        if (r < I_OUT) { const float* g1 = p.ssm_norm + L * 1024; const float* g2 = p.attn_out_norm + L * 1024;
            tr_item(p.w_out + (size_t)L * 2048 * 1024, 2048, 1024, (bf16_t*)(ws + WS_WOUT), 32, scr, r, lane, [](int n) { return n; }, [g1, g2](int k) { return k < 1024 ? g1[k] : g2[k - 1024]; }); continue; } r -= I_OUT;
        if (r < I_MQ) { const float* g = p.norm_mem_q + L * 1024;
            tr_item(p.w_mq + (size_t)L * 1024 * 1024, 1024, 1024, (bf16_t*)(ws + WS_WMQ), 32, scr, r, lane, [](int n) { return n; }, [g](int k) { return g[k]; }); continue; } r -= I_MQ;
        if (r < I_MO) {
            tr_item(p.w_mo + (size_t)L * 1024 * 1024, 1024, 1024, (bf16_t*)(ws + WS_WMO), 32, scr, r, lane, [](int n) { return n; }, [](int) { return 1.f; }); continue; } r -= I_MO;
        if (r < I_UP) { const float* g = p.norm_ffn + L * 1024;
            tr_item(p.w_up + (size_t)L * 1024 * 5632, 1024, 5632, (bf16_t*)(ws + WS_WUP), 176, scr, r, lane, [](int n) { return n; }, [g](int k) { return g[k]; }); continue; } r -= I_UP;
        tr_item(p.w_down + (size_t)L * 2816 * 1024, 2816, 1024, (bf16_t*)(ws + ((L & 1) ? WS_WDN1 : WS_WDN0)), 32, scr, r, lane, [](int n) { return n; }, [](int) { return 1.f; });
    }
}

__device__ __forceinline__ void prologue(const P& p, LAS float* scr, int gw, int NGW, int lane_unused) {
    const int lane = fresh_tid() & 63;
    unsigned char* ws = p.ws; asm volatile("" : "+s"(ws));
    float* rss = (float*)(ws + WS_RSP);
    bf16_t* XB = (bf16_t*)(ws + WS_XB);
    for (int m = gw; m < M; m += NGW) {
        const f32x4* xr = (const f32x4*)(p.x + (size_t)m * 1024) + lane; float ss = 0.f;
#pragma unroll
        for (int j = 0; j < 4; ++j) { const f32x4 v = xr[64 * j]; ss += (v[0] * v[0] + v[1] * v[1]) + (v[2] * v[2] + v[3] * v[3]);
            u32x2 w; w.x = cvt_pk_bf16(v[0], v[1]); w.y = cvt_pk_bf16(v[2], v[3]); *((u32x2*)(XB + (size_t)m * 1024) + lane + 64 * j) = w; }
        ss = wave_sum(ss); if (lane < 16) rss[(size_t)(lane >> 2) * M * 4 + (size_t)m * 4 + (lane & 3)] = (lane == 0) ? ss : 0.f;
    }
    bf16_t* MEMN = (bf16_t*)(ws + WS_MEMN);
    for (int m = gw; m < 2048; m += NGW) {
        const f32x4* xr = (const f32x4*)(p.mem + (size_t)m * 1024) + lane; f32x4 v[4]; float ss = 0.f;
#pragma unroll
        for (int j = 0; j < 4; ++j) { v[j] = xr[64 * j]; ss += (v[j][0] * v[j][0] + v[j][1] * v[j][1]) + (v[j][2] * v[j][2] + v[j][3] * v[j][3]); }
        const float rs = rsqrtf(wave_sum(ss) * (1.f / 1024.f) + EPS);
#pragma unroll
        for (int j = 0; j < 4; ++j) { u32x2 w; w.x = cvt_pk_bf16(v[j][0] * rs, v[j][1] * rs); w.y = cvt_pk_bf16(v[j][2] * rs, v[j][3] * rs); *((u32x2*)(MEMN + (size_t)m * 1024) + lane + 64 * j) = w; }
    }
    float* COS = (float*)(ws + WS_COS); float* SIN = (float*)(ws + WS_SIN);
    for (int i = gw * 64 + lane; i < M * 16; i += NGW * 64) { const int m = i >> 4, k = i & 15;
        const float inv = powf(10000.f, -(float)(2 * k) / 32.f); const float ang = (float)p.pos[m] * inv;
        COS[i] = cosf(ang); SIN[i] = sinf(ang); }
    for (int it = gw; it < 4 * 2 * 512; it += NGW) { const int L = it >> 10, kv = (it >> 9) & 1, r = it & 511; const float* g = p.norm_mem_kv + L * 1024;
        tr_item((kv ? p.w_mv : p.w_mk) + (size_t)L * 1024 * 1024, 1024, 1024, (bf16_t*)(ws + WS_WMKV) + (size_t)(L * 2048 + kv * 1024) * 1024, 32, scr, r, lane, [](int n) { return n; }, [g](int k) { return g[k]; }); }
    convert_layer(p, 0, scr, gw, NGW, lane);
}

__device__ __forceinline__ void pass_l2(const P& p, int L, int gw, int NGW, int lane_unused) {
    const int lane = fresh_tid() & 63;
    unsigned char* ws = p.ws; asm volatile("" : "+s"(ws));
    const bf16_t* XP = (const bf16_t*)(ws + WS_XBCPRE); bf16_t* XO = (bf16_t*)(ws + WS_XBC); const bf16_t* SM = (const bf16_t*)(ws + WS_SM);
    bf16_t* CQN = (bf16_t*)(ws + WS_CQN); bf16_t* CKVN = (bf16_t*)(ws + WS_CKVN); bf16_t* KPE = (bf16_t*)(ws + WS_KPE); float* DT = (float*)(ws + WS_DT);
    const float* COS = (const float*)(ws + WS_COS); const float* SIN = (const float*)(ws + WS_SIN);
    const float* cw = p.ssm_conv_w + (size_t)L * 4 * 2048; const float* cb = p.ssm_conv_b + (size_t)L * 2048;
    for (int m = gw; m < M; m += NGW) {
        const int t = m & (SEQ - 1);
#pragma unroll
        for (int j = 0; j < 4; ++j) {
            const int c = lane * 8 + 512 * j;
            f32x4 a0 = *(const f32x4*)(cb + c), a1 = *(const f32x4*)(cb + c + 4);
#pragma unroll
            for (int k = 0; k < 4; ++k) { if (t - 3 + k >= 0) {
                const u32x4 v = *(const u32x4*)(XP + (size_t)(m - 3 + k) * 2048 + c);
                const f32x4 w0 = *(const f32x4*)(cw + k * 2048 + c), w1 = *(const f32x4*)(cw + k * 2048 + c + 4);
                a0[0] += w0[0] * bflo(v.x); a0[1] += w0[1] * bfhi(v.x); a0[2] += w0[2] * bflo(v.y); a0[3] += w0[3] * bfhi(v.y);
                a1[0] += w1[0] * bflo(v.z); a1[1] += w1[1] * bfhi(v.z); a1[2] += w1[2] * bflo(v.w); a1[3] += w1[3] * bfhi(v.w); } }
            u32x4 o; o.x = cvt_pk_bf16(silu_f(a0[0]), silu_f(a0[1])); o.y = cvt_pk_bf16(silu_f(a0[2]), silu_f(a0[3]));
            o.z = cvt_pk_bf16(silu_f(a1[0]), silu_f(a1[1])); o.w = cvt_pk_bf16(silu_f(a1[2]), silu_f(a1[3]));
            *(u32x4*)(XO + (size_t)m * 2048 + c) = o;
        }
    }
    for (int m = gw; m < M; m += NGW) {
        const unsigned* sm = (const unsigned*)(SM + (size_t)m * 768);
        {
            unsigned w[3]; float ss = 0.f;
#pragma unroll
            for (int i = 0; i < 3; ++i) { w[i] = sm[lane + 64 * i]; const float a = bflo(w[i]), b = bfhi(w[i]); ss += a * a + b * b; }
            const float rs = rsqrtf(wave_sum(ss) * (1.f / 384.f) + EPS);
#pragma unroll
            for (int i = 0; i < 3; ++i) ((unsigned*)(CQN + (size_t)m * 384))[lane + 64 * i] = cvt_pk_bf16(bflo(w[i]) * rs, bfhi(w[i]) * rs);
        }
        {
            unsigned w[2]; float ss = 0.f;
#pragma unroll
            for (int i = 0; i < 2; ++i) { w[i] = sm[192 + lane + 64 * i]; const float a = bflo(w[i]), b = bfhi(w[i]); ss += a * a + b * b; }
            const float rs = rsqrtf(wave_sum(ss) * (1.f / 256.f) + EPS);
#pragma unroll
            for (int i = 0; i < 2; ++i) ((unsigned*)(CKVN + (size_t)m * 256))[lane + 64 * i] = cvt_pk_bf16(bflo(w[i]) * rs, bfhi(w[i]) * rs);
        }
        {
            const bf16_t* sr = SM + (size_t)m * 768;
            const float v = bf1(sr[640 + (lane & 31)]); const float pr = __shfl_xor(v, 16); const int i = lane & 15;
            const float c = COS[(size_t)m * 16 + i], s = SIN[(size_t)m * 16 + i];
            const float o = (lane & 16) ? (v * c + pr * s) : (v * c - pr * s);
            if (lane < 32) KPE[(size_t)m * 32 + lane] = tobf(o);
            const float d = bf1(sr[672 + (lane & 15)]) + p.dt_bias[L * 16 + (lane & 15)];
            const float sp = fmaxf(d, 0.f) + __logf(1.f + __expf(-fabsf(d)));
            if (lane < 16) DT[(size_t)m * 16 + lane] = sp;
        }
    }
}

__device__ __forceinline__ void pass_ycnorm(const P& p, int gw, int NGW, int lane_unused) {
    const int lane = fresh_tid() & 63;
    unsigned char* ws = p.ws; asm volatile("" : "+s"(ws));
    bf16_t* YC = (bf16_t*)(ws + WS_YC);
    for (int m = gw; m < M; m += NGW) {
        u32x4* row = (u32x4*)(YC + (size_t)m * 2048);
        u32x4 v[4]; float s[2] = {0.f, 0.f};
#pragma unroll
        for (int j = 0; j < 4; ++j) { v[j] = row[lane + 64 * j];
            float q = 0.f;
            q += bflo(v[j].x) * bflo(v[j].x) + bfhi(v[j].x) * bfhi(v[j].x); q += bflo(v[j].y) * bflo(v[j].y) + bfhi(v[j].y) * bfhi(v[j].y);
            q += bflo(v[j].z) * bflo(v[j].z) + bfhi(v[j].z) * bfhi(v[j].z); q += bflo(v[j].w) * bflo(v[j].w) + bfhi(v[j].w) * bfhi(v[j].w);
            s[j >> 1] += q; }
        const float r0 = rsqrtf(wave_sum(s[0]) * (1.f / 1024.f) + EPS), r1 = rsqrtf(wave_sum(s[1]) * (1.f / 1024.f) + EPS);
#pragma unroll
        for (int j = 0; j < 4; ++j) { const float r = (j < 2) ? r0 : r1; u32x4 o;
            o.x = cvt_pk_bf16(bflo(v[j].x) * r, bfhi(v[j].x) * r); o.y = cvt_pk_bf16(bflo(v[j].y) * r, bfhi(v[j].y) * r);
            o.z = cvt_pk_bf16(bflo(v[j].z) * r, bfhi(v[j].z) * r); o.w = cvt_pk_bf16(bflo(v[j].w) * r, bfhi(v[j].w) * r);
            row[lane + 64 * j] = o; }
    }
}

__device__ __forceinline__ void pass_ffnact(const P& p, int L, int half, int gw, int NGW, int lane_unused) {
    const int lane = fresh_tid() & 63;
    unsigned char* ws = p.ws; asm volatile("" : "+s"(ws));
    const bf16_t* U = (const bf16_t*)(ws + WS_U); bf16_t* ACT = (bf16_t*)(ws + WS_ACT) + (size_t)half * 8192 * DFF;
    const float* cw = p.ffn_conv_w + (size_t)L * 3 * 5632; const float* cb = p.ffn_conv_b + (size_t)L * 5632;
    for (int m = gw; m < 8192; m += NGW) {
        const int t = m & (SEQ - 1);
        for (int ch = lane; ch < DFF / 8; ch += 64) {
            const int c = ch * 8;
            float g[8], v[8];
            { const f32x4 b0 = *(const f32x4*)(cb + c), b1 = *(const f32x4*)(cb + c + 4), b2 = *(const f32x4*)(cb + DFF + c), b3 = *(const f32x4*)(cb + DFF + c + 4);
#pragma unroll
              for (int i = 0; i < 4; ++i) { g[i] = b0[i]; g[4 + i] = b1[i]; v[i] = b2[i]; v[4 + i] = b3[i]; } }
#pragma unroll
            for (int k = 0; k < 3; ++k) { if (t - 2 + k >= 0) {
                const bf16_t* ur = U + (size_t)(m - 2 + k) * 5632;
                const u32x4 ug = *(const u32x4*)(ur + c), uv = *(const u32x4*)(ur + DFF + c);
                const float* wk = cw + k * 5632;
                const f32x4 w0 = *(const f32x4*)(wk + c), w1 = *(const f32x4*)(wk + c + 4), w2 = *(const f32x4*)(wk + DFF + c), w3 = *(const f32x4*)(wk + DFF + c + 4);
                g[0] += w0[0] * bflo(ug.x); g[1] += w0[1] * bfhi(ug.x); g[2] += w0[2] * bflo(ug.y); g[3] += w0[3] * bfhi(ug.y);
                g[4] += w1[0] * bflo(ug.z); g[5] += w1[1] * bfhi(ug.z); g[6] += w1[2] * bflo(ug.w); g[7] += w1[3] * bfhi(ug.w);
                v[0] += w2[0] * bflo(uv.x); v[1] += w2[1] * bfhi(uv.x); v[2] += w2[2] * bflo(uv.y); v[3] += w2[3] * bfhi(uv.y);
                v[4] += w3[0] * bflo(uv.z); v[5] += w3[1] * bfhi(uv.z); v[6] += w3[2] * bflo(uv.w); v[7] += w3[3] * bfhi(uv.w); } }
            u32x4 o; o.x = cvt_pk_bf16(silu_f(g[0]) * v[0], silu_f(g[1]) * v[1]); o.y = cvt_pk_bf16(silu_f(g[2]) * v[2], silu_f(g[3]) * v[3]);
            o.z = cvt_pk_bf16(silu_f(g[4]) * v[4], silu_f(g[5]) * v[5]); o.w = cvt_pk_bf16(silu_f(g[6]) * v[6], silu_f(g[7]) * v[7]);
            *(u32x4*)(ACT + (size_t)m * DFF + c) = o;
        }
    }
}

__device__ __forceinline__ void pass_final(const P& p, int gw, int NGW, int lane_unused) {
    const int lane = fresh_tid() & 63;
    const float* rss = (const float*)(p.ws + WS_RSP);
    for (int m = gw; m < M; m += NGW) {
        const float rs = rsqrtf(rss16(rss, m) * (1.f / 1024.f) + EPS);
        f32x4* xr = (f32x4*)(p.out + (size_t)m * 1024) + lane; const f32x4* g = (const f32x4*)p.final_norm + lane;
#pragma unroll
        for (int j = 0; j < 4; ++j) { f32x4 v = xr[64 * j]; v = v * rs * g[64 * j]; xr[64 * j] = v; }
    }
}

typedef short v4i16_t __attribute__((ext_vector_type(4)));
__device__ __forceinline__ s16x4 vtr(const LAS unsigned char* p) { return __builtin_bit_cast(s16x4, __builtin_amdgcn_ds_read_tr16_b64_v4i16((LAS v4i16_t*)p)); }
__device__ __forceinline__ bf16x8 join8(s16x4 lo, s16x4 hi) { return (bf16x8){lo[0], lo[1], lo[2], lo[3], hi[0], hi[1], hi[2], hi[3]}; }
__device__ __forceinline__ bf16x8 pack8(const f32x16& s, int b) {
    u32x4 w; w.x = cvt_pk_bf16(s[b], s[b + 1]); w.y = cvt_pk_bf16(s[b + 2], s[b + 3]); w.z = cvt_pk_bf16(s[b + 4], s[b + 5]); w.w = cvt_pk_bf16(s[b + 6], s[b + 7]);
    return __builtin_bit_cast(bf16x8, w);
}

template <int DQK, int DV, bool CAUSAL, bool K2>
__device__ __forceinline__ void attn_unit(LAS unsigned char* lds, const bf16_t* Q, int qpitch, const bf16_t* K, int kpitch, const bf16_t* Kp2, int k2pitch,
                                          const bf16_t* V, int vpitch, bf16_t* O, int opitch, int q0, int NT) {
    constexpr int KP = (DQK + 8) * 2, VP = (DV == 64) ? 192 : 320;
    constexpr int KBUF = 64 * KP, VBUF = 64 * VP, BUF = KBUF + VBUF;
    constexpr int KCH = DQK / 8, VCH = DV / 8, NKC = 64 * KCH, NVC = 64 * VCH;
    constexpr int NKR = (NKC + 511) / 512, NVR = NVC / 512;
    const int tid = fresh_tid(), lane = tid & 63, w = __builtin_amdgcn_readfirstlane(tid >> 6), ql = lane & 31, hi = lane >> 5;
    u32x4 kreg[NKR], vreg[NVR];
    auto gload = [&](int t) {
#pragma unroll
        for (int i = 0; i < NKR; ++i) { const int id = tid + 512 * i;
            if (id < NKC) { const int row = id / KCH, c = id % KCH; const size_t kv = (size_t)(64 * t + row);
                if (K2 && c >= (DQK - 32) / 8) kreg[i] = *(const u32x4*)(Kp2 + kv * k2pitch + (c - (DQK - 32) / 8) * 8);
                else kreg[i] = *(const u32x4*)(K + kv * kpitch + c * 8); } }
#pragma unroll
        for (int i = 0; i < NVR; ++i) { const int id = tid + 512 * i; const int row = id / VCH, c = id % VCH;
            vreg[i] = *(const u32x4*)(V + (size_t)(64 * t + row) * vpitch + c * 8); }
    };
    auto lstore = [&](int b) {
        LAS unsigned char* kb = lds + b * BUF; LAS unsigned char* vb = kb + KBUF;
#pragma unroll
        for (int i = 0; i < NKR; ++i) { const int id = tid + 512 * i; if (id < NKC) { const int row = id / KCH, c = id % KCH; *(LAS u32x4*)(kb + row * KP + c * 16) = kreg[i]; } }
#pragma unroll
        for (int i = 0; i < NVR; ++i) { const int id = tid + 512 * i; const int row = id / VCH, c = id % VCH; *(LAS u32x4*)(vb + row * VP + c * 16) = vreg[i]; }
    };
    gload(0);
    bf16x8 qf[DQK / 16];
#pragma unroll
    for (int d0 = 0; d0 < DQK / 16; ++d0) qf[d0] = *(const bf16x8*)(Q + (size_t)(32 * w + ql) * qpitch + 16 * d0 + 8 * hi);
    f32x16 oacc[DV / 32];
#pragma unroll
    for (int i = 0; i < DV / 32; ++i)
#pragma unroll
        for (int r = 0; r < 16; ++r) oacc[i][r] = 0.f;
    float m_run = -INFINITY, l_run = 0.f;
    const int q0w = q0 + 32 * w, qg = q0w + ql;
    lstore(0);
    __syncthreads();
    const int vtoff = (4 * hi + ((lane & 15) >> 2)) * VP + (16 * ((lane >> 4) & 1) + 4 * (lane & 3)) * 2;
    for (int t = 0; t < NT; ++t) {
        if (t + 1 < NT) gload(t + 1);
        const bool active = !CAUSAL || (64 * t <= q0w + 31);
        if (active) {
            const LAS unsigned char* kb = lds + (t & 1) * BUF; const LAS unsigned char* vb = kb + KBUF;
            f32x16 s0, s1;
#pragma unroll
            for (int r = 0; r < 16; ++r) { s0[r] = 0.f; s1[r] = 0.f; }
#pragma unroll
            for (int d0 = 0; d0 < DQK / 16; ++d0) {
                const bf16x8 a0 = *(const LAS bf16x8*)(kb + ql * KP + (16 * d0 + 8 * hi) * 2);
                const bf16x8 a1 = *(const LAS bf16x8*)(kb + (32 + ql) * KP + (16 * d0 + 8 * hi) * 2);
                s0 = __builtin_amdgcn_mfma_f32_32x32x16_bf16(a0, qf[d0], s0, 0, 0, 0);
                s1 = __builtin_amdgcn_mfma_f32_32x32x16_bf16(a1, qf[d0], s1, 0, 0, 0);
            }
            if (CAUSAL && (64 * t + 63 > q0w)) {
#pragma unroll
                for (int r = 0; r < 16; ++r) { const int kv = 64 * t + crow(r, hi); if (kv > qg) s0[r] = -INFINITY; if (kv + 32 > qg) s1[r] = -INFINITY; }
            }
            float mx = s0[0];
#pragma unroll
            for (int r = 1; r < 16; ++r) mx = fmaxf(mx, s0[r]);
#pragma unroll
            for (int r = 0; r < 16; ++r) mx = fmaxf(mx, s1[r]);
            mx = fmaxf(mx, __shfl_xor(mx, 32));
            const float m_new = fmaxf(m_run, mx);
            const float alpha = __builtin_amdgcn_exp2f(m_run - m_new);
            m_run = m_new;
            float ps = 0.f;
#pragma unroll
            for (int r = 0; r < 16; ++r) { s0[r] = __builtin_amdgcn_exp2f(s0[r] - m_new); s1[r] = __builtin_amdgcn_exp2f(s1[r] - m_new); ps += s0[r] + s1[r]; }
            l_run = l_run * alpha + ps;
#pragma unroll
            for (int i = 0; i < DV / 32; ++i)
#pragma unroll
                for (int r = 0; r < 16; ++r) oacc[i][r] *= alpha;
            const bf16x8 p00 = pack8(s0, 0), p01 = pack8(s0, 8), p10 = pack8(s1, 0), p11 = pack8(s1, 8);
#pragma unroll
            for (int i = 0; i < DV / 32; ++i) {
                const LAS unsigned char* vp = vb + vtoff + i * 64;
                { const bf16x8 a = join8(vtr(vp + (0) * VP), vtr(vp + (8) * VP)); oacc[i] = __builtin_amdgcn_mfma_f32_32x32x16_bf16(a, p00, oacc[i], 0, 0, 0); }
                { const bf16x8 a = join8(vtr(vp + (16) * VP), vtr(vp + (24) * VP)); oacc[i] = __builtin_amdgcn_mfma_f32_32x32x16_bf16(a, p01, oacc[i], 0, 0, 0); }
                { const bf16x8 a = join8(vtr(vp + (32) * VP), vtr(vp + (40) * VP)); oacc[i] = __builtin_amdgcn_mfma_f32_32x32x16_bf16(a, p10, oacc[i], 0, 0, 0); }
                { const bf16x8 a = join8(vtr(vp + (48) * VP), vtr(vp + (56) * VP)); oacc[i] = __builtin_amdgcn_mfma_f32_32x32x16_bf16(a, p11, oacc[i], 0, 0, 0); }
            }
        }
        if (t + 1 < NT) lstore((t + 1) & 1);
        __syncthreads();
    }
    const float lt = l_run + __shfl_xor(l_run, 32); const float inv = 1.f / lt;
    bf16_t* orow = O + (size_t)(32 * w + ql) * opitch;
#pragma unroll
    for (int i = 0; i < DV / 32; ++i)
#pragma unroll
        for (int rr = 0; rr < 4; ++rr) { u32x2 o; o.x = cvt_pk_bf16(oacc[i][4 * rr] * inv, oacc[i][4 * rr + 1] * inv); o.y = cvt_pk_bf16(oacc[i][4 * rr + 2] * inv, oacc[i][4 * rr + 3] * inv);
            *(u32x2*)(orow + 32 * i + 8 * rr + 4 * hi) = o; }
}

constexpr int SS_BP = 272, SS_XP = 192;
constexpr int SS_B = 0, SS_C = 34816, SS_XD = 69632, SS_XDD = 94208, SS_SB = 118784, SS_CS = 136192, SS_DT = 136704;
__device__ __forceinline__ void ssd_unit(const P& p, int L, LAS unsigned char* lds, int b, int h) {
    unsigned char* ws = p.ws; asm volatile("" : "+s"(ws));
    const bf16_t* XBC = (const bf16_t*)(ws + WS_XBC); const bf16_t* Z = (const bf16_t*)(ws + WS_Z); const float* DT = (const float*)(ws + WS_DT); bf16_t* YC = (bf16_t*)(ws + WS_YC);
    const int tid = fresh_tid(), lane = tid & 63, w = __builtin_amdgcn_readfirstlane(tid >> 6), ql = lane & 31, hi = lane >> 5;
    const int g = h >> 2;
    const float Ah = -__expf(p.a_log[L * 16 + h]); const float dsk = p.d_skip[L * 16 + h];
    const int lb = w >> 1, pb = w & 1;
    LAS float* CS = (LAS float*)(lds + SS_CS); LAS float* DTS = (LAS float*)(lds + SS_DT);
    f32x16 sacc;
#pragma unroll
    for (int r = 0; r < 16; ++r) sacc[r] = 0.f;
    for (int i = tid; i < 64 * SS_BP / 4; i += 512) ((LAS unsigned*)(lds + SS_SB))[i] = 0u;
    u32x4 breg[4], creg[4], xreg[2]; float dreg[2] = {0.f, 0.f};
    auto gload = [&](int c) {
        const size_t m0 = (size_t)b * SEQ + (size_t)c * 128;
#pragma unroll
        for (int i = 0; i < 4; ++i) { const int id = tid + 512 * i, row = id >> 4, c16 = id & 15;
            breg[i] = *(const u32x4*)(XBC + (m0 + row) * 2048 + 1024 + g * 128 + 8 * c16);
            creg[i] = *(const u32x4*)(XBC + (m0 + row) * 2048 + 1536 + g * 128 + 8 * c16); }
#pragma unroll
        for (int i = 0; i < 2; ++i) { const int id = tid + 512 * i, row = id >> 3, c8 = id & 7; xreg[i] = *(const u32x4*)(XBC + (m0 + row) * 2048 + h * 64 + 8 * c8); }
        if (w == 0) { dreg[0] = DT[(m0 + 2 * lane) * 16 + h]; dreg[1] = DT[(m0 + 2 * lane + 1) * 16 + h]; }
    };
    gload(0);
    const int troff = (((lane & 15) >> 2)) ;
    const int tcol = 16 * ((lane >> 4) & 1) + 4 * (lane & 3);
    for (int c = 0; c < 16; ++c) {
        const size_t m0 = (size_t)b * SEQ + (size_t)c * 128;
        if (w == 0) {
            const float v0 = dreg[0] * Ah, v1 = dreg[1] * Ah; float s = v0 + v1;
#pragma unroll
            for (int o = 1; o < 64; o <<= 1) { const float t = __shfl_up(s, o); if (lane >= o) s += t; }
            CS[2 * lane] = s - v1; CS[2 * lane + 1] = s; DTS[2 * lane] = dreg[0]; DTS[2 * lane + 1] = dreg[1];
        }
#pragma unroll
        for (int i = 0; i < 4; ++i) { const int id = tid + 512 * i, row = id >> 4, c16 = id & 15;
            *(LAS u32x4*)(lds + SS_B + row * SS_BP + c16 * 16) = breg[i]; *(LAS u32x4*)(lds + SS_C + row * SS_BP + c16 * 16) = creg[i]; }
        __syncthreads();
        { const float cend = CS[127];
#pragma unroll
          for (int i = 0; i < 2; ++i) { const int id = tid + 512 * i, row = id >> 3, c8 = id & 7; const float d = DTS[row], e = d * __expf(cend - CS[row]);
              const u32x4 v = xreg[i]; u32x4 o1, o2;
              o1.x = cvt_pk_bf16(bflo(v.x) * d, bfhi(v.x) * d); o1.y = cvt_pk_bf16(bflo(v.y) * d, bfhi(v.y) * d); o1.z = cvt_pk_bf16(bflo(v.z) * d, bfhi(v.z) * d); o1.w = cvt_pk_bf16(bflo(v.w) * d, bfhi(v.w) * d);
              o2.x = cvt_pk_bf16(bflo(v.x) * e, bfhi(v.x) * e); o2.y = cvt_pk_bf16(bflo(v.y) * e, bfhi(v.y) * e); o2.z = cvt_pk_bf16(bflo(v.z) * e, bfhi(v.z) * e); o2.w = cvt_pk_bf16(bflo(v.w) * e, bfhi(v.w) * e);
              *(LAS u32x4*)(lds + SS_XD + row * SS_XP + c8 * 16) = o1; *(LAS u32x4*)(lds + SS_XDD + row * SS_XP + c8 * 16) = o2; } }
        __syncthreads();
        if (c + 1 < 16) gload(c + 1);
        f32x16 yacc, oac;
#pragma unroll
        for (int r = 0; r < 16; ++r) { yacc[r] = 0.f; oac[r] = 0.f; }
        const float cs_l = CS[32 * lb + ql];
        for (int sb = 0; sb <= lb; ++sb) {
            f32x16 gt;
#pragma unroll
            for (int r = 0; r < 16; ++r) gt[r] = 0.f;
#pragma unroll
            for (int ks = 0; ks < 8; ++ks) {
                const bf16x8 a = *(const LAS bf16x8*)(lds + SS_B + (32 * sb + ql) * SS_BP + (16 * ks + 8 * hi) * 2);
                const bf16x8 bb = *(const LAS bf16x8*)(lds + SS_C + (32 * lb + ql) * SS_BP + (16 * ks + 8 * hi) * 2);
                gt = __builtin_amdgcn_mfma_f32_32x32x16_bf16(a, bb, gt, 0, 0, 0);
            }
            const int lg = 32 * lb + ql;
#pragma unroll
            for (int r = 0; r < 16; ++r) { const int s = 32 * sb + crow(r, hi); const float e = __expf(cs_l - CS[s]); gt[r] = (s <= lg) ? gt[r] * e : 0.f; }
            const bf16x8 w0 = pack8(gt, 0), w1 = pack8(gt, 8);
            const LAS unsigned char* xp = lds + SS_XD + (32 * sb + 4 * hi + troff) * SS_XP + (32 * pb + tcol) * 2;
            { const bf16x8 bx = join8(vtr(xp), vtr(xp + 8 * SS_XP)); yacc = __builtin_amdgcn_mfma_f32_32x32x16_bf16(w0, bx, yacc, 0, 0, 0); }
            { const bf16x8 bx = join8(vtr(xp + 16 * SS_XP), vtr(xp + 24 * SS_XP)); yacc = __builtin_amdgcn_mfma_f32_32x32x16_bf16(w1, bx, yacc, 0, 0, 0); }
        }
#pragma unroll
        for (int ks = 0; ks < 8; ++ks) {
            const bf16x8 a = *(const LAS bf16x8*)(lds + SS_C + (32 * lb + ql) * SS_BP + (16 * ks + 8 * hi) * 2);
            const bf16x8 bb = *(const LAS bf16x8*)(lds + SS_SB + (32 * pb + ql) * SS_BP + (16 * ks + 8 * hi) * 2);
            oac = __builtin_amdgcn_mfma_f32_32x32x16_bf16(a, bb, oac, 0, 0, 0);
        }
#pragma unroll
        for (int r = 0; r < 16; ++r) { const int l = 32 * lb + crow(r, hi); const size_t m = m0 + l; const int col = h * 64 + 32 * pb + ql;
            const float xv = bf1(XBC[m * 2048 + col]); const float zv = bf1(Z[m * 1024 + col]);
            const float y = yacc[r] + oac[r] * __expf(CS[l]) + xv * dsk;
            YC[m * 2048 + col] = tobf(y * silu_f(zv)); }
        { const float dec = __expf(CS[127]);
#pragma unroll
          for (int r = 0; r < 16; ++r) sacc[r] *= dec;
#pragma unroll
          for (int st = 0; st < 8; ++st) {
              const LAS unsigned char* ap = lds + SS_XDD + (16 * st + 8 * hi + troff) * SS_XP + (32 * pb + tcol) * 2;
              const LAS unsigned char* bp = lds + SS_B + (16 * st + 8 * hi + troff) * SS_BP + (32 * lb + tcol) * 2;
              const bf16x8 a = join8(vtr(ap), vtr(ap + 4 * SS_XP)); const bf16x8 bb = join8(vtr(bp), vtr(bp + 4 * SS_BP));
              sacc = __builtin_amdgcn_mfma_f32_32x32x16_bf16(a, bb, sacc, 0, 0, 0);
          } }
        __syncthreads();
#pragma unroll
        for (int r = 0; r < 16; ++r) *(LAS bf16_t*)(lds + SS_SB + (32 * pb + crow(r, hi)) * SS_BP + (32 * lb + ql) * 2) = tobf(sacc[r]);
    }
    __syncthreads();
}

__device__ __forceinline__ void my_grid_sync(unsigned* bar, unsigned& gen) {
    asm volatile("s_waitcnt vmcnt(0) lgkmcnt(0)" ::: "memory");
    __syncthreads();
    gen += 1u;
    if (threadIdx.x == 0) {
        __builtin_amdgcn_fence(__ATOMIC_RELEASE, "agent");
        asm volatile("s_waitcnt vmcnt(0)" ::: "memory");
        __hip_atomic_fetch_add(bar, 1u, __ATOMIC_RELAXED, __HIP_MEMORY_SCOPE_AGENT);
        const unsigned target = gen * gridDim.x;
        while (__hip_atomic_load(bar, __ATOMIC_RELAXED, __HIP_MEMORY_SCOPE_AGENT) < target) __builtin_amdgcn_s_sleep(1);
        __builtin_amdgcn_fence(__ATOMIC_ACQUIRE, "agent");
        asm volatile("s_waitcnt vmcnt(0)" ::: "memory");
    }
    __syncthreads();
    asm volatile("buffer_inv sc1\n\ts_waitcnt vmcnt(0)" ::: "memory");
}
#define GRID_SYNC() do { my_grid_sync((unsigned*)(p.ws + WS_RSS), bar_gen); ws = p.ws; asm volatile("" : "+s"(ws)); RSS = (float*)(ws + WS_RSP); XB = (bf16_t*)(ws + WS_XB); } while (0)
__global__ void __launch_bounds__(512, 2) trunk_fwd(P p) {
    extern __shared__ __attribute__((aligned(16))) unsigned char lds_raw[];
    cg::grid_group grid = cg::this_grid();
    LAS unsigned char* lds = (LAS unsigned char*)lds_raw;
    const int tid = threadIdx.x, lane = tid & 63, wave = __builtin_amdgcn_readfirstlane(tid >> 6);
    const int G = gridDim.x, gw = blockIdx.x * 8 + wave, NGW = G * 8;
    LAS float* scr = (LAS float*)(lds + wave * 16384);
    unsigned char* ws = p.ws; asm volatile("" : "+s"(ws));
    float* RSS = (float*)(ws + WS_RSP);
    bf16_t* XB = (bf16_t*)(ws + WS_XB);

    unsigned bar_gen = 0u;
    grid.sync();
#ifndef SKIP_PRO
    prologue(p, scr, gw, NGW, lane);
#endif
    GRID_SYNC();
    { EpiRoute E{(bf16_t*)(ws + WS_KMVM), nullptr, nullptr, 8192, 0, 0, 1 << 30, 1 << 30, nullptr, 0.f, 1.f};
      run_gemm(lds, (const bf16_t*)(ws + WS_MEMN), (const bf16_t*)(ws + WS_WMKV), 2048, 8192, 1024, E); }

    for (int L = 0; L < DEPTH; ++L) {
        { EpiRoute E{(bf16_t*)(ws + WS_Z), (bf16_t*)(ws + WS_XBCPRE), (bf16_t*)(ws + WS_SM), 1024, 2048, 768, 4, 12, RSS, 1.f / 1024.f, 1.f};
          run_gemm(lds, XB, (const bf16_t*)(ws + WS_WIN), M, NIN, 1024, E); }
        GRID_SYNC();
#ifndef SKIP_L2
        pass_l2(p, L, gw, NGW, lane);
#endif
        GRID_SYNC();
#if defined(DBG_STOP) && DBG_STOP == 1
        { for (size_t i = (size_t)blockIdx.x * 512 + threadIdx.x; i < (size_t)M * 1024; i += (size_t)G * 512) { const size_t mm = i >> 10; const int cc = (int)(i & 1023); p.out[i] = bf1(((const bf16_t*)(ws + WS_XBC))[mm * 2048 + cc]) + bf1(((const bf16_t*)(ws + WS_XBC))[mm * 2048 + 1024 + cc]) + bf1(((const bf16_t*)(ws + WS_CQN))[mm * 384 + cc % 384]) + bf1(((const bf16_t*)(ws + WS_CKVN))[mm * 256 + cc % 256]) + bf1(((const bf16_t*)(ws + WS_KPE))[mm * 32 + cc % 32]) + ((const float*)(ws + WS_DT))[mm * 16 + cc % 16] + bf1(((const bf16_t*)(ws + WS_Z))[mm * 1024 + cc]); } return; }
#endif

#ifndef SKIP_SSD
        for (int u = blockIdx.x; u < NB * 16; u += G) ssd_unit(p, L, lds, u >> 4, u & 15);
#endif
        GRID_SYNC();
#if defined(DBG_STOP) && DBG_STOP == 2
        { for (size_t i = (size_t)blockIdx.x * 512 + threadIdx.x; i < (size_t)M * 1024; i += (size_t)G * 512) { const size_t mm = i >> 10; const int cc = (int)(i & 1023); p.out[i] = bf1(((const bf16_t*)(ws + WS_YC))[mm * 2048 + cc]); } return; }
#endif

        { EpiRope E{(bf16_t*)(ws + WS_QB), (const float*)(ws + WS_COS), (const float*)(ws + WS_SIN), 0.10206207261596575f * LOG2E};
          run_gemm(lds, (const bf16_t*)(ws + WS_CQN), (const bf16_t*)(ws + WS_WUQ), M, 1536, 384, E); }
        { EpiRoute E{(bf16_t*)(ws + WS_KN), (bf16_t*)(ws + WS_VB), nullptr, 1024, 1024, 0, 4, 1 << 30, nullptr, 0.f, 1.f};
          run_gemm(lds, (const bf16_t*)(ws + WS_CKVN), (const bf16_t*)(ws + WS_WUKV), M, 2048, 256, E); }
        GRID_SYNC();
#ifndef SKIP_MLA
        { const int v = blockIdx.x;
          for (int uu = v; uu < 256; uu += G) { const int bh = uu >> 1, half = uu & 1, b = bh >> 4, h = bh & 15;
            for (int i = 0; i < 4; ++i) { const int qb = half ? ((i == 0) ? 1 : (i == 1) ? 6 : (i == 2) ? 2 : 5) : ((i == 0) ? 0 : (i == 1) ? 7 : (i == 2) ? 3 : 4);
                const size_t r0 = (size_t)b * SEQ;
                attn_unit<96, 64, true, true>(lds, (const bf16_t*)(ws + WS_QB) + (r0 + 256 * qb) * 1536 + 96 * h, 1536, (const bf16_t*)(ws + WS_KN) + r0 * 1024 + 64 * h, 1024,
                                              (const bf16_t*)(ws + WS_KPE) + r0 * 32, 32, (const bf16_t*)(ws + WS_VB) + r0 * 1024 + 64 * h, 1024,
                                              (bf16_t*)(ws + WS_YC) + (r0 + 256 * qb) * 2048 + 1024 + 64 * h, 2048, 256 * qb, 4 * (qb + 1)); } } }
#endif
        GRID_SYNC();
#if defined(DBG_STOP) && DBG_STOP == 3
        { for (size_t i = (size_t)blockIdx.x * 512 + threadIdx.x; i < (size_t)M * 1024; i += (size_t)G * 512) { const size_t mm = i >> 10; const int cc = (int)(i & 1023); p.out[i] = bf1(((const bf16_t*)(ws + WS_YC))[mm * 2048 + 1024 + cc]); } return; }
#endif

#ifndef SKIP_YCN
        pass_ycnorm(p, gw, NGW, lane);
#endif
        GRID_SYNC();
        { EpiRes E{L == 0 ? p.x : p.out, p.out, XB, RSS + (size_t)16 * M};
          run_gemm(lds, (const bf16_t*)(ws + WS_YC), (const bf16_t*)(ws + WS_WOUT), M, 1024, 2048, E); }
        GRID_SYNC();
#if defined(DBG_STOP) && DBG_STOP == 4
        return;
#endif

#if defined(DBG_STOP) && DBG_STOP == 9
        { for (size_t i = (size_t)blockIdx.x * 512 + threadIdx.x; i < (size_t)M * 1024; i += (size_t)G * 512) { const size_t mm = i >> 10; const int cc = (int)(i & 1023); p.out[i] = bf1(XB[mm * 1024 + cc]); } return; }
#endif

#if defined(DBG_STOP) && DBG_STOP == 10
        { for (size_t i = (size_t)blockIdx.x * 512 + threadIdx.x; i < (size_t)M * 1024; i += (size_t)G * 512) { const size_t mm = i >> 10; const int cc = (int)(i & 1023); p.out[i] = (RSS + (size_t)16 * M)[(size_t)(cc & 3) * M * 4 + mm * 4 + ((cc >> 2) & 3)]; } return; }
#endif

        { EpiRoute E{(bf16_t*)(ws + WS_QM), nullptr, nullptr, 1024, 0, 0, 1 << 30, 1 << 30, RSS + (size_t)16 * M, 1.f / 1024.f, 0.0625f * LOG2E};
          run_gemm(lds, XB, (const bf16_t*)(ws + WS_WMQ), M, 1024, 1024, E); }
        GRID_SYNC();
#if defined(DBG_STOP) && DBG_STOP == 7
        { for (size_t i = (size_t)blockIdx.x * 512 + threadIdx.x; i < (size_t)M * 1024; i += (size_t)G * 512) { const size_t mm = i >> 10; const int cc = (int)(i & 1023); p.out[i] = bf1(((const bf16_t*)(ws + WS_QM))[mm * 1024 + cc]); } return; }
#endif

#ifndef SKIP_MEM
        for (int uu = blockIdx.x; uu < 512; uu += G) { const int dh = uu & 1, qb = (uu >> 1) & 7, mh = (uu >> 4) & 3, b = uu >> 6;
            const bf16_t* KM = (const bf16_t*)(ws + WS_KMVM) + (size_t)(b * 256) * 8192 + L * 2048 + 256 * mh;
            attn_unit<256, 128, false, false>(lds, (const bf16_t*)(ws + WS_QM) + ((size_t)b * SEQ + 256 * qb) * 1024 + 256 * mh, 1024, KM, 8192, nullptr, 0,
                                              KM + 1024 + 128 * dh, 8192, (bf16_t*)(ws + WS_OM) + ((size_t)b * SEQ + 256 * qb) * 1024 + 256 * mh + 128 * dh, 1024, 0, 4); }
#endif
        GRID_SYNC();
#if defined(DBG_STOP) && DBG_STOP == 8
        { for (size_t i = (size_t)blockIdx.x * 512 + threadIdx.x; i < (size_t)M * 1024; i += (size_t)G * 512) { const size_t mm = i >> 10; const int cc = (int)(i & 1023); p.out[i] = bf1(((const bf16_t*)(ws + WS_OM))[mm * 1024 + cc]); } return; }
#endif

        { EpiRes E{p.out, p.out, XB, RSS + (size_t)32 * M};
          run_gemm(lds, (const bf16_t*)(ws + WS_OM), (const bf16_t*)(ws + WS_WMO), M, 1024, 1024, E); }
        GRID_SYNC();
#if defined(DBG_STOP) && DBG_STOP == 5
        return;
#endif

        for (int half = 0; half < 2; ++half) {
            { EpiRoute E{(bf16_t*)(ws + WS_U), nullptr, nullptr, 5632, 0, 0, 1 << 30, 1 << 30, RSS + (size_t)32 * M + (size_t)half * 8192 * 4, 1.f / 1024.f, 1.f};
              run_gemm(lds, XB + (size_t)half * 8192 * 1024, (const bf16_t*)(ws + WS_WUP), 8192, 5632, 1024, E); }
            GRID_SYNC();
#ifndef SKIP_FFN
            pass_ffnact(p, L, half, gw, NGW, lane);
#endif
#ifndef SKIP_PRO
            if (half == 1 && L + 1 < DEPTH) convert_layer(p, L + 1, scr, gw, NGW, lane);
#endif
            GRID_SYNC();
        }
        { EpiRes E{p.out, p.out, XB, RSS};
          run_gemm(lds, (const bf16_t*)(ws + WS_ACT), (const bf16_t*)(ws + ((L & 1) ? WS_WDN1 : WS_WDN0)), M, 1024, 2816, E); }
        GRID_SYNC();
#if defined(DBG_STOP) && DBG_STOP == 6
        return;
#endif

    }
#ifndef SKIP_FIN
    pass_final(p, gw, NGW, lane);
#endif
}

extern "C" void kernel_launch(void* const* d_in, const int* in_sizes, int n_in, void* d_out, int out_size, void* d_ws, size_t ws_size, hipStream_t stream) {
    static int grid = 0;
    if (grid == 0) {
        if (n_in != 29 || out_size != M * DM || ws_size < WS_END) { fprintf(stderr, "kernel_launch: unexpected shapes (n_in %d out %d ws %zu need %zu)\n", n_in, out_size, ws_size, (size_t)WS_END); grid = -1; return; }
        int dev = 0, cus = 0, per_cu = 0;
        hipGetDevice(&dev);
        hipDeviceGetAttribute(&cus, hipDeviceAttributeMultiprocessorCount, dev);
        hipFuncSetAttribute((const void*)trunk_fwd, hipFuncAttributeMaxDynamicSharedMemorySize, LDS_BYTES);
        hipOccupancyMaxActiveBlocksPerMultiprocessor(&per_cu, (const void*)trunk_fwd, 512, LDS_BYTES);
        if (per_cu < 1) fprintf(stderr, "kernel_launch: occupancy query reports %d\n", per_cu);
        (void)hipGetLastError();
        grid = cus;
    }
    if (grid < 0) return;
    (void)hipMemsetAsync((char*)d_ws + WS_RSS, 0, 256, stream);
    P a{};
    const void** pp = (const void**)&a;
    for (int i = 0; i < 29; ++i) pp[i] = d_in[i];
    a.out = (float*)d_out; a.ws = (unsigned char*)d_ws;
    void* args[] = {&a};
    hipError_t e = hipLaunchCooperativeKernel((const void*)trunk_fwd, dim3(grid), dim3(512), args, LDS_BYTES, stream);
    if (e != hipSuccess) fprintf(stderr, "cooperative launch failed: %s (grid %d)\n", hipGetErrorString(e), grid);
}
```

```cpp
#include <hip/hip_runtime.h>
#include <cstdio>
#include <cstdint>
namespace pg8 {
#define PG8_LAS __attribute__((address_space(3)))
typedef unsigned short bf16_t;
typedef short bf16x8 __attribute__((ext_vector_type(8)));
typedef float f32x4 __attribute__((ext_vector_type(4)));
typedef unsigned u32x4 __attribute__((ext_vector_type(4)));
constexpr int BM = 256, BK = 64, HALF = 128, HTB = HALF * BK * 2  , STAGE_BYTES = 8 * HTB, NXCD = 8, WGM = 8;

__host__ __device__ __forceinline__ int lds_byte(int r, int c) { const int st = (r >> 4) * 2 + (c >> 5), rr = r & 15, cc = c & 31, ob = rr * 64 + cc * 2; return st * 1024 + (ob ^ (((ob >> 9) & 1) << 5)); }
__host__ __device__ __forceinline__ void stage_rc(int b, int& R, int& C) { const int st = b / 1024, sb = b % 1024, swz = sb ^ (((sb >> 9) & 1) << 5); R = (st >> 1) * 16 + swz / 64; C = (st & 1) * 32 + (swz % 64) / 2; }
__host__ __device__ __forceinline__ int perm32(int rho) { const int n = rho >> 4, i = rho & 15; return 8 * (i >> 2) + 4 * n + (i & 3); }

struct Unit { int pm, pn; };
struct Gemm { const bf16_t* A; const bf16_t* Bt; int M, N, K; };

struct StaticOrder {
    int nM, nN, nwg, G, c;
    __host__ __device__ void init(int M, int N, int G_, int c_) { nM = M / BM; nN = N / BM; nwg = nM * nN; G = G_; c = c_; }
    __host__ __device__ bool next(int i, Unit& u) const {
        const long L = (long)i * G + c; if (L >= nwg) return false;
        int wgid = (int)L; { const int q = nwg / NXCD, r = nwg % NXCD, xcd = wgid % NXCD, off = wgid / NXCD; wgid = (xcd < r ? xcd * (q + 1) : r * (q + 1) + (xcd - r) * q) + off; }
        const int nig = WGM * nN, gid = wgid / nig, fm = gid * WGM, gsz = (nM - fm) < WGM ? (nM - fm) : WGM;
        u.pm = fm + ((wgid % nig) % gsz); u.pn = (wgid % nig) / gsz; return true;
    }
    __device__ __forceinline__ void a_ready(const Unit&) const {}
    __device__ __forceinline__ void done(const Unit&) const {}
};

__device__ __forceinline__ unsigned cvt_pk_bf16(float lo, float hi) { unsigned r; asm volatile("v_cvt_pk_bf16_f32 %0, %1, %2" : "=v"(r) : "v"(lo), "v"(hi)); return r; }
typedef float f32x2 __attribute__((ext_vector_type(2)));
__device__ __forceinline__ f32x2 gelu_pk(f32x2 v) {
    const f32x2 av = __builtin_elementwise_abs(v), d = av * 0.2316418882f + 1.0f;
    f32x2 t; t.x = __builtin_amdgcn_rcpf(d.x); t.y = __builtin_amdgcn_rcpf(d.y);
    f32x2 q = t * 0.5307027145f + (-0.7265760135f); q = q * t + 0.7107068705f; q = q * t + (-0.142248368f); q = q * t + 0.127414796f; q = q * t;
    const f32x2 s = (v * v) * (-0.72134752044f);
    f32x2 e; e.x = __builtin_amdgcn_exp2f(s.x); e.y = __builtin_amdgcn_exp2f(s.y);
    const f32x2 m = v * (q * e), r = v - m;
    f32x2 o; o.x = v.x < 0.f ? m.x : r.x; o.y = v.y < 0.f ? m.y : r.y; return o;
}

template <int ACT  > struct EpiBf16 {
    static constexpr bool PERM = true, AFTER_DRAIN = false; static_assert(ACT == 0 || ACT == 1, "EpiBf16: ACT is 0 (none) or 1 (gelu_pk)");
    bf16_t* O; int ldc; const float* bias; int split_cols; size_t split_stride; float scale0;
    __device__ __forceinline__ void operator()(const f32x4 (&acc)[2][2][4][2], const Unit& u, int wr, int wc, int fr, int fq) const {
        const int row0 = u.pm * BM + wr * 64 + fr; int colt = u.pn * BM; bf16_t* base = O;
        float sc = 1.f; if (split_cols) { const int t = colt / split_cols; base += (size_t)t * split_stride; colt -= t * split_cols; if (t == 0) sc = scale0; }
        const int col0 = colt + wc * 32 + 8 * fq, bcol0 = u.pn * BM + wc * 32 + 8 * fq;
        f32x4 bv[2][2];
#pragma unroll
        for (int bj = 0; bj < 2; ++bj)
#pragma unroll
            for (int n = 0; n < 2; ++n) bv[bj][n] = bias ? *(const f32x4*)(bias + bcol0 + bj * HALF + 4 * n) : (f32x4){0.f, 0.f, 0.f, 0.f};
#pragma unroll
        for (int ai = 0; ai < 2; ++ai)
#pragma unroll
            for (int m = 0; m < 4; ++m) { bf16_t* rowp = base + (size_t)(row0 + ai * HALF + m * 16) * ldc + col0;
#pragma unroll
                for (int bj = 0; bj < 2; ++bj) { f32x4 v0 = acc[ai][bj][m][0] + bv[bj][0], v1 = acc[ai][bj][m][1] + bv[bj][1];
                    if (ACT == 1) { f32x2 a = gelu_pk((f32x2){v0[0], v0[1]}), b = gelu_pk((f32x2){v0[2], v0[3]}), c = gelu_pk((f32x2){v1[0], v1[1]}), d = gelu_pk((f32x2){v1[2], v1[3]});
                        v0 = (f32x4){a.x, a.y, b.x, b.y}; v1 = (f32x4){c.x, c.y, d.x, d.y}; }
                    v0 = v0 * sc; v1 = v1 * sc; u32x4 w; w.x = cvt_pk_bf16(v0[0], v0[1]); w.y = cvt_pk_bf16(v0[2], v0[3]); w.z = cvt_pk_bf16(v1[0], v1[1]); w.w = cvt_pk_bf16(v1[2], v1[3]);
                    *(u32x4*)(rowp + bj * HALF) = w; } }
    }
};

struct PanelStats {
    unsigned* xbuf;
    unsigned* cnt;
    unsigned* tmo;
    int ntn; float eps;
    unsigned code;
    __device__ __forceinline__ bool run(const f32x4 (&v)[2][2][4][2], const Unit& u, int wr, int wc, int fr, int fq, PG8_LAS unsigned char* lds, int wid, int lane) const {
        typedef float f32x2v __attribute__((ext_vector_type(2)));
        PG8_LAS f32x2v* P = (PG8_LAS f32x2v*)lds;
        PG8_LAS f32x2v* S = (PG8_LAS f32x2v*)(lds + 8192);
        PG8_LAS unsigned* flag = (PG8_LAS unsigned*)(lds + 8192 + 2048);
#pragma unroll
        for (int ai = 0; ai < 2; ++ai)
#pragma unroll
            for (int m = 0; m < 4; ++m) {
                float s = 0.f;
#pragma unroll
                for (int bj = 0; bj < 2; ++bj)
#pragma unroll
                    for (int n = 0; n < 2; ++n) { const f32x4 x = v[ai][bj][m][n]; s += (x[0] + x[1]) + (x[2] + x[3]); }
                s += __shfl_xor(s, 16); s += __shfl_xor(s, 32);
                const float mw = s * (1.0f / 64.0f); float q = 0.f;
#pragma unroll
                for (int bj = 0; bj < 2; ++bj)
#pragma unroll
                    for (int n = 0; n < 2; ++n) { const f32x4 d = v[ai][bj][m][n] - mw; q += (d[0] * d[0] + d[1] * d[1]) + (d[2] * d[2] + d[3] * d[3]); }
                q += __shfl_xor(q, 16); q += __shfl_xor(q, 32);
                if (fq == 0) P[(ai * HALF + wr * 64 + m * 16 + fr) * 4 + wc] = (f32x2v){mw, q};
            }
        asm volatile("s_waitcnt lgkmcnt(0)" ::: "memory"); __builtin_amdgcn_s_barrier(); asm volatile("" ::: "memory");
#if defined(BROKEN_EXCHANGE_NO_WAIT)
#warning BROKEN CONTROL BUILD: the row-statistics exchange does not wait; results are wrong by design
        if (blockIdx.x >= 64) { const long long t0_ = clock64(); while (clock64() - t0_ < 60000) __builtin_amdgcn_s_sleep(8); }
#endif
        const int row = wid * 32 + (lane & 31);
        if (lane < 32) {
            const f32x2v a = P[row * 4 + 0], b = P[row * 4 + 1], c = P[row * 4 + 2], d = P[row * 4 + 3];
            const float mt = (a.x + b.x + c.x + d.x) * 0.25f;
            const float da = a.x - mt, db = b.x - mt, dc = c.x - mt, dd = d.x - mt;
            const float m2 = (a.y + b.y) + (c.y + d.y) + 64.0f * ((da * da + db * db) + (dc * dc + dd * dd));
            unsigned long long* slot = (unsigned long long*)xbuf + ((size_t)(u.pm * BM + row) * 4 + u.pn);
            __hip_atomic_store(slot, ((unsigned long long)__float_as_uint(m2) << 32) | __float_as_uint(mt), __ATOMIC_RELAXED, __HIP_MEMORY_SCOPE_AGENT);
        }
        asm volatile("s_waitcnt vmcnt(0)" ::: "memory");
        if (lane == 0) __hip_atomic_fetch_add(cnt + 64 * u.pm, 1u, __ATOMIC_RELAXED, __HIP_MEMORY_SCOPE_AGENT);
        if (wid == 0) {
            bool dead = false; const unsigned long long t0 = __builtin_amdgcn_s_memrealtime(); const unsigned want = 8u * (unsigned)ntn;
            for (;;) {
#if defined(BROKEN_EXCHANGE_NO_WAIT)
                break;
#endif
                if ((unsigned)__builtin_amdgcn_readfirstlane(__hip_atomic_load(cnt + 64 * u.pm, __ATOMIC_RELAXED, __HIP_MEMORY_SCOPE_AGENT)) >= want) break;
                if (__builtin_amdgcn_s_memrealtime() - t0 > 2000000ull) {
                    if (lane == 0) { unsigned expect = 0u; __hip_atomic_compare_exchange_strong(tmo + 1, &expect, code | (unsigned)(u.pm & 0xff), __ATOMIC_RELAXED, __ATOMIC_RELAXED, __HIP_MEMORY_SCOPE_AGENT);
                                     __hip_atomic_store(tmo, 1u, __ATOMIC_RELAXED, __HIP_MEMORY_SCOPE_AGENT); }
                    dead = true; break; }
                __builtin_amdgcn_s_sleep(2);
            }
            __builtin_amdgcn_fence(__ATOMIC_ACQUIRE, "agent");
            if (lane == 0) flag[0] = dead ? 1u : 0u;
        }
        asm volatile("s_waitcnt vmcnt(0) lgkmcnt(0)" ::: "memory"); __builtin_amdgcn_s_barrier(); asm volatile("" ::: "memory");
        const bool bad = flag[0] != 0u;
        if (lane < 32) {
            const unsigned long long* slot = (const unsigned long long*)xbuf + (size_t)(u.pm * BM + row) * 4; float mt[4], m2[4]; float ms = 0.f;
#pragma unroll
            for (int t = 0; t < 4; ++t) { if (t < ntn) { const unsigned long long w = __hip_atomic_load(slot + t, __ATOMIC_RELAXED, __HIP_MEMORY_SCOPE_AGENT); mt[t] = __uint_as_float((unsigned)w); m2[t] = __uint_as_float((unsigned)(w >> 32)); } else { mt[t] = 0.f; m2[t] = 0.f; } ms += mt[t]; }
            const float mean = ms / (float)ntn; float q = 0.f;
#pragma unroll
            for (int t = 0; t < 4; ++t) if (t < ntn) { const float dm = mt[t] - mean; q += m2[t] + 256.0f * dm * dm; }
            S[row] = (f32x2v){mean, 1.0f / sqrtf(q / (256.0f * (float)ntn) + eps)};
        }
        asm volatile("s_waitcnt lgkmcnt(0)" ::: "memory"); __builtin_amdgcn_s_barrier(); asm volatile("" ::: "memory");
        return bad;
    }
};
struct EpiLnRes {
    static constexpr bool PERM = false, AFTER_DRAIN = true;
    const float* base; float* out; int ldc; const float* bias; PanelStats st; unsigned poison;
    __device__ __forceinline__ void fused(f32x4 (&acc)[2][2][4][2], const Unit& u, int wr, int wc, int fr, int fq, PG8_LAS unsigned char* lds, int wid, int lane) const {
        typedef float f32x2v __attribute__((ext_vector_type(2)));
        const PG8_LAS f32x2v* S = (const PG8_LAS f32x2v*)(lds + 8192);
        const int col0 = u.pn * BM + wc * 32 + 4 * fq;
#pragma unroll
        for (int bj = 0; bj < 2; ++bj)
#pragma unroll
            for (int n = 0; n < 2; ++n) { const f32x4 bv = bias ? *(const f32x4*)(bias + col0 + bj * HALF + n * 16) : (f32x4){0.f, 0.f, 0.f, 0.f};
#pragma unroll
                for (int ai = 0; ai < 2; ++ai)
#pragma unroll
                    for (int m = 0; m < 4; ++m) acc[ai][bj][m][n] += bv; }
        f32x4 pre[4][2][2];
#pragma unroll
        for (int m = 0; m < 4; ++m) { const size_t off = (size_t)(u.pm * BM + wr * 64 + m * 16 + fr) * ldc + col0;
#pragma unroll
            for (int bj = 0; bj < 2; ++bj)
#pragma unroll
                for (int n = 0; n < 2; ++n) pre[m][bj][n] = *(const f32x4*)(base + off + bj * HALF + n * 16); }
        const bool bad = st.run(acc, u, wr, wc, fr, fq, lds, wid, lane) || poison != 0u;
        const float qnan = __builtin_nanf("");
#pragma unroll
        for (int ai = 0; ai < 2; ++ai)
#pragma unroll
            for (int m = 0; m < 4; ++m) { const int r = ai * HALF + wr * 64 + m * 16 + fr; const f32x2v sr = S[r]; const size_t off = (size_t)(u.pm * BM + r) * ldc + col0;
#pragma unroll
                for (int bj = 0; bj < 2; ++bj)
#pragma unroll
                    for (int n = 0; n < 2; ++n) { const f32x4 bs = ai == 0 ? pre[m][bj][n] : *(const f32x4*)(base + off + bj * HALF + n * 16); f32x4 o = bs + (acc[ai][bj][m][n] - sr.x) * sr.y;
                        if (bad) o = (f32x4){qnan, qnan, qnan, qnan}; *(f32x4*)(out + off + bj * HALF + n * 16) = o; }
                if (m & 1) asm volatile("" ::: "memory"); }
    }
};
struct EpiLnResLn {
    static constexpr bool PERM = false, AFTER_DRAIN = true;
    const float* base; float* out; bf16_t* xn; int ldc; const float* bias; PanelStats st1, st2; unsigned poison;
    __device__ __forceinline__ void fused(f32x4 (&acc)[2][2][4][2], const Unit& u, int wr, int wc, int fr, int fq, PG8_LAS unsigned char* lds, int wid, int lane) const {
        typedef float f32x2v __attribute__((ext_vector_type(2))); typedef unsigned u32x2v __attribute__((ext_vector_type(2)));
        const PG8_LAS f32x2v* S = (const PG8_LAS f32x2v*)(lds + 8192);
        const int col0 = u.pn * BM + wc * 32 + 4 * fq;
#pragma unroll
        for (int bj = 0; bj < 2; ++bj)
#pragma unroll
            for (int n = 0; n < 2; ++n) { const f32x4 bv = bias ? *(const f32x4*)(bias + col0 + bj * HALF + n * 16) : (f32x4){0.f, 0.f, 0.f, 0.f};
#pragma unroll
                for (int ai = 0; ai < 2; ++ai)
#pragma unroll
                    for (int m = 0; m < 4; ++m) acc[ai][bj][m][n] += bv; }
        bool bad = st1.run(acc, u, wr, wc, fr, fq, lds, wid, lane) || poison != 0u;
        const float qnan = __builtin_nanf("");
#pragma unroll
        for (int ai = 0; ai < 2; ++ai)
#pragma unroll
            for (int m = 0; m < 4; ++m) { const int r = ai * HALF + wr * 64 + m * 16 + fr; const f32x2v sr = S[r]; const size_t off = (size_t)(u.pm * BM + r) * ldc + col0;
#pragma unroll
                for (int bj = 0; bj < 2; ++bj)
#pragma unroll
                    for (int n = 0; n < 2; ++n) { const f32x4 bs = *(const f32x4*)(base + off + bj * HALF + n * 16); acc[ai][bj][m][n] = bs + (acc[ai][bj][m][n] - sr.x) * sr.y; }
                asm volatile("" : "+v"(acc[ai][0][m][0]), "+v"(acc[ai][0][m][1]), "+v"(acc[ai][1][m][0]), "+v"(acc[ai][1][m][1]));
                if (m & 1) asm volatile("" ::: "memory"); }
        const bool bad1 = bad;
        bad = st2.run(acc, u, wr, wc, fr, fq, lds, wid, lane) || bad;
#pragma unroll
        for (int ai = 0; ai < 2; ++ai)
#pragma unroll
            for (int m = 0; m < 4; ++m) { const int r = ai * HALF + wr * 64 + m * 16 + fr; const f32x2v sr = S[r]; const size_t off = (size_t)(u.pm * BM + r) * ldc + col0;
#pragma unroll
                for (int bj = 0; bj < 2; ++bj)
#pragma unroll
                    for (int n = 0; n < 2; ++n) { const f32x4 x1 = acc[ai][bj][m][n]; *(f32x4*)(out + off + bj * HALF + n * 16) = bad1 ? (f32x4){qnan, qnan, qnan, qnan} : x1;
                        const f32x4 o = (x1 - sr.x) * sr.y; u32x2v w; w.x = cvt_pk_bf16(o[0], o[1]); w.y = cvt_pk_bf16(o[2], o[3]);
                        if (bad) { w.x = 0x7fc07fc0u; w.y = 0x7fc07fc0u; } *(u32x2v*)(xn + off + bj * HALF + n * 16) = w; }
                asm volatile("" ::: "memory"); }
    }
};

template <class Epi, class Sched, bool ALIGN_EPI = false, bool SP2 = false>
__device__ __forceinline__ void gemm_phase(PG8_LAS unsigned char* lds, const Gemm g, const Sched& S, const Epi& E) {
    int tid_ = threadIdx.x; asm volatile("" : "+v"(tid_));
    const int tid = tid_, wid = __builtin_amdgcn_readfirstlane(tid >> 6), lane = tid & 63, wr = wid >> 2, wc = wid & 3, fr = lane & 15, fq = lane >> 4;
    const int K = g.K, nt = K / BK;
    unsigned voffA[2], voffB[2];
#pragma unroll
    for (int i = 0; i < 2; ++i) { int R, C; stage_rc(tid * 16 + i * 8192, R, C); const int Rb = Epi::PERM ? ((R & ~31) + perm32(R & 31)) : R;
        voffA[i] = (unsigned)(R * K + C) * 2u; voffB[i] = (unsigned)(Rb * K + C) * 2u; }
    const size_t kstep = (size_t)(BK * 2);
    const size_t hstep = (size_t)HALF * K * 2;
    const size_t tstep = 2 * hstep;
    const unsigned ldsw = (unsigned)wid * 1024u;
    const int aoff = lds_byte(wr * 64 + fr, fq * 8), boff = lds_byte(wc * 32 + fr, fq * 8);
#define PG8_SA(b, h) (((b) * 2 + (h)) * HTB)
#define PG8_SB(b, h) ((4 + (b) * 2 + (h)) * HTB)
#define PG8_STAGE(bufoff, gbase, voff) do { _Pragma("unroll") for (int _i = 0; _i < 2; ++_i) \
        __builtin_amdgcn_global_load_lds((const unsigned*)((const char*)(gbase) + (voff)[_i]), (PG8_LAS unsigned*)(lds + (bufoff) + ldsw + _i * 8192), 16, 0, 0); } while (0)
#define PG8_LDA(dst, b, h) do { _Pragma("unroll") for (int m = 0; m < 4; ++m) _Pragma("unroll") for (int k = 0; k < 2; ++k) dst[m][k] = *(const PG8_LAS bf16x8*)(lds + PG8_SA(b, h) + aoff + m * 2048 + k * 1024); } while (0)
#define PG8_LDB(dst, b, h) do { _Pragma("unroll") for (int n = 0; n < 2; ++n) _Pragma("unroll") for (int k = 0; k < 2; ++k) dst[n][k] = *(const PG8_LAS bf16x8*)(lds + PG8_SB(b, h) + boff + n * 2048 + k * 1024); } while (0)
#define PG8_MMA(ai, bj, At, Bt) do { __builtin_amdgcn_s_setprio(1); _Pragma("unroll") for (int m = 0; m < 4; ++m) _Pragma("unroll") for (int n = 0; n < 2; ++n) _Pragma("unroll") for (int k = 0; k < 2; ++k) \
        acc[ai][bj][m][n] = __builtin_amdgcn_mfma_f32_16x16x32_bf16(Bt[n][k], At[m][k], acc[ai][bj][m][n], 0, 0, 0); __builtin_amdgcn_s_setprio(0); } while (0)
#define PG8_WAIT_V(n) asm volatile("s_waitcnt vmcnt(" #n ")" ::: "memory")
#define PG8_WAIT_L(n) asm volatile("s_waitcnt lgkmcnt(" #n ")" ::: "memory")
#define PG8_BAR __builtin_amdgcn_s_barrier()
#define PG8_SCHED __builtin_amdgcn_sched_barrier(0)
    Unit cur, nxt; int ui = 0;
    if (!S.next(0, cur)) return;
    f32x4 acc[2][2][4][2];
#pragma unroll
    for (int a = 0; a < 2; ++a)
#pragma unroll
        for (int b = 0; b < 2; ++b)
#pragma unroll
            for (int m = 0; m < 4; ++m)
#pragma unroll
                for (int n = 0; n < 2; ++n) acc[a][b][m][n] = (f32x4){0.f, 0.f, 0.f, 0.f};
    bf16x8 At[4][2], B0[2][2], B1[2][2];
    const char* cA = (const char*)g.A + (size_t)cur.pm * tstep; const char* cB = (const char*)g.Bt + (size_t)cur.pn * tstep;
    S.a_ready(cur);
    if constexpr (SP2) {
        PG8_STAGE(PG8_SB(0, 0), cB, voffB); PG8_STAGE(PG8_SB(0, 1), cB + hstep, voffB); PG8_STAGE(PG8_SA(0, 0), cA, voffA); PG8_STAGE(PG8_SA(0, 1), cA + hstep, voffA);
        if (wr == 1) PG8_BAR;
        PG8_WAIT_V(2); PG8_BAR;
        PG8_STAGE(PG8_SB(1, 0), cB + kstep, voffB); PG8_STAGE(PG8_SA(1, 0), cA + kstep, voffA); PG8_STAGE(PG8_SB(1, 1), cB + hstep + kstep, voffB);
        PG8_WAIT_V(6); PG8_BAR;
    } else {
        PG8_STAGE(PG8_SB(0, 0), cB, voffB); PG8_STAGE(PG8_SA(0, 0), cA, voffA); PG8_STAGE(PG8_SB(0, 1), cB + hstep, voffB); PG8_STAGE(PG8_SA(0, 1), cA + hstep, voffA);
        if (wr == 1) PG8_BAR;
        PG8_WAIT_V(4); PG8_BAR;
        PG8_STAGE(PG8_SB(1, 0), cB + kstep, voffB); PG8_STAGE(PG8_SA(1, 0), cA + kstep, voffA); PG8_STAGE(PG8_SB(1, 1), cB + hstep + kstep, voffB);
        PG8_WAIT_V(6); PG8_BAR;
    }
    for (;;) {
        const bool has_next = S.next(ui + 1, nxt);
        const char* nA = has_next ? (const char*)g.A + (size_t)nxt.pm * tstep : cA; const char* nB = has_next ? (const char*)g.Bt + (size_t)nxt.pn * tstep : cB;
        for (int t = 0; t < nt; t += 2) {
            const bool last = (t == nt - 2);
            const char* a1 = cA + (size_t)(t + 1) * kstep;
            const char* a2 = last ? nA : cA + (size_t)(t + 2) * kstep; const char* b2 = last ? nB : cB + (size_t)(t + 2) * kstep;
            const char* a3 = a2 + kstep; const char* b3 = b2 + kstep;
            if (last && has_next) S.a_ready(nxt);
            if constexpr (SP2) {
            PG8_LDB(B0, 0, 0); PG8_LDB(B1, 0, 1); PG8_SCHED; PG8_LDA(At, 0, 0); PG8_STAGE(PG8_SA(1, 1), a1 + hstep, voffA);
            PG8_WAIT_V(8); PG8_WAIT_L(0); PG8_BAR; PG8_MMA(0, 0, At, B0); PG8_MMA(0, 1, At, B1); PG8_BAR; PG8_SCHED;
            PG8_LDA(At, 0, 1); PG8_STAGE(PG8_SB(0, 0), b2, voffB); PG8_STAGE(PG8_SB(0, 1), b2 + hstep, voffB); PG8_STAGE(PG8_SA(0, 0), a2, voffA);
            PG8_WAIT_V(8); PG8_WAIT_L(0); PG8_BAR; PG8_MMA(1, 0, At, B0); PG8_MMA(1, 1, At, B1); PG8_BAR; PG8_SCHED;
            PG8_LDB(B0, 1, 0); PG8_LDB(B1, 1, 1); PG8_SCHED; PG8_LDA(At, 1, 0); PG8_STAGE(PG8_SA(0, 1), a2 + hstep, voffA);
            PG8_WAIT_V(8); PG8_WAIT_L(0); PG8_BAR; PG8_MMA(0, 0, At, B0); PG8_MMA(0, 1, At, B1); PG8_BAR; PG8_SCHED;
            PG8_LDA(At, 1, 1); PG8_STAGE(PG8_SB(1, 0), b3, voffB); PG8_STAGE(PG8_SB(1, 1), b3 + hstep, voffB); PG8_STAGE(PG8_SA(1, 0), a3, voffA);
            PG8_WAIT_V(8); PG8_WAIT_L(0); PG8_BAR; PG8_MMA(1, 0, At, B0); PG8_MMA(1, 1, At, B1); PG8_BAR; PG8_SCHED;
            } else {
            PG8_LDB(B0, 0, 0); PG8_SCHED; PG8_LDA(At, 0, 0); PG8_STAGE(PG8_SA(1, 1), a1 + hstep, voffA);
            PG8_WAIT_L(8); PG8_BAR; PG8_WAIT_L(0); PG8_MMA(0, 0, At, B0); PG8_BAR; PG8_SCHED;
            PG8_LDB(B1, 0, 1); PG8_STAGE(PG8_SB(0, 0), b2, voffB);
            PG8_BAR; PG8_WAIT_L(0); PG8_MMA(0, 1, At, B1); PG8_BAR;
            PG8_LDA(At, 0, 1); PG8_STAGE(PG8_SA(0, 0), a2, voffA);
            PG8_BAR; PG8_WAIT_L(0); PG8_MMA(1, 0, At, B0); PG8_BAR; PG8_SCHED;
            PG8_STAGE(PG8_SB(0, 1), b2 + hstep, voffB);
            PG8_WAIT_V(6); PG8_BAR; PG8_MMA(1, 1, At, B1); PG8_BAR;
            PG8_LDB(B0, 1, 0); PG8_SCHED; PG8_LDA(At, 1, 0); PG8_STAGE(PG8_SA(0, 1), a2 + hstep, voffA);
            PG8_WAIT_L(8); PG8_BAR; PG8_WAIT_L(0); PG8_MMA(0, 0, At, B0); PG8_BAR; PG8_SCHED;
            PG8_LDB(B1, 1, 1); PG8_STAGE(PG8_SB(1, 0), b3, voffB);
            PG8_BAR; PG8_WAIT_L(0); PG8_MMA(0, 1, At, B1); PG8_BAR;
            PG8_LDA(At, 1, 1); PG8_STAGE(PG8_SA(1, 0), a3, voffA);
            PG8_BAR; PG8_WAIT_L(0); PG8_MMA(1, 0, At, B0); PG8_BAR; PG8_SCHED;
            PG8_STAGE(PG8_SB(1, 1), b3 + hstep, voffB);
            PG8_WAIT_V(6); PG8_BAR; PG8_MMA(1, 1, At, B1); PG8_BAR;
            }
        }
        if constexpr (ALIGN_EPI) { if (wr == 0) PG8_BAR; }
        if constexpr (!Epi::AFTER_DRAIN) { E(acc, cur, wr, wc, fr, fq); S.done(cur); }
        if (!has_next) break;
#pragma unroll
        for (int a = 0; a < 2; ++a)
#pragma unroll
            for (int b = 0; b < 2; ++b)
#pragma unroll
                for (int m = 0; m < 4; ++m)
#pragma unroll
                    for (int n = 0; n < 2; ++n) acc[a][b][m][n] = (f32x4){0.f, 0.f, 0.f, 0.f};
        cur = nxt; cA = nA; cB = nB; ++ui;
        if constexpr (ALIGN_EPI) { if (wr == 1) PG8_BAR; }
    }
    PG8_WAIT_V(0);
    if constexpr (!ALIGN_EPI) { if (wr == 0) PG8_BAR; }
    PG8_BAR;
    if constexpr (Epi::AFTER_DRAIN) { E.fused(acc, cur, wr, wc, fr, fq, lds, wid, lane); S.done(cur); }
#undef PG8_SA
#undef PG8_SB
#undef PG8_STAGE
#undef PG8_LDA
#undef PG8_LDB
#undef PG8_MMA
#undef PG8_WAIT_V
#undef PG8_WAIT_L
#undef PG8_BAR
#undef PG8_SCHED
}
}

#include <hip/hip_cooperative_groups.h>
namespace cg = cooperative_groups;
#define LAS __attribute__((address_space(3)))
typedef unsigned short bf16_t;
using pg8::f32x4; using pg8::bf16x8; using pg8::u32x4;
typedef float f32x2_t __attribute__((ext_vector_type(2))); typedef __bf16 bf16x2_t __attribute__((ext_vector_type(2)));
__device__ __forceinline__ unsigned cvt_pk_bf16(float lo, float hi) { f32x2_t v = {lo, hi}; bf16x2_t b = __builtin_convertvector(v, bf16x2_t); return __builtin_bit_cast(unsigned, b); }
typedef float f32x16 __attribute__((ext_vector_type(16)));
typedef short s16x4 __attribute__((ext_vector_type(4)));
typedef unsigned u32x2 __attribute__((ext_vector_type(2)));

constexpr int M = 16384, DM = 1024, SEQ = 2048, NB = 8, DEPTH = 4;
constexpr int NIN = 3840;
constexpr int DFF = 2816;
constexpr float EPS = 1e-6f;
constexpr float LOG2E = 1.4426950408889634f;
constexpr int LDS_BYTES = 147456;

struct P {
    const float *x, *mem; const int* pos;
    const float *norm_mix, *w_in, *ssm_conv_w, *ssm_conv_b, *dt_bias, *a_log, *d_skip, *ssm_norm, *q_norm, *w_uq, *kv_norm, *w_ukv, *attn_out_norm, *w_out,
                *norm_mem_q, *norm_mem_kv, *w_mq, *w_mk, *w_mv, *w_mo, *norm_ffn, *w_up, *ffn_conv_w, *ffn_conv_b, *w_down, *final_norm;
    float* out; unsigned char* ws;
};

constexpr size_t KiB = 1024, MiB = 1024 * 1024;
constexpr size_t WS_RSS = 0, WS_COS = 1 * MiB, WS_SIN = 2 * MiB, WS_DT = 3 * MiB, WS_KPE = 4 * MiB;
constexpr size_t WS_WIN = 6144 * KiB, WS_WUQ = 13824 * KiB, WS_WUKV = 14976 * KiB, WS_WOUT = 16000 * KiB, WS_WMQ = 20096 * KiB, WS_WMO = 22144 * KiB,
                 WS_WUP = 24192 * KiB, WS_WDN0 = 35456 * KiB, WS_WDN1 = 41088 * KiB;
constexpr size_t WS_WMKV = 46 * MiB, WS_KMVM = 62 * MiB, WS_MEMN = 94 * MiB, WS_XB = 98 * MiB, WS_VB = 98 * MiB;
constexpr size_t WS_Z = 130 * MiB, WS_QM = 130 * MiB, WS_U = 130 * MiB;
constexpr size_t WS_WUKV1 = 5 * MiB;
constexpr size_t WS_XBCPRE = 162 * MiB, WS_YC = 162 * MiB, WS_OM = 162 * MiB;
constexpr size_t WS_ACT = 218 * MiB;
constexpr size_t WS_SM = 226 * MiB, WS_XBC = 250 * MiB, WS_QB = 250 * MiB, WS_CQN = 314 * MiB, WS_CKVN = 326 * MiB, WS_RSP = 334 * MiB, WS_HALO = 337 * MiB, WS_PART = 340 * MiB, WS_KN = 343 * MiB, WS_END = 375 * MiB;

__device__ __forceinline__ float bflo(unsigned w) { return __uint_as_float(w << 16); }
__device__ __forceinline__ float bfhi(unsigned w) { return __uint_as_float(w & 0xffff0000u); }
__device__ __forceinline__ float bf1(bf16_t h) { return __uint_as_float((unsigned)h << 16); }
__device__ __forceinline__ bf16_t tobf(float f) { return (bf16_t)(cvt_pk_bf16(f, 0.f) & 0xffffu); }
__device__ __forceinline__ float wave_sum(float v) {
#pragma unroll
    for (int o = 1; o < 64; o <<= 1) v += __shfl_xor(v, o);
    return v;
}
__device__ __forceinline__ float silu_f(float v) { return v * __builtin_amdgcn_rcpf(1.f + __expf(-v)); }
__device__ __forceinline__ int crow(int r, int hi) { return (r & 3) + 8 * (r >> 2) + 4 * hi; }
#define LDS_WAIT() asm volatile("s_waitcnt lgkmcnt(0)" ::: "memory")
__device__ __forceinline__ int fresh_tid() { int t = threadIdx.x; asm volatile("" : "+v"(t)); return t; }
__device__ __forceinline__ float rss16(const float* rsp, int row) { const f32x4 a = *(const f32x4*)(rsp + (size_t)row * 4), b = *(const f32x4*)(rsp + (size_t)M * 4 + (size_t)row * 4), c = *(const f32x4*)(rsp + (size_t)M * 8 + (size_t)row * 4), d = *(const f32x4*)(rsp + (size_t)M * 12 + (size_t)row * 4);
    return (((a[0] + a[1]) + (a[2] + a[3])) + ((b[0] + b[1]) + (b[2] + b[3]))) + (((c[0] + c[1]) + (c[2] + c[3])) + ((d[0] + d[1]) + (d[2] + d[3]))); }

struct EpiRoute {
    static constexpr bool PERM = true, AFTER_DRAIN = false;
    bf16_t *b0, *b1, *b2; int ld0, ld1, ld2, t1, t2; const float* rss; float invk, mul;
    __device__ __forceinline__ void operator()(const f32x4 (&acc)[2][2][4][2], const pg8::Unit& u, int wr_, int wc_, int fr_, int fq_) const {
        const int t_ = fresh_tid(), wid_ = __builtin_amdgcn_readfirstlane(t_ >> 6), wr = wid_ >> 2, wc = wid_ & 3, fr = t_ & 15, fq = (t_ >> 4) & 3;
        bf16_t* base; int ld, colt;
        if (u.pn < t1) { base = b0; ld = ld0; colt = u.pn * 256; } else if (u.pn < t2) { base = b1; ld = ld1; colt = (u.pn - t1) * 256; } else { base = b2; ld = ld2; colt = (u.pn - t2) * 256; }
        const int col0 = colt + wc * 32 + 8 * fq;
#pragma unroll
        for (int ai = 0; ai < 2; ++ai)
#pragma unroll
            for (int m = 0; m < 4; ++m) {
                const int row = u.pm * 256 + ai * 128 + wr * 64 + m * 16 + fr;
                float s = mul; if (rss) s *= rsqrtf(rss16(rss, row) * invk + EPS);
                bf16_t* rowp = base + (size_t)row * ld + col0;
#pragma unroll
                for (int bj = 0; bj < 2; ++bj) { const f32x4 v0 = acc[ai][bj][m][0] * s, v1 = acc[ai][bj][m][1] * s;
                    u32x4 w; w.x = cvt_pk_bf16(v0[0], v0[1]); w.y = cvt_pk_bf16(v0[2], v0[3]); w.z = cvt_pk_bf16(v1[0], v1[1]); w.w = cvt_pk_bf16(v1[2], v1[3]);
                    *(u32x4*)(rowp + bj * 128) = w; }
                asm volatile("" ::: "memory");
            }
    }
};
struct EpiRope {
    static constexpr bool PERM = false, AFTER_DRAIN = false;
    bf16_t* YCq; bf16_t* QPE; const float* cs; const float* sn; float mul;
    __device__ __forceinline__ void operator()(const f32x4 (&acc)[2][2][4][2], const pg8::Unit& u, int wr_, int wc_, int fr_, int fq_) const {
        const int t_ = fresh_tid(), wid_ = __builtin_amdgcn_readfirstlane(t_ >> 6), wr = wid_ >> 2, wc = wid_ & 3, fr = t_ & 15, fq = (t_ >> 4) & 3;
#pragma unroll
        for (int ai = 0; ai < 2; ++ai)
#pragma unroll
            for (int m = 0; m < 4; ++m) {
                const int row = u.pm * 256 + ai * 128 + wr * 64 + m * 16 + fr;
                const f32x4 c = *(const f32x4*)(cs + (size_t)row * 16 + 4 * fq), s = *(const f32x4*)(sn + (size_t)row * 16 + 4 * fq);
#pragma unroll
                for (int bj = 0; bj < 2; ++bj) { const int gb = u.pn * 256 + bj * 128 + wc * 32; const int head = gb / 96, within = gb - head * 96; const bool rope = within == 64;
                    f32x4 a = acc[ai][bj][m][0], b = acc[ai][bj][m][1];
                    if (rope) { const f32x4 a2 = a * c - b * s, b2 = b * c + a * s; a = a2; b = b2; }
                    a = a * mul; b = b * mul;
                    bf16_t* dst = rope ? (QPE + (size_t)row * 512 + 32 * head + 4 * fq) : (YCq + (size_t)row * 2048 + 1024 + 64 * head + within + 4 * fq);
                    u32x2 w0, w1; w0.x = cvt_pk_bf16(a[0], a[1]); w0.y = cvt_pk_bf16(a[2], a[3]); w1.x = cvt_pk_bf16(b[0], b[1]); w1.y = cvt_pk_bf16(b[2], b[3]);
                    *(u32x2*)dst = w0; *(u32x2*)(dst + 16) = w1; }
                asm volatile("" ::: "memory");
            }
    }
};
struct EpiRes {
    static constexpr bool PERM = false, AFTER_DRAIN = false;
    const float* xin; float* xout; bf16_t* xb; float* rss;
    __device__ __forceinline__ void operator()(const f32x4 (&acc)[2][2][4][2], const pg8::Unit& u, int wr_, int wc_, int fr_, int fq_) const {
        const int t_ = fresh_tid(), wid_ = __builtin_amdgcn_readfirstlane(t_ >> 6), wr = wid_ >> 2, wc = wid_ & 3, fr = t_ & 15, fq = (t_ >> 4) & 3;
#pragma unroll
        for (int ai = 0; ai < 2; ++ai)
#pragma unroll
            for (int m = 0; m < 4; ++m) {
                const int row = u.pm * 256 + ai * 128 + wr * 64 + m * 16 + fr; float ss = 0.f;
#pragma unroll
                for (int bj = 0; bj < 2; ++bj)
#pragma unroll
                    for (int n = 0; n < 2; ++n) { const size_t off = (size_t)row * 1024 + u.pn * 256 + bj * 128 + wc * 32 + 16 * n + 4 * fq;
                        const f32x4 v = *(const f32x4*)(xin + off) + acc[ai][bj][m][n];
                        *(f32x4*)(xout + off) = v; u32x2 w; w.x = cvt_pk_bf16(v[0], v[1]); w.y = cvt_pk_bf16(v[2], v[3]); *(u32x2*)(xb + off) = w;
                        ss += (v[0] * v[0] + v[1] * v[1]) + (v[2] * v[2] + v[3] * v[3]); }
                ss += __shfl_xor(ss, 16); ss += __shfl_xor(ss, 32);
                if (fq == 0) rss[(size_t)u.pn * M * 4 + (size_t)row * 4 + wc] = ss;
                asm volatile("" ::: "memory");
            }
    }
};


template <int CTRL> __device__ __forceinline__ float dpp_mov(float old, float src) {
    return __builtin_bit_cast(float, __builtin_amdgcn_update_dpp(__builtin_bit_cast(int, old), __builtin_bit_cast(int, src), CTRL, 0xf, 0xf, false)); }
struct EpiGlu {
    static constexpr bool PERM = true, AFTER_DRAIN = false;
    bf16_t* ACT; const float* rss; const float* cw; const float* cb; float* HALO; float* PART; LAS float* H;
    __device__ __forceinline__ void operator()(const f32x4 (&acc)[2][2][4][2], const pg8::Unit& u, int wr_, int wc_, int fr_, int fq_) const {
        typedef float f32x2v __attribute__((ext_vector_type(2)));
        typedef __attribute__((address_space(1))) f32x4 gf4; typedef __attribute__((address_space(1))) f32x2v gf2; typedef __attribute__((address_space(1))) u32x2 gu2;
        const int t_ = fresh_tid(), wid_ = __builtin_amdgcn_readfirstlane(t_ >> 6), wr = wid_ >> 2, wc = wid_ & 3, fr = t_ & 15, fq = (t_ >> 4) & 3;
        const int pm = u.pm, pn = u.pn;
        LAS float* RS = H + 2048; LAS float* WT = H + 2304;
        if (t_ < 256) { RS[t_] = rsqrtf(rss16(rss, pm * 256 + t_) * (1.f / 1024.f) + EPS);
            const unsigned gcol = (unsigned)((t_ >> 7) * 2816 + 128 * pn + (t_ & 127));
            WT[t_] = cw[gcol]; WT[256 + t_] = cw[5632u + gcol]; WT[512 + t_] = cw[11264u + gcol]; WT[768 + t_] = cb[gcol]; }
        asm volatile("s_waitcnt lgkmcnt(0)" ::: "memory"); __builtin_amdgcn_s_barrier(); asm volatile("" ::: "memory");
        const LAS float* RSl = RS + wr * 64 + fr;
        const int lc = wc * 32 + 8 * fq;
        if (fr >= 14) {
#pragma unroll
            for (int ai = 0; ai < 2; ++ai)
#pragma unroll
                for (int bj = 0; bj < 2; ++bj)
#pragma unroll
                    for (int n = 0; n < 2; ++n) { const f32x4 v = acc[ai][bj][3][n] * RSl[ai * 128 + 48];
                        *(LAS f32x4*)(H + ((ai * 2 + wr) * 2 + (fr - 14)) * 256 + bj * 128 + lc + 4 * n) = v;
                        if (ai == 1 && wr == 1) *(gf4*)(HALO + (unsigned)((pm * 2 + (fr - 14)) * 5632 + bj * 2816 + 128 * pn + lc + 4 * n)) = v; }
        }
        asm volatile("s_waitcnt lgkmcnt(0)" ::: "memory"); __builtin_amdgcn_s_barrier(); asm volatile("" ::: "memory");
#pragma unroll
        for (int n = 0; n < 2; ++n)
#pragma unroll
            for (int ai = 0; ai < 2; ++ai) {
                const int src = ai * 2 + wr - 1;
                unsigned res0[4];
#pragma unroll
                for (int jp = 0; jp < 2; ++jp) {
                    const int lcc = lc + 4 * n + 2 * jp;
                    const f32x2v w0g = *(const LAS f32x2v*)(WT + lcc), w1g = *(const LAS f32x2v*)(WT + 256 + lcc), w2g = *(const LAS f32x2v*)(WT + 512 + lcc), bg = *(const LAS f32x2v*)(WT + 768 + lcc);
                    const f32x2v w0v = *(const LAS f32x2v*)(WT + 128 + lcc), w1v = *(const LAS f32x2v*)(WT + 384 + lcc), w2v = *(const LAS f32x2v*)(WT + 640 + lcc), bv = *(const LAS f32x2v*)(WT + 896 + lcc);
                    f32x2v pg = (f32x2v){0.f, 0.f}, pv = (f32x2v){0.f, 0.f};
                    if (src >= 0) { const LAS float* hp = H + (src * 2 + (fr & 1)) * 256 + lcc; pg = *(const LAS f32x2v*)hp; pv = *(const LAS f32x2v*)(hp + 128); }
                    const unsigned gc = (unsigned)(128 * pn + lcc);
#pragma unroll
                    for (int m = 0; m < 4; ++m) {
                        const float sm_ = RSl[ai * 128 + m * 16];
                        const f32x2v cg = (f32x2v){acc[ai][0][m][n][2 * jp] * sm_, acc[ai][0][m][n][2 * jp + 1] * sm_}, cv = (f32x2v){acc[ai][1][m][n][2 * jp] * sm_, acc[ai][1][m][n][2 * jp + 1] * sm_};
                        f32x2v og, ov;
#pragma unroll
                        for (int j = 0; j < 2; ++j) {
                            const float g1 = dpp_mov<0x111>(dpp_mov<0x121>(pg[j], pg[j]), cg[j]), g2 = dpp_mov<0x112>(dpp_mov<0x122>(pg[j], pg[j]), cg[j]);
                            const float v1 = dpp_mov<0x111>(dpp_mov<0x121>(pv[j], pv[j]), cv[j]), v2 = dpp_mov<0x112>(dpp_mov<0x122>(pv[j], pv[j]), cv[j]);
                            og[j] = bg[j] + w2g[j] * cg[j] + w1g[j] * g1 + w0g[j] * g2;
                            ov[j] = bv[j] + w2v[j] * cv[j] + w1v[j] * v1 + w0v[j] * v2; }
                        pg = cg; pv = cv;
                        const int row = pm * 256 + ai * 128 + wr * 64 + m * 16 + fr;
                        const bool partial = (ai == 0) && (m == 0) && (wr == 0) && (fr < 2) && ((pm & 7) != 0);
                        if (partial) { *(gf2*)(PART + ((unsigned)(((pm * 2 + fr) * 2 + 0) * 2816) + gc)) = og; *(gf2*)(PART + ((unsigned)(((pm * 2 + fr) * 2 + 1) * 2816) + gc)) = ov; }
                        const unsigned pk = cvt_pk_bf16(silu_f(og[0]) * ov[0], silu_f(og[1]) * ov[1]);
                        if (jp == 0) res0[m] = pk;
                        else if (!partial) { u32x2 o; o.x = res0[m]; o.y = pk; *(gu2*)(ACT + ((unsigned)(row * DFF) + gc - 2u)) = o; }
                    }
                    asm volatile("" ::: "memory");
                }
            }
    }
};
__device__ __forceinline__ void ffn_fixup(const P& p, int L, int pm) {
    if ((pm & 7) == 0) return;
    unsigned char* ws = p.ws; asm volatile("" : "+s"(ws));
    const float* HALO = (const float*)(ws + WS_HALO); const float* PART = (const float*)(ws + WS_PART); bf16_t* ACT = (bf16_t*)(ws + WS_ACT);
    const float* cw = p.ffn_conv_w + (size_t)L * 3 * 5632;
    const int tid = fresh_tid();
    for (int idx = tid; idx < 2 * DFF; idx += 512) { const int r = idx / DFF, c = idx - r * DFF;
        float g = PART[(((size_t)pm * 2 + r) * 2 + 0) * 2816 + c], v = PART[(((size_t)pm * 2 + r) * 2 + 1) * 2816 + c];
        const float hg0 = HALO[((size_t)(pm - 1) * 2 + 0) * 5632 + c], hg1 = HALO[((size_t)(pm - 1) * 2 + 1) * 5632 + c];
        const float hv0 = HALO[((size_t)(pm - 1) * 2 + 0) * 5632 + 2816 + c], hv1 = HALO[((size_t)(pm - 1) * 2 + 1) * 5632 + 2816 + c];
        if (r == 0) { g += cw[5632 + c] * hg1 + cw[c] * hg0; v += cw[5632 + 2816 + c] * hv1 + cw[2816 + c] * hv0; }
        else { g += cw[c] * hg1; v += cw[2816 + c] * hv1; }
        ACT[((size_t)pm * 256 + r) * DFF + c] = tobf(silu_f(g) * v); }
    asm volatile("s_waitcnt vmcnt(0)" ::: "memory");
    __syncthreads();
}

template <class Epi>
__device__ __forceinline__ void run_gemm_on(LAS unsigned char* lds, const bf16_t* A, const bf16_t* Bt, int m, int n, int k, const Epi& E, int G_, int c_) {
    pg8::Gemm g{A, Bt, m, n, k}; pg8::StaticOrder S; S.init(m, n, G_, c_);
    pg8::gemm_phase<Epi, pg8::StaticOrder, true, true>(lds, g, S, E);
}
template <class Epi>
__device__ __forceinline__ void run_gemm(LAS unsigned char* lds, const bf16_t* A, const bf16_t* Bt, int m, int n, int k, const Epi& E) {
    pg8::Gemm g{A, Bt, m, n, k}; pg8::StaticOrder S; S.init(m, n, (int)gridDim.x, (int)blockIdx.x);
    pg8::gemm_phase<Epi, pg8::StaticOrder, true, true>(lds, g, S, E);
}

template <class SrcCol, class Gain>
__device__ __forceinline__ void tr_item(const float* W, int K, int Nsrc, bf16_t* WT, int nblk, LAS float* scr, int item, int lane, SrcCol srccol, Gain gain) {
    const int kb = item / nblk, nb = item % nblk, k0 = 64 * kb, n0 = 32 * nb;
    const int sc = srccol(n0 + (lane & 31));
#pragma unroll
    for (int i = 0; i < 32; ++i) { const int kk = 2 * i + (lane >> 5);
        float v = 0.f; if (sc >= 0) v = W[(size_t)(k0 + kk) * Nsrc + sc] * gain(k0 + kk);
        scr[kk * 33 + (lane & 31)] = v; }
    LDS_WAIT(); asm volatile("" ::: "memory");
    const int c = lane & 7;
#pragma unroll
    for (int j = 0; j < 4; ++j) { const int n = (lane >> 3) + 8 * j; const LAS float* s = scr + (8 * c) * 33 + n;
        u32x4 o; o.x = cvt_pk_bf16(s[0 * 33], s[1 * 33]); o.y = cvt_pk_bf16(s[2 * 33], s[3 * 33]); o.z = cvt_pk_bf16(s[4 * 33], s[5 * 33]); o.w = cvt_pk_bf16(s[6 * 33], s[7 * 33]);
        *(u32x4*)(WT + (size_t)(n0 + n) * K + k0 + 8 * c) = o; }
    LDS_WAIT(); asm volatile("" ::: "memory");
}

__device__ __forceinline__ void convert_layer(const P& p, int Lw, int Lq, int Lu, int L, LAS float* scr, int gw, int NGW, int lane_unused) {
    const int lane = fresh_tid() & 63;
    unsigned char* ws = p.ws; asm volatile("" : "+s"(ws));
    constexpr int I_IN = 16 * 120, I_UQ = 6 * 48, I_UKV = 4 * 64, I_OUT = 32 * 32, I_MQ = 16 * 32, I_MO = 16 * 32, I_UP = 16 * 176, I_DN = 44 * 32;
    constexpr int NIT = I_IN + I_UQ + I_UKV + I_OUT + I_MQ + I_MO + I_UP + I_DN;
    for (int it = gw; it < NIT; it += NGW) {
        int r = it;
        if (r < I_IN) { if (Lw < 0 || Lw >= DEPTH) continue; const float* g = p.norm_mix + Lw * 1024;
            tr_item(p.w_in + (size_t)Lw * 1024 * 3760, 1024, 3760, (bf16_t*)(ws + WS_WIN), 120, scr, r, lane,
                    [](int n) { return n < 3072 ? n : (n < 3744 ? n + 16 : (n < 3760 ? n - 672 : -1)); }, [g](int k) { return g[k]; }); continue; } r -= I_IN;
        if (r < I_UQ) { if (Lq < 0 || Lq >= DEPTH) continue; const float* g = p.q_norm + Lq * 384;
            tr_item(p.w_uq + (size_t)Lq * 384 * 1536, 384, 1536, (bf16_t*)(ws + WS_WUQ), 48, scr, r, lane, [](int n) { return n; }, [g](int k) { return g[k]; }); continue; } r -= I_UQ;
        if (r < I_UKV) { if (Lq < 0 || Lq >= DEPTH) continue; const float* g = p.kv_norm + Lq * 256;
            tr_item(p.w_ukv + (size_t)Lq * 256 * 2048, 256, 2048, (bf16_t*)(ws + WS_WUKV), 64, scr, r, lane,
                    [](int n) { return n < 1024 ? 128 * (n >> 6) + (n & 63) : 128 * ((n - 1024) >> 6) + 64 + (n & 63); }, [g](int k) { return g[k]; }); continue; } r -= I_UKV;
        if (r < I_OUT) { if (L < 0) continue; const float* g1 = p.ssm_norm + L * 1024; const float* g2 = p.attn_out_norm + L * 1024;
            tr_item(p.w_out + (size_t)L * 2048 * 1024, 2048, 1024, (bf16_t*)(ws + WS_WOUT), 32, scr, r, lane, [](int n) { return n; }, [g1, g2](int k) { return k < 1024 ? g1[k] : g2[k - 1024]; }); continue; } r -= I_OUT;
        if (r < I_MQ) { if (L < 0) continue; const float* g = p.norm_mem_q + L * 1024;
            tr_item(p.w_mq + (size_t)L * 1024 * 1024, 1024, 1024, (bf16_t*)(ws + WS_WMQ), 32, scr, r, lane, [](int n) { return n; }, [g](int k) { return g[k]; }); continue; } r -= I_MQ;
        if (r < I_MO) { if (L < 0) continue;
            tr_item(p.w_mo + (size_t)L * 1024 * 1024, 1024, 1024, (bf16_t*)(ws + WS_WMO), 32, scr, r, lane, [](int n) { return n; }, [](int) { return 1.f; }); continue; } r -= I_MO;
        if (r < I_UP) { if (Lu < 0 || Lu >= DEPTH) continue; const float* g = p.norm_ffn + Lu * 1024;
            tr_item(p.w_up + (size_t)Lu * 1024 * 5632, 1024, 5632, (bf16_t*)(ws + WS_WUP), 176, scr, r, lane, [](int n) { return (n & 128) ? 2816 + 128 * (n >> 8) + (n & 127) : 128 * (n >> 8) + (n & 127); }, [g](int k) { return g[k]; }); continue; } r -= I_UP;
        if (L < 0) continue;
        tr_item(p.w_down + (size_t)L * 2816 * 1024, 2816, 1024, (bf16_t*)(ws + ((L & 1) ? WS_WDN1 : WS_WDN0)), 32, scr, r, lane, [](int n) { return n; }, [](int) { return 1.f; });
    }
}

__device__ __forceinline__ void prologue(const P& p, LAS float* scr, int gw, int NGW, int lane_unused) {
    const int lane = fresh_tid() & 63;
    unsigned char* ws = p.ws; asm volatile("" : "+s"(ws));
    float* rss = (float*)(ws + WS_RSP);
    bf16_t* XB = (bf16_t*)(ws + WS_XB);
    for (int m = gw; m < M; m += NGW) {
        const f32x4* xr = (const f32x4*)(p.x + (size_t)m * 1024) + lane; float ss = 0.f;
#pragma unroll
        for (int j = 0; j < 4; ++j) { const f32x4 v = xr[64 * j]; ss += (v[0] * v[0] + v[1] * v[1]) + (v[2] * v[2] + v[3] * v[3]);
            u32x2 w; w.x = cvt_pk_bf16(v[0], v[1]); w.y = cvt_pk_bf16(v[2], v[3]); *((u32x2*)(XB + (size_t)m * 1024) + lane + 64 * j) = w; }
        ss = wave_sum(ss); if (lane < 16) rss[(size_t)(lane >> 2) * M * 4 + (size_t)m * 4 + (lane & 3)] = (lane == 0) ? ss : 0.f;
    }
    bf16_t* MEMN = (bf16_t*)(ws + WS_MEMN);
    for (int m = gw; m < 2048; m += NGW) {
        const f32x4* xr = (const f32x4*)(p.mem + (size_t)m * 1024) + lane; f32x4 v[4]; float ss = 0.f;
#pragma unroll
        for (int j = 0; j < 4; ++j) { v[j] = xr[64 * j]; ss += (v[j][0] * v[j][0] + v[j][1] * v[j][1]) + (v[j][2] * v[j][2] + v[j][3] * v[j][3]); }
        const float rs = rsqrtf(wave_sum(ss) * (1.f / 1024.f) + EPS);
#pragma unroll
        for (int j = 0; j < 4; ++j) { u32x2 w; w.x = cvt_pk_bf16(v[j][0] * rs, v[j][1] * rs); w.y = cvt_pk_bf16(v[j][2] * rs, v[j][3] * rs); *((u32x2*)(MEMN + (size_t)m * 1024) + lane + 64 * j) = w; }
    }
    float* COS = (float*)(ws + WS_COS); float* SIN = (float*)(ws + WS_SIN);
    for (int i = gw * 64 + lane; i < M * 16; i += NGW * 64) { const int m = i >> 4, k = i & 15;
        const float inv = powf(10000.f, -(float)(2 * k) / 32.f); const float ang = (float)p.pos[m] * inv;
        COS[i] = cosf(ang); SIN[i] = sinf(ang); }
    for (int it = gw; it < 4 * 2 * 512; it += NGW) { const int L = it >> 10, kv = (it >> 9) & 1, r = it & 511; const float* g = p.norm_mem_kv + L * 1024;
        tr_item((kv ? p.w_mv : p.w_mk) + (size_t)L * 1024 * 1024, 1024, 1024, (bf16_t*)(ws + WS_WMKV) + (size_t)(L * 2048 + kv * 1024) * 1024, 32, scr, r, lane, [](int n) { return n; }, [g](int k) { return g[k]; }); }
    convert_layer(p, 0, 0, -1, -1, scr, gw, NGW, lane);
}

__device__ __forceinline__ void pass_l2(const P& p, int L, int gw, int NGW, int lane_unused) {
    const int lane = fresh_tid() & 63;
    unsigned char* ws = p.ws; asm volatile("" : "+s"(ws));
    const bf16_t* XP = (const bf16_t*)(ws + WS_XBCPRE); bf16_t* XO = (bf16_t*)(ws + WS_XBC); const bf16_t* SM = (const bf16_t*)(ws + WS_SM);
    bf16_t* CQN = (bf16_t*)(ws + WS_CQN); bf16_t* CKVN = (bf16_t*)(ws + WS_CKVN); bf16_t* KPE = (bf16_t*)(ws + WS_KPE); float* DT = (float*)(ws + WS_DT);
    const float* COS = (const float*)(ws + WS_COS); const float* SIN = (const float*)(ws + WS_SIN);
    const float* cw = p.ssm_conv_w + (size_t)L * 4 * 2048; const float* cb = p.ssm_conv_b + (size_t)L * 2048;
    for (int blk = gw; blk < M / 8; blk += NGW) {
        const int m0 = blk * 8, t0 = m0 & (SEQ - 1);
#pragma unroll 2
        for (int j = 0; j < 4; ++j) {
            const int c = lane * 8 + 512 * j;
            const f32x4 b0 = *(const f32x4*)(cb + c), b1 = *(const f32x4*)(cb + c + 4);
            f32x4 w0[4], w1[4];
#pragma unroll
            for (int k = 0; k < 4; ++k) { w0[k] = *(const f32x4*)(cw + k * 2048 + c); w1[k] = *(const f32x4*)(cw + k * 2048 + c + 4); }
            u32x4 xr[11];
#pragma unroll
            for (int i = 0; i < 11; ++i) { if (t0 - 3 + i >= 0) xr[i] = *(const u32x4*)(XP + (size_t)(m0 - 3 + i) * 2048 + c); else xr[i] = (u32x4){0u, 0u, 0u, 0u}; }
#pragma unroll
            for (int r = 0; r < 8; ++r) {
                f32x4 a0 = b0, a1 = b1;
#pragma unroll
                for (int k = 0; k < 4; ++k) { const u32x4 v = xr[r + k];
                    a0[0] += w0[k][0] * bflo(v.x); a0[1] += w0[k][1] * bfhi(v.x); a0[2] += w0[k][2] * bflo(v.y); a0[3] += w0[k][3] * bfhi(v.y);
                    a1[0] += w1[k][0] * bflo(v.z); a1[1] += w1[k][1] * bfhi(v.z); a1[2] += w1[k][2] * bflo(v.w); a1[3] += w1[k][3] * bfhi(v.w); }
                u32x4 o; o.x = cvt_pk_bf16(silu_f(a0[0]), silu_f(a0[1])); o.y = cvt_pk_bf16(silu_f(a0[2]), silu_f(a0[3]));
                o.z = cvt_pk_bf16(silu_f(a1[0]), silu_f(a1[1])); o.w = cvt_pk_bf16(silu_f(a1[2]), silu_f(a1[3]));
                *(u32x4*)(XO + (size_t)(m0 + r) * 2048 + c) = o;
            }
        }
    }
    for (int m = gw; m < M; m += NGW) {
        const unsigned* sm = (const unsigned*)(SM + (size_t)m * 768);
        {
            unsigned w[3]; float ss = 0.f;
#pragma unroll
            for (int i = 0; i < 3; ++i) { w[i] = sm[lane + 64 * i]; const float a = bflo(w[i]), b = bfhi(w[i]); ss += a * a + b * b; }
            const float rs = rsqrtf(wave_sum(ss) * (1.f / 384.f) + EPS);
#pragma unroll
            for (int i = 0; i < 3; ++i) ((unsigned*)(CQN + (size_t)m * 384))[lane + 64 * i] = cvt_pk_bf16(bflo(w[i]) * rs, bfhi(w[i]) * rs);
        }
        {
            unsigned w[2]; float ss = 0.f;
#pragma unroll
            for (int i = 0; i < 2; ++i) { w[i] = sm[192 + lane + 64 * i]; const float a = bflo(w[i]), b = bfhi(w[i]); ss += a * a + b * b; }
            const float rs = rsqrtf(wave_sum(ss) * (1.f / 256.f) + EPS);
#pragma unroll
            for (int i = 0; i < 2; ++i) ((unsigned*)(CKVN + (size_t)m * 256))[lane + 64 * i] = cvt_pk_bf16(bflo(w[i]) * rs, bfhi(w[i]) * rs);
        }
        {
            const bf16_t* sr = SM + (size_t)m * 768;
            const float v = bf1(sr[640 + (lane & 31)]); const float pr = __shfl_xor(v, 16); const int i = lane & 15;
            const float c = COS[(size_t)m * 16 + i], s = SIN[(size_t)m * 16 + i];
            const float o = (lane & 16) ? (v * c + pr * s) : (v * c - pr * s);
            if (lane < 32) KPE[(size_t)m * 32 + lane] = tobf(o);
            const float d = bf1(sr[672 + (lane & 15)]) + p.dt_bias[L * 16 + (lane & 15)];
            const float sp = fmaxf(d, 0.f) + __logf(1.f + __expf(-fabsf(d)));
            if (lane < 16) DT[(size_t)m * 16 + lane] = sp;
        }
    }
}

__device__ __forceinline__ void pass_ycnorm(const P& p, int gw, int NGW, int lane_unused) {
    const int lane = fresh_tid() & 63;
    unsigned char* ws = p.ws; asm volatile("" : "+s"(ws));
    bf16_t* YC = (bf16_t*)(ws + WS_YC);
    for (int m0 = gw; m0 < M; m0 += 2 * NGW) {
        u32x4 v[2][4];
#pragma unroll
        for (int q = 0; q < 2; ++q) { const int m = m0 + q * NGW; if (m < M) {
#pragma unroll
            for (int j = 0; j < 4; ++j) v[q][j] = ((const u32x4*)(YC + (size_t)m * 2048))[lane + 64 * j]; } }
#pragma unroll
        for (int q = 0; q < 2; ++q) { const int m = m0 + q * NGW; if (m < M) {
            u32x4* row = (u32x4*)(YC + (size_t)m * 2048); float s[2] = {0.f, 0.f};
#pragma unroll
            for (int j = 0; j < 4; ++j) { const u32x4 w = v[q][j]; float a = 0.f;
                a += bflo(w.x) * bflo(w.x) + bfhi(w.x) * bfhi(w.x); a += bflo(w.y) * bflo(w.y) + bfhi(w.y) * bfhi(w.y);
                a += bflo(w.z) * bflo(w.z) + bfhi(w.z) * bfhi(w.z); a += bflo(w.w) * bflo(w.w) + bfhi(w.w) * bfhi(w.w);
                s[j >> 1] += a; }
            const float r0 = rsqrtf(wave_sum(s[0]) * (1.f / 1024.f) + EPS), r1 = rsqrtf(wave_sum(s[1]) * (1.f / 1024.f) + EPS);
#pragma unroll
            for (int j = 0; j < 4; ++j) { const float r = (j < 2) ? r0 : r1; const u32x4 w = v[q][j]; u32x4 o;
                o.x = cvt_pk_bf16(bflo(w.x) * r, bfhi(w.x) * r); o.y = cvt_pk_bf16(bflo(w.y) * r, bfhi(w.y) * r);
                o.z = cvt_pk_bf16(bflo(w.z) * r, bfhi(w.z) * r); o.w = cvt_pk_bf16(bflo(w.w) * r, bfhi(w.w) * r);
                row[lane + 64 * j] = o; } } }
    }
}

__device__ __forceinline__ void pass_ffnact(const P& p, int L, int half, int gw, int NGW, int lane_unused) {
    const int lane = fresh_tid() & 63;
    unsigned char* ws = p.ws; asm volatile("" : "+s"(ws));
    const bf16_t* U = (const bf16_t*)(ws + WS_U); bf16_t* ACT = (bf16_t*)(ws + WS_ACT) + (size_t)half * 8192 * DFF;
    const float* cw = p.ffn_conv_w + (size_t)L * 3 * 5632; const float* cb = p.ffn_conv_b + (size_t)L * 5632;
    for (int blk = gw; blk < 8192 / 4; blk += NGW) {
        const int m0 = blk * 4, t0 = m0 & (SEQ - 1);
        for (int ch = lane; ch < DFF / 8; ch += 64) {
            const int c = ch * 8;
            const f32x4 bg0 = *(const f32x4*)(cb + c), bg1 = *(const f32x4*)(cb + c + 4), bv0 = *(const f32x4*)(cb + DFF + c), bv1 = *(const f32x4*)(cb + DFF + c + 4);
            f32x4 wg0[3], wg1[3], wv0[3], wv1[3];
#pragma unroll
            for (int k = 0; k < 3; ++k) { const float* wk = cw + k * 5632; wg0[k] = *(const f32x4*)(wk + c); wg1[k] = *(const f32x4*)(wk + c + 4); wv0[k] = *(const f32x4*)(wk + DFF + c); wv1[k] = *(const f32x4*)(wk + DFF + c + 4); }
            u32x4 ug[6], uv[6];
#pragma unroll
            for (int i = 0; i < 6; ++i) { if (t0 - 2 + i >= 0) { const bf16_t* ur = U + (size_t)(m0 - 2 + i) * 5632; ug[i] = *(const u32x4*)(ur + c); uv[i] = *(const u32x4*)(ur + DFF + c); }
                else { ug[i] = (u32x4){0u, 0u, 0u, 0u}; uv[i] = (u32x4){0u, 0u, 0u, 0u}; } }
#pragma unroll
            for (int r = 0; r < 4; ++r) {
                f32x4 g0 = bg0, g1 = bg1, v0 = bv0, v1 = bv1;
#pragma unroll
                for (int k = 0; k < 3; ++k) { const u32x4 a = ug[r + k], b = uv[r + k];
                    g0[0] += wg0[k][0] * bflo(a.x); g0[1] += wg0[k][1] * bfhi(a.x); g0[2] += wg0[k][2] * bflo(a.y); g0[3] += wg0[k][3] * bfhi(a.y);
                    g1[0] += wg1[k][0] * bflo(a.z); g1[1] += wg1[k][1] * bfhi(a.z); g1[2] += wg1[k][2] * bflo(a.w); g1[3] += wg1[k][3] * bfhi(a.w);
                    v0[0] += wv0[k][0] * bflo(b.x); v0[1] += wv0[k][1] * bfhi(b.x); v0[2] += wv0[k][2] * bflo(b.y); v0[3] += wv0[k][3] * bfhi(b.y);
                    v1[0] += wv1[k][0] * bflo(b.z); v1[1] += wv1[k][1] * bfhi(b.z); v1[2] += wv1[k][2] * bflo(b.w); v1[3] += wv1[k][3] * bfhi(b.w); }
                u32x4 o; o.x = cvt_pk_bf16(silu_f(g0[0]) * v0[0], silu_f(g0[1]) * v0[1]); o.y = cvt_pk_bf16(silu_f(g0[2]) * v0[2], silu_f(g0[3]) * v0[3]);
                o.z = cvt_pk_bf16(silu_f(g1[0]) * v1[0], silu_f(g1[1]) * v1[1]); o.w = cvt_pk_bf16(silu_f(g1[2]) * v1[2], silu_f(g1[3]) * v1[3]);
                *(u32x4*)(ACT + (size_t)(m0 + r) * DFF + c) = o;
            }
        }
    }
}

__device__ __forceinline__ void pass_final(const P& p, int gw, int NGW, int lane_unused) {
    const int lane = fresh_tid() & 63;
    const float* rss = (const float*)(p.ws + WS_RSP);
    for (int m = gw; m < M; m += NGW) {
        const float rs = rsqrtf(rss16(rss, m) * (1.f / 1024.f) + EPS);
        f32x4* xr = (f32x4*)(p.out + (size_t)m * 1024) + lane; const f32x4* g = (const f32x4*)p.final_norm + lane;
#pragma unroll
        for (int j = 0; j < 4; ++j) { f32x4 v = xr[64 * j]; v = v * rs * g[64 * j]; xr[64 * j] = v; }
    }
}

typedef short v4i16_t __attribute__((ext_vector_type(4)));
__device__ __forceinline__ s16x4 vtr(const LAS unsigned char* p) { return __builtin_bit_cast(s16x4, __builtin_amdgcn_ds_read_tr16_b64_v4i16((LAS v4i16_t*)p)); }
__device__ __forceinline__ bf16x8 join8(s16x4 lo, s16x4 hi) { return (bf16x8){lo[0], lo[1], lo[2], lo[3], hi[0], hi[1], hi[2], hi[3]}; }
__device__ __forceinline__ bf16x8 pack8(const f32x16& s, int b) {
    u32x4 w; w.x = cvt_pk_bf16(s[b], s[b + 1]); w.y = cvt_pk_bf16(s[b + 2], s[b + 3]); w.z = cvt_pk_bf16(s[b + 4], s[b + 5]); w.w = cvt_pk_bf16(s[b + 6], s[b + 7]);
    return __builtin_bit_cast(bf16x8, w);
}

template <int DQK, int DV, bool CAUSAL, bool K2>
__device__ __forceinline__ void attn_unit(LAS unsigned char* lds, const bf16_t* Q, int qpitch, const bf16_t* Qp2, int q2pitch, const bf16_t* K, int kpitch, const bf16_t* Kp2, int k2pitch,
                                          const bf16_t* V, int vpitch, bf16_t* O, int opitch, int q0, int NT) {
    constexpr int KP = (DQK + 8) * 2, VP = (DV == 64) ? 192 : 320;
    constexpr int KBUF = 64 * KP, VBUF = 64 * VP, BUF = KBUF + VBUF;
    constexpr int KCH = DQK / 8, VCH = DV / 8, NKC = 64 * KCH, NVC = 64 * VCH;
    constexpr int NKR = (NKC + 511) / 512, NVR = NVC / 512;
    const int tid = fresh_tid(), lane = tid & 63, w = __builtin_amdgcn_readfirstlane(tid >> 6), ql = lane & 31, hi = lane >> 5;
    u32x4 kreg[NKR], vreg[NVR];
    auto gload = [&](int t) {
#pragma unroll
        for (int i = 0; i < NKR; ++i) { const int id = tid + 512 * i;
            if (id < NKC) { const int row = id / KCH, c = id % KCH; const size_t kv = (size_t)(64 * t + row);
                if (K2 && c >= (DQK - 32) / 8) kreg[i] = *(const u32x4*)(Kp2 + kv * k2pitch + (c - (DQK - 32) / 8) * 8);
                else kreg[i] = *(const u32x4*)(K + kv * kpitch + c * 8); } }
#pragma unroll
        for (int i = 0; i < NVR; ++i) { const int id = tid + 512 * i; const int row = id / VCH, c = id % VCH;
            vreg[i] = *(const u32x4*)(V + (size_t)(64 * t + row) * vpitch + c * 8); }
    };
    auto lstore = [&](int b) {
        LAS unsigned char* kb = lds + b * BUF; LAS unsigned char* vb = kb + KBUF;
#pragma unroll
        for (int i = 0; i < NKR; ++i) { const int id = tid + 512 * i; if (id < NKC) { const int row = id / KCH, c = id % KCH; *(LAS u32x4*)(kb + row * KP + c * 16) = kreg[i]; } }
#pragma unroll
        for (int i = 0; i < NVR; ++i) { const int id = tid + 512 * i; const int row = id / VCH, c = id % VCH; *(LAS u32x4*)(vb + row * VP + c * 16) = vreg[i]; }
    };
    gload(0);
    bf16x8 qf[DQK / 16];
#pragma unroll
    for (int d0 = 0; d0 < DQK / 16; ++d0) {
        if (K2 && d0 >= (DQK - 32) / 16) qf[d0] = *(const bf16x8*)(Qp2 + (size_t)(32 * w + ql) * q2pitch + 16 * (d0 - (DQK - 32) / 16) + 8 * hi);
        else qf[d0] = *(const bf16x8*)(Q + (size_t)(32 * w + ql) * qpitch + 16 * d0 + 8 * hi); }
    f32x16 oacc[DV / 32];
#pragma unroll
    for (int i = 0; i < DV / 32; ++i)
#pragma unroll
        for (int r = 0; r < 16; ++r) oacc[i][r] = 0.f;
    float m_run = -INFINITY, l_run = 0.f;
    const int q0w = q0 + 32 * w, qg = q0w + ql;
    lstore(0);
    __syncthreads();
    const int vtoff = (4 * hi + ((lane & 15) >> 2)) * VP + (16 * ((lane >> 4) & 1) + 4 * (lane & 3)) * 2;
    for (int t = 0; t < NT; ++t) {
        if (t + 1 < NT) gload(t + 1);
        const bool active = !CAUSAL || (64 * t <= q0w + 31);
        if (active) {
            const LAS unsigned char* kb = lds + (t & 1) * BUF; const LAS unsigned char* vb = kb + KBUF;
            f32x16 s0, s1;
#pragma unroll
            for (int r = 0; r < 16; ++r) { s0[r] = 0.f; s1[r] = 0.f; }
            if (DQK <= 128) __builtin_amdgcn_s_setprio(1);
#pragma unroll
            for (int d0 = 0; d0 < DQK / 16; ++d0) {
                const bf16x8 a0 = *(const LAS bf16x8*)(kb + ql * KP + (16 * d0 + 8 * hi) * 2);
                const bf16x8 a1 = *(const LAS bf16x8*)(kb + (32 + ql) * KP + (16 * d0 + 8 * hi) * 2);
                s0 = __builtin_amdgcn_mfma_f32_32x32x16_bf16(a0, qf[d0], s0, 0, 0, 0);
                s1 = __builtin_amdgcn_mfma_f32_32x32x16_bf16(a1, qf[d0], s1, 0, 0, 0);
            }
            if (DQK <= 128) __builtin_amdgcn_s_setprio(0);
            if (CAUSAL && (64 * t + 63 > q0w)) {
#pragma unroll
                for (int r = 0; r < 16; ++r) { const int kv = 64 * t + crow(r, hi); if (kv > qg) s0[r] = -INFINITY; if (kv + 32 > qg) s1[r] = -INFINITY; }
            }
            float mx = s0[0];
#pragma unroll
            for (int r = 1; r < 16; ++r) mx = fmaxf(mx, s0[r]);
#pragma unroll
            for (int r = 0; r < 16; ++r) mx = fmaxf(mx, s1[r]);
            mx = fmaxf(mx, __shfl_xor(mx, 32));
            const float m_new = fmaxf(m_run, mx);
            const float alpha = __builtin_amdgcn_exp2f(m_run - m_new);
            m_run = m_new;
            float ps = 0.f;
#pragma unroll
            for (int r = 0; r < 16; ++r) { s0[r] = __builtin_amdgcn_exp2f(s0[r] - m_new); s1[r] = __builtin_amdgcn_exp2f(s1[r] - m_new); ps += s0[r] + s1[r]; }
            l_run = l_run * alpha + ps;
            if (__any(alpha != 1.f)) {
#pragma unroll
                for (int i = 0; i < DV / 32; ++i)
#pragma unroll
                    for (int r = 0; r < 16; ++r) oacc[i][r] *= alpha;
            }
            const bf16x8 p00 = pack8(s0, 0), p01 = pack8(s0, 8), p10 = pack8(s1, 0), p11 = pack8(s1, 8);
            if (DQK <= 128) __builtin_amdgcn_s_setprio(1);
#pragma unroll
            for (int i = 0; i < DV / 32; ++i) {
                const LAS unsigned char* vp = vb + vtoff + i * 64;
                { const bf16x8 a = join8(vtr(vp + (0) * VP), vtr(vp + (8) * VP)); oacc[i] = __builtin_amdgcn_mfma_f32_32x32x16_bf16(a, p00, oacc[i], 0, 0, 0); }
                { const bf16x8 a = join8(vtr(vp + (16) * VP), vtr(vp + (24) * VP)); oacc[i] = __builtin_amdgcn_mfma_f32_32x32x16_bf16(a, p01, oacc[i], 0, 0, 0); }
                { const bf16x8 a = join8(vtr(vp + (32) * VP), vtr(vp + (40) * VP)); oacc[i] = __builtin_amdgcn_mfma_f32_32x32x16_bf16(a, p10, oacc[i], 0, 0, 0); }
                { const bf16x8 a = join8(vtr(vp + (48) * VP), vtr(vp + (56) * VP)); oacc[i] = __builtin_amdgcn_mfma_f32_32x32x16_bf16(a, p11, oacc[i], 0, 0, 0); }
            }
            if (DQK <= 128) __builtin_amdgcn_s_setprio(0);
        }
        if (t + 1 < NT) lstore((t + 1) & 1);
        __syncthreads();
    }
    const float lt = l_run + __shfl_xor(l_run, 32); const float inv = 1.f / lt;
    bf16_t* orow = O + (size_t)(32 * w + ql) * opitch;
#pragma unroll
    for (int i = 0; i < DV / 32; ++i)
#pragma unroll
        for (int rr = 0; rr < 4; ++rr) { u32x2 o; o.x = cvt_pk_bf16(oacc[i][4 * rr] * inv, oacc[i][4 * rr + 1] * inv); o.y = cvt_pk_bf16(oacc[i][4 * rr + 2] * inv, oacc[i][4 * rr + 3] * inv);
            *(u32x2*)(orow + 32 * i + 8 * rr + 4 * hi) = o; }
}

constexpr int SS_BP = 272, SS_XP = 144;
constexpr int SS_B = 0, SS_C = 34816, SS_XD = 69632  , SS_XDD = 88064  , SS_ZI = 106496  , SS_SB = 124928, SS_CS = 142336, SS_DT = 142848;
constexpr int SS_ECS = SS_DT + 512, SS_CSD = SS_DT + 1024;
static_assert(SS_CSD + 512 <= LDS_BYTES - 64, "SSD LDS map");
__device__ __forceinline__ void ssd_unit(const P& p, int L, LAS unsigned char* lds, int b, int h) {
    unsigned char* ws = p.ws; asm volatile("" : "+s"(ws));
    const bf16_t* XBC = (const bf16_t*)(ws + WS_XBC); const bf16_t* Z = (const bf16_t*)(ws + WS_Z); const float* DT = (const float*)(ws + WS_DT); bf16_t* YC = (bf16_t*)(ws + WS_YC);
    const int tid = fresh_tid(), lane = tid & 63, w = __builtin_amdgcn_readfirstlane(tid >> 6), ql = lane & 31, hi = lane >> 5;
    const int g = h >> 2;
    const float Ah = -__expf(p.a_log[L * 16 + h]); const float dsk = p.d_skip[L * 16 + h];
    const int lb = (w < 4) ? w : (7 - w), pb = (w >> 1) & 1;
    LAS float* CS = (LAS float*)(lds + SS_CS); LAS float* DTS = (LAS float*)(lds + SS_DT);
    f32x16 sacc;
#pragma unroll
    for (int r = 0; r < 16; ++r) sacc[r] = 0.f;
    for (int i = tid; i < 64 * SS_BP / 4; i += 512) ((LAS unsigned*)(lds + SS_SB))[i] = 0u;
    u32x4 breg[4], creg[4], xreg[2], zreg[2]; float dreg[2] = {0.f, 0.f};
    auto gload = [&](int c) {
        const size_t m0 = (size_t)b * SEQ + (size_t)c * 128;
#pragma unroll
        for (int i = 0; i < 4; ++i) { const int id = tid + 512 * i, row = id >> 4, c16 = id & 15;
            breg[i] = *(const u32x4*)(XBC + (m0 + row) * 2048 + 1024 + g * 128 + 8 * c16);
            creg[i] = *(const u32x4*)(XBC + (m0 + row) * 2048 + 1536 + g * 128 + 8 * c16); }
#pragma unroll
        for (int i = 0; i < 2; ++i) { const int id = tid + 512 * i, row = id >> 3, c8 = id & 7; xreg[i] = *(const u32x4*)(XBC + (m0 + row) * 2048 + h * 64 + 8 * c8); zreg[i] = *(const u32x4*)(Z + (m0 + row) * 1024 + h * 64 + 8 * c8); }
        if (w == 0) { dreg[0] = DT[(m0 + 2 * lane) * 16 + h]; dreg[1] = DT[(m0 + 2 * lane + 1) * 16 + h]; }
    };
    gload(0);
    const int troff = (((lane & 15) >> 2)) ;
    const int tcol = 16 * ((lane >> 4) & 1) + 4 * (lane & 3);
    for (int c = 0; c < 16; ++c) {
        const size_t m0 = (size_t)b * SEQ + (size_t)c * 128;
        if (w == 0) {
            const float v0 = dreg[0] * Ah, v1 = dreg[1] * Ah; float s = v0 + v1;
#pragma unroll
            for (int o = 1; o < 64; o <<= 1) { const float t = __shfl_up(s, o); if (lane >= o) s += t; }
            CS[2 * lane] = s - v1; CS[2 * lane + 1] = s; DTS[2 * lane] = dreg[0]; DTS[2 * lane + 1] = dreg[1];
            { LAS float* ECS = (LAS float*)(lds + SS_ECS); LAS float* CSD = (LAS float*)(lds + SS_CSD);
              ECS[2 * lane] = __expf(s - v1); ECS[2 * lane + 1] = __expf(s); CSD[2 * lane] = (s - v1) - __logf(dreg[0]); CSD[2 * lane + 1] = s - __logf(dreg[1]); }
        }
#pragma unroll
        for (int i = 0; i < 4; ++i) { const int id = tid + 512 * i, row = id >> 4, c16 = id & 15;
            *(LAS u32x4*)(lds + SS_B + row * SS_BP + c16 * 16) = breg[i]; *(LAS u32x4*)(lds + SS_C + row * SS_BP + c16 * 16) = creg[i]; }
        __syncthreads();
        { const float cend = CS[127];
#pragma unroll
          for (int i = 0; i < 2; ++i) { const int id = tid + 512 * i, row = id >> 3, c8 = id & 7; const float e = DTS[row] * __expf(cend - CS[row]);
              const u32x4 v = xreg[i]; u32x4 o2;
              o2.x = cvt_pk_bf16(bflo(v.x) * e, bfhi(v.x) * e); o2.y = cvt_pk_bf16(bflo(v.y) * e, bfhi(v.y) * e); o2.z = cvt_pk_bf16(bflo(v.z) * e, bfhi(v.z) * e); o2.w = cvt_pk_bf16(bflo(v.w) * e, bfhi(v.w) * e);
              *(LAS u32x4*)(lds + SS_XD + row * SS_XP + c8 * 16) = v; *(LAS u32x4*)(lds + SS_XDD + row * SS_XP + c8 * 16) = o2; *(LAS u32x4*)(lds + SS_ZI + row * SS_XP + c8 * 16) = zreg[i]; } }
        __syncthreads();
        if (c + 1 < 16) gload(c + 1);
        f32x16 yacc, oac;
#pragma unroll
        for (int r = 0; r < 16; ++r) { yacc[r] = 0.f; oac[r] = 0.f; }
        const float cs_l = CS[32 * lb + ql];
        for (int sb = 0; sb <= lb; ++sb) {
            f32x16 gt;
#pragma unroll
            for (int r = 0; r < 16; ++r) gt[r] = 0.f;
#pragma unroll
            for (int ks = 0; ks < 8; ++ks) {
                const bf16x8 a = *(const LAS bf16x8*)(lds + SS_B + (32 * sb + ql) * SS_BP + (16 * ks + 8 * hi) * 2);
                const bf16x8 bb = *(const LAS bf16x8*)(lds + SS_C + (32 * lb + ql) * SS_BP + (16 * ks + 8 * hi) * 2);
                gt = __builtin_amdgcn_mfma_f32_32x32x16_bf16(a, bb, gt, 0, 0, 0);
            }
            const int lg = 32 * lb + ql;
#pragma unroll
            for (int r = 0; r < 16; ++r) { const int s = 32 * sb + crow(r, hi); const float e = __expf(cs_l - ((const LAS float*)(lds + SS_CSD))[s]); gt[r] = (s <= lg) ? gt[r] * e : 0.f; }
            const bf16x8 w0 = pack8(gt, 0), w1 = pack8(gt, 8);
            const LAS unsigned char* xp = lds + SS_XD + (32 * sb + 4 * hi + troff) * SS_XP + (32 * pb + tcol) * 2;
            { const bf16x8 bx = join8(vtr(xp), vtr(xp + 8 * SS_XP)); yacc = __builtin_amdgcn_mfma_f32_32x32x16_bf16(w0, bx, yacc, 0, 0, 0); }
            { const bf16x8 bx = join8(vtr(xp + 16 * SS_XP), vtr(xp + 24 * SS_XP)); yacc = __builtin_amdgcn_mfma_f32_32x32x16_bf16(w1, bx, yacc, 0, 0, 0); }
        }
#pragma unroll
        for (int ks = 0; ks < 8; ++ks) {
            const bf16x8 a = *(const LAS bf16x8*)(lds + SS_C + (32 * lb + ql) * SS_BP + (16 * ks + 8 * hi) * 2);
            const bf16x8 bb = *(const LAS bf16x8*)(lds + SS_SB + (32 * pb + ql) * SS_BP + (16 * ks + 8 * hi) * 2);
            oac = __builtin_amdgcn_mfma_f32_32x32x16_bf16(a, bb, oac, 0, 0, 0);
        }
#pragma unroll
        for (int r = 0; r < 16; ++r) { const int l = 32 * lb + crow(r, hi); const size_t m = m0 + l; const int col = h * 64 + 32 * pb + ql;
            const float xv = bf1(*(const LAS bf16_t*)(lds + SS_XD + l * SS_XP + (32 * pb + ql) * 2)); const float zv = bf1(*(const LAS bf16_t*)(lds + SS_ZI + l * SS_XP + (32 * pb + ql) * 2));
            const float y = yacc[r] + oac[r] * ((const LAS float*)(lds + SS_ECS))[l] + xv * dsk;
            YC[m * 2048 + col] = tobf(y * silu_f(zv)); }
        { const float dec = __expf(CS[127]);
#pragma unroll
          for (int r = 0; r < 16; ++r) sacc[r] *= dec;
#pragma unroll
          for (int st = 0; st < 8; ++st) {
              const LAS unsigned char* ap = lds + SS_XDD + (16 * st + 8 * hi + troff) * SS_XP + (32 * pb + tcol) * 2;
              const LAS unsigned char* bp = lds + SS_B + (16 * st + 8 * hi + troff) * SS_BP + (32 * lb + tcol) * 2;
              const bf16x8 a = join8(vtr(ap), vtr(ap + 4 * SS_XP)); const bf16x8 bb = join8(vtr(bp), vtr(bp + 4 * SS_BP));
              sacc = __builtin_amdgcn_mfma_f32_32x32x16_bf16(a, bb, sacc, 0, 0, 0);
          } }
        __syncthreads();
#pragma unroll
        for (int r = 0; r < 16; ++r) *(LAS bf16_t*)(lds + SS_SB + (32 * pb + crow(r, hi)) * SS_BP + (32 * lb + ql) * 2) = tobf(sacc[r]);
    }
    __syncthreads();
}

#define XB_TMO      128
#define XB_XCNT(j)  (256  + 64 * (j))
#define XB_XSUB(j)  (1280 + 64 * (j))
#define XB_XGEN(j)  (2304 + 64 * (j))
#define XB_TOP      3328
#define XB_TOPGEN   3392
#define XCD_BAR_WORDS 3456
#define XB_SPIN_CAP (1u << 18)

__device__ __forceinline__ unsigned xb_ld(unsigned* p)              { return __hip_atomic_load(p, __ATOMIC_RELAXED, __HIP_MEMORY_SCOPE_AGENT); }
__device__ __forceinline__ unsigned xb_add(unsigned* p, unsigned v) { return __hip_atomic_fetch_add(p, v, __ATOMIC_RELAXED, __HIP_MEMORY_SCOPE_AGENT); }
__device__ __forceinline__ unsigned xb_xcc_id() { return (unsigned)__builtin_amdgcn_s_getreg((3 << 11) | 20) & 0xFu; }
#define XB_SPIN(cond, bar) do { unsigned _sp = 0; while (cond) { __builtin_amdgcn_s_sleep(1); \
    if ((++_sp & 255u) == 0u) { if (xb_ld(&(bar)[XB_TMO])) break; if (_sp > XB_SPIN_CAP) { atomicAdd(&(bar)[XB_TMO], 1u); break; } } } } while (0)

struct XcdBarrier {
    unsigned* bar; unsigned x;
    volatile LAS unsigned* st;
};

__device__ __forceinline__ XcdBarrier xcd_barrier_post(unsigned* bar, volatile LAS unsigned* st) {
    XcdBarrier b; b.bar = bar; b.x = xb_xcc_id(); b.st = st;
    if (threadIdx.x == 0) (void)xb_add(&bar[XB_XCNT(b.x)], 1u);
    return b;
}
__device__ __forceinline__ void xcd_barrier_complete(unsigned* bar, unsigned x, unsigned& nloc, unsigned& nx) {
    const unsigned G = gridDim.x * gridDim.y * gridDim.z;
    unsigned sum, cnt, mine, sp = 0u;
    for (;;) {
        sum = 0u; cnt = 0u; mine = 0u;
#pragma unroll
        for (unsigned j = 0; j < 16; ++j) { const unsigned c = xb_ld(&bar[XB_XCNT(j)]); sum += c; cnt += (c > 0u) ? 1u : 0u; mine = (j == x) ? c : mine; }
        if (sum == G) break;
        __builtin_amdgcn_s_sleep(1);
        if ((++sp & 255u) == 0u) { if (xb_ld(&bar[XB_TMO])) break; if (sp > XB_SPIN_CAP) { atomicAdd(&bar[XB_TMO], 1u); break; } }
    }
    nloc = mine > 0u ? mine : 1u; nx = cnt > 0u ? cnt : 1u;
}

__device__ __forceinline__ void xcd_barrier(const XcdBarrier& b) {
    asm volatile("s_waitcnt vmcnt(0)" ::: "memory");
    __syncthreads();
    if (threadIdx.x == 0) {
        unsigned* bar = b.bar; unsigned bx_ = b.x; asm volatile("" : "+s"(bar), "+s"(bx_));
        __builtin_amdgcn_s_waitcnt(0);
        unsigned nloc = b.st[0], nx = b.st[1];
        if (nloc == 0u) { xcd_barrier_complete(bar, bx_, nloc, nx); b.st[0] = nloc; b.st[1] = nx; }
        const unsigned old = xb_add(&bar[XB_XSUB(bx_)], 1u);
        const unsigned gen = old / nloc;
        if (old + 1u == (gen + 1u) * nloc) {
            __builtin_amdgcn_fence(__ATOMIC_RELEASE, "agent");
            asm volatile("s_waitcnt vmcnt(0)" ::: "memory");
            const unsigned og = xb_add(&bar[XB_TOP], 1u);
            const unsigned tg = og / nx;
            if (og + 1u == (tg + 1u) * nx) xb_add(&bar[XB_TOPGEN], 1u);
            else XB_SPIN(xb_ld(&bar[XB_TOPGEN]) == tg, bar);
            __builtin_amdgcn_fence(__ATOMIC_ACQUIRE, "agent");
            xb_add(&bar[XB_XGEN(bx_)], 1u);
            asm volatile("s_waitcnt vmcnt(0)" ::: "memory");
        } else {
            XB_SPIN(xb_ld(&bar[XB_XGEN(bx_)]) == gen, bar);
            __builtin_amdgcn_fence(__ATOMIC_ACQUIRE, "agent");
            asm volatile("s_waitcnt vmcnt(0)" ::: "memory");
        }
    }
    __syncthreads();
}

__device__ __forceinline__ void my_grid_sync(unsigned* bar, unsigned& gen) {
    asm volatile("s_waitcnt vmcnt(0) lgkmcnt(0)" ::: "memory");
    __syncthreads();
    gen += 1u;
    if (threadIdx.x == 0) {
        __builtin_amdgcn_fence(__ATOMIC_RELEASE, "agent");
        asm volatile("s_waitcnt vmcnt(0)" ::: "memory");
        __hip_atomic_fetch_add(bar, 1u, __ATOMIC_RELAXED, __HIP_MEMORY_SCOPE_AGENT);
        const unsigned target = gen * gridDim.x;
        while (__hip_atomic_load(bar, __ATOMIC_RELAXED, __HIP_MEMORY_SCOPE_AGENT) < target) __builtin_amdgcn_s_sleep(1);
        __builtin_amdgcn_fence(__ATOMIC_ACQUIRE, "agent");
        asm volatile("s_waitcnt vmcnt(0)" ::: "memory");
    }
    __syncthreads();
    asm volatile("buffer_inv sc1\n\ts_waitcnt vmcnt(0)" ::: "memory");
}
#ifdef DUP_SYNC
#define SYNC2() xcd_barrier(xbar)
#else
#define SYNC2() do {} while (0)
#endif
#define GRID_SYNC() do { xcd_barrier(xbar); SYNC2(); ws = p.ws; asm volatile("" : "+s"(ws)); RSS = (float*)(ws + WS_RSP); XB = (bf16_t*)(ws + WS_XB); } while (0)
__global__ void __launch_bounds__(512, 2) trunk_fwd(P p) {
    extern __shared__ __attribute__((aligned(16))) unsigned char lds_raw[];
    cg::grid_group grid = cg::this_grid();
    LAS unsigned char* lds = (LAS unsigned char*)lds_raw;
    const int tid = threadIdx.x, lane = tid & 63, wave = __builtin_amdgcn_readfirstlane(tid >> 6);
    const int G = gridDim.x, gw = blockIdx.x * 8 + wave, NGW = G * 8;
    LAS float* scr = (LAS float*)(lds + wave * 16384);
    const int vcu = (G % 8 == 0) ? ((int)blockIdx.x % 8) * (G / 8) + (int)blockIdx.x / 8 : (int)blockIdx.x;
    unsigned char* ws = p.ws; asm volatile("" : "+s"(ws));
    float* RSS = (float*)(ws + WS_RSP);
    bf16_t* XB = (bf16_t*)(ws + WS_XB);

    volatile LAS unsigned* bst = (volatile LAS unsigned*)(lds + (LDS_BYTES - 64));
    if (tid < 2) bst[tid] = 0u;
    __syncthreads();
    grid.sync();
    XcdBarrier xbar = xcd_barrier_post((unsigned*)(p.ws + WS_RSS), bst);
#ifndef SKIP_PRO
    prologue(p, scr, gw, NGW, lane);
#endif
    GRID_SYNC();
    { EpiRoute E{(bf16_t*)(ws + WS_KMVM), nullptr, nullptr, 8192, 0, 0, 1 << 30, 1 << 30, nullptr, 0.f, 1.f};
      run_gemm(lds, (const bf16_t*)(ws + WS_MEMN), (const bf16_t*)(ws + WS_WMKV), 2048, 8192, 1024, E); }

    for (int L = 0; L < DEPTH; ++L) {
        { EpiRoute E{(bf16_t*)(ws + WS_Z), (bf16_t*)(ws + WS_XBCPRE), (bf16_t*)(ws + WS_SM), 1024, 2048, 768, 4, 12, RSS, 1.f / 1024.f, 1.f};
          run_gemm(lds, XB, (const bf16_t*)(ws + WS_WIN), M, NIN, 1024, E); }
#ifdef DUP_G1
        { EpiRoute E{(bf16_t*)(ws + WS_Z), (bf16_t*)(ws + WS_XBCPRE), (bf16_t*)(ws + WS_SM), 1024, 2048, 768, 4, 12, RSS, 1.f / 1024.f, 1.f};
          run_gemm(lds, XB, (const bf16_t*)(ws + WS_WIN), M, NIN, 1024, E); }
#endif
        GRID_SYNC();
#ifndef SKIP_L2
        pass_l2(p, L, gw, NGW, lane);
#ifdef DUP_PASS
        pass_l2(p, L, gw, NGW, lane);
#endif
#endif
        GRID_SYNC();
#if defined(DBG_STOP) && DBG_STOP == 1
        { for (size_t i = (size_t)blockIdx.x * 512 + threadIdx.x; i < (size_t)M * 1024; i += (size_t)G * 512) { const size_t mm = i >> 10; const int cc = (int)(i & 1023); p.out[i] = bf1(((const bf16_t*)(ws + WS_XBC))[mm * 2048 + cc]) + bf1(((const bf16_t*)(ws + WS_XBC))[mm * 2048 + 1024 + cc]) + bf1(((const bf16_t*)(ws + WS_CQN))[mm * 384 + cc % 384]) + bf1(((const bf16_t*)(ws + WS_CKVN))[mm * 256 + cc % 256]) + bf1(((const bf16_t*)(ws + WS_KPE))[mm * 32 + cc % 32]) + ((const float*)(ws + WS_DT))[mm * 16 + cc % 16] + bf1(((const bf16_t*)(ws + WS_Z))[mm * 1024 + cc]); } return; }
#endif

#ifndef SKIP_SSD
        if (G >= 256) {
            if (blockIdx.x < 128) { const int su = ((int)blockIdx.x & 7) * 16 + ((int)blockIdx.x >> 3); ssd_unit(p, L, lds, su >> 4, su & 15); }
            else {
                { EpiRope E{(bf16_t*)(ws + WS_YC), (bf16_t*)(ws + WS_SM), (const float*)(ws + WS_COS), (const float*)(ws + WS_SIN), 0.10206207261596575f * LOG2E};
                  run_gemm_on(lds, (const bf16_t*)(ws + WS_CQN), (const bf16_t*)(ws + WS_WUQ), M, 1536, 384, E, 128, (int)blockIdx.x - 128); }
                { EpiRoute E{(bf16_t*)(ws + WS_KN), (bf16_t*)(ws + WS_VB), nullptr, 1024, 1024, 0, 4, 1 << 30, nullptr, 0.f, 1.f};
                  run_gemm_on(lds, (const bf16_t*)(ws + WS_CKVN), (const bf16_t*)(ws + WS_WUKV), M, 2048, 256, E, 128, (int)blockIdx.x - 128); }
                convert_layer(p, -1, -1, -1, L, scr, gw - 1024, NGW - 1024, lane); } }
        else { for (int u = blockIdx.x; u < NB * 16; u += G) ssd_unit(p, L, lds, u >> 4, u & 15);
               { EpiRope E{(bf16_t*)(ws + WS_YC), (bf16_t*)(ws + WS_SM), (const float*)(ws + WS_COS), (const float*)(ws + WS_SIN), 0.10206207261596575f * LOG2E};
                 run_gemm(lds, (const bf16_t*)(ws + WS_CQN), (const bf16_t*)(ws + WS_WUQ), M, 1536, 384, E); }
               { EpiRoute E{(bf16_t*)(ws + WS_KN), (bf16_t*)(ws + WS_VB), nullptr, 1024, 1024, 0, 4, 1 << 30, nullptr, 0.f, 1.f};
                 run_gemm(lds, (const bf16_t*)(ws + WS_CKVN), (const bf16_t*)(ws + WS_WUKV), M, 2048, 256, E); }
               convert_layer(p, -1, -1, -1, L, scr, gw, NGW, lane); }
#ifdef DUP_SSD
        for (int u = blockIdx.x; u < NB * 16; u += G) ssd_unit(p, L, lds, u >> 4, u & 15);
#endif
#endif
        GRID_SYNC();
#if defined(DBG_STOP) && DBG_STOP == 2
        { for (size_t i = (size_t)blockIdx.x * 512 + threadIdx.x; i < (size_t)M * 1024; i += (size_t)G * 512) { const size_t mm = i >> 10; const int cc = (int)(i & 1023); p.out[i] = bf1(((const bf16_t*)(ws + WS_YC))[mm * 2048 + cc]); } return; }
#endif

#ifndef SKIP_MLA
#ifdef DUP_MLA
        for (int rep_ = 0; rep_ < 2; ++rep_)
#endif
        { const int v = vcu;
          for (int uu = v; uu < 256; uu += G) { const int bh = uu >> 1, half = uu & 1, b = bh >> 4, h = bh & 15;
            for (int i = 0; i < 4; ++i) { const int qb = half ? ((i == 0) ? 1 : (i == 1) ? 6 : (i == 2) ? 2 : 5) : ((i == 0) ? 0 : (i == 1) ? 7 : (i == 2) ? 3 : 4);
                const size_t r0 = (size_t)b * SEQ;
                attn_unit<96, 64, true, true>(lds, (const bf16_t*)(ws + WS_YC) + (r0 + 256 * qb) * 2048 + 1024 + 64 * h, 2048, (const bf16_t*)(ws + WS_SM) + (r0 + 256 * qb) * 512 + 32 * h, 512,
                                              (const bf16_t*)(ws + WS_KN) + r0 * 1024 + 64 * h, 1024,
                                              (const bf16_t*)(ws + WS_KPE) + r0 * 32, 32, (const bf16_t*)(ws + WS_VB) + r0 * 1024 + 64 * h, 1024,
                                              (bf16_t*)(ws + WS_YC) + (r0 + 256 * qb) * 2048 + 1024 + 64 * h, 2048, 256 * qb, 4 * (qb + 1)); } } }
#endif
        GRID_SYNC();
#if defined(DBG_STOP) && DBG_STOP == 3
        { for (size_t i = (size_t)blockIdx.x * 512 + threadIdx.x; i < (size_t)M * 1024; i += (size_t)G * 512) { const size_t mm = i >> 10; const int cc = (int)(i & 1023); p.out[i] = bf1(((const bf16_t*)(ws + WS_YC))[mm * 2048 + 1024 + cc]); } return; }
#endif

#ifndef SKIP_YCN
        pass_ycnorm(p, gw, NGW, lane);
#endif
        convert_layer(p, L + 1, L + 1, L, -1, scr, gw, NGW, lane);
        GRID_SYNC();
        { EpiRes E{L == 0 ? p.x : p.out, p.out, XB, RSS + (size_t)16 * M};
          run_gemm(lds, (const bf16_t*)(ws + WS_YC), (const bf16_t*)(ws + WS_WOUT), M, 1024, 2048, E); }
        GRID_SYNC();
#if defined(DBG_STOP) && DBG_STOP == 4
        return;
#endif

#if defined(DBG_STOP) && DBG_STOP == 9
        { for (size_t i = (size_t)blockIdx.x * 512 + threadIdx.x; i < (size_t)M * 1024; i += (size_t)G * 512) { const size_t mm = i >> 10; const int cc = (int)(i & 1023); p.out[i] = bf1(XB[mm * 1024 + cc]); } return; }
#endif

#if defined(DBG_STOP) && DBG_STOP == 10
        { for (size_t i = (size_t)blockIdx.x * 512 + threadIdx.x; i < (size_t)M * 1024; i += (size_t)G * 512) { const size_t mm = i >> 10; const int cc = (int)(i & 1023); p.out[i] = (RSS + (size_t)16 * M)[(size_t)(cc & 3) * M * 4 + mm * 4 + ((cc >> 2) & 3)]; } return; }
#endif

        { EpiRoute E{(bf16_t*)(ws + WS_QM), nullptr, nullptr, 1024, 0, 0, 1 << 30, 1 << 30, RSS + (size_t)16 * M, 1.f / 1024.f, 0.0625f * LOG2E};
          run_gemm(lds, XB, (const bf16_t*)(ws + WS_WMQ), M, 1024, 1024, E); }
#ifdef DUP_G6
        { EpiRoute E{(bf16_t*)(ws + WS_QM), nullptr, nullptr, 1024, 0, 0, 1 << 30, 1 << 30, RSS + (size_t)16 * M, 1.f / 1024.f, 0.0625f * LOG2E};
          run_gemm(lds, XB, (const bf16_t*)(ws + WS_WMQ), M, 1024, 1024, E); }
#endif
        GRID_SYNC();
#if defined(DBG_STOP) && DBG_STOP == 7
        { for (size_t i = (size_t)blockIdx.x * 512 + threadIdx.x; i < (size_t)M * 1024; i += (size_t)G * 512) { const size_t mm = i >> 10; const int cc = (int)(i & 1023); p.out[i] = bf1(((const bf16_t*)(ws + WS_QM))[mm * 1024 + cc]); } return; }
#endif

#ifndef SKIP_MEM
        for (int uu = vcu; uu < 512; uu += G) { const int dh = uu & 1, qb = (uu >> 1) & 7, mh = (uu >> 4) & 3, b = uu >> 6;
            const bf16_t* KM = (const bf16_t*)(ws + WS_KMVM) + (size_t)(b * 256) * 8192 + L * 2048 + 256 * mh;
            attn_unit<256, 128, false, false>(lds, (const bf16_t*)(ws + WS_QM) + ((size_t)b * SEQ + 256 * qb) * 1024 + 256 * mh, 1024, nullptr, 0, KM, 8192, nullptr, 0,
                                              KM + 1024 + 128 * dh, 8192, (bf16_t*)(ws + WS_OM) + ((size_t)b * SEQ + 256 * qb) * 1024 + 256 * mh + 128 * dh, 1024, 0, 4); }
#endif
        GRID_SYNC();
#if defined(DBG_STOP) && DBG_STOP == 8
        { for (size_t i = (size_t)blockIdx.x * 512 + threadIdx.x; i < (size_t)M * 1024; i += (size_t)G * 512) { const size_t mm = i >> 10; const int cc = (int)(i & 1023); p.out[i] = bf1(((const bf16_t*)(ws + WS_OM))[mm * 1024 + cc]); } return; }
#endif

        { EpiRes E{p.out, p.out, XB, RSS + (size_t)32 * M};
          run_gemm(lds, (const bf16_t*)(ws + WS_OM), (const bf16_t*)(ws + WS_WMO), M, 1024, 1024, E); }
        GRID_SYNC();
#if defined(DBG_STOP) && DBG_STOP == 5
        return;
#endif

        { EpiGlu E{(bf16_t*)(ws + WS_ACT), RSS + (size_t)32 * M, p.ffn_conv_w + (size_t)L * 3 * 5632, p.ffn_conv_b + (size_t)L * 5632, (float*)(ws + WS_HALO), (float*)(ws + WS_PART), (LAS float*)(lds + 131072)};
          run_gemm(lds, XB, (const bf16_t*)(ws + WS_WUP), M, 5632, 1024, E); }
#ifdef DUP_G8
        { EpiGlu E{(bf16_t*)(ws + WS_ACT), RSS + (size_t)32 * M, p.ffn_conv_w + (size_t)L * 3 * 5632, p.ffn_conv_b + (size_t)L * 5632, (float*)(ws + WS_HALO), (float*)(ws + WS_PART), (LAS float*)(lds + 131072)};
          run_gemm(lds, XB, (const bf16_t*)(ws + WS_WUP), M, 5632, 1024, E); }
#endif
        GRID_SYNC();
        {
          const int nM_ = M / 256, nN_ = 4, nwg_ = nM_ * nN_;
          for (int i_ = 0; (long)i_ * G + (int)blockIdx.x < nwg_; ++i_) { int wg_ = i_ * G + (int)blockIdx.x;
              { const int q_ = nwg_ / 8, r_ = nwg_ % 8, xcd_ = wg_ % 8, off_ = wg_ / 8; wg_ = (xcd_ < r_ ? xcd_ * (q_ + 1) : r_ * (q_ + 1) + (xcd_ - r_) * q_) + off_; }
              const int nig_ = 8 * nN_, gid_ = wg_ / nig_, fm_ = gid_ * 8, gsz_ = (nM_ - fm_) < 8 ? (nM_ - fm_) : 8;
              ffn_fixup(p, L, fm_ + ((wg_ % nig_) % gsz_)); }
          EpiRes E{p.out, p.out, XB, RSS};
          run_gemm(lds, (const bf16_t*)(ws + WS_ACT), (const bf16_t*)(ws + ((L & 1) ? WS_WDN1 : WS_WDN0)), M, 1024, 2816, E); }
        GRID_SYNC();
#if defined(DBG_STOP) && DBG_STOP == 6
        return;
#endif
    }
#ifndef SKIP_FIN
    pass_final(p, gw, NGW, lane);
#endif
}

extern "C" void kernel_launch(void* const* d_in, const int* in_sizes, int n_in, void* d_out, int out_size, void* d_ws, size_t ws_size, hipStream_t stream) {
    static int grid = 0;
    if (grid == 0) {
        if (n_in != 29 || out_size != M * DM || ws_size < WS_END) { fprintf(stderr, "kernel_launch: unexpected shapes (n_in %d out %d ws %zu need %zu)\n", n_in, out_size, ws_size, (size_t)WS_END); grid = -1; return; }
        int dev = 0, cus = 0, per_cu = 0;
        hipGetDevice(&dev);
        hipDeviceGetAttribute(&cus, hipDeviceAttributeMultiprocessorCount, dev);
        hipFuncSetAttribute((const void*)trunk_fwd, hipFuncAttributeMaxDynamicSharedMemorySize, LDS_BYTES);
        hipOccupancyMaxActiveBlocksPerMultiprocessor(&per_cu, (const void*)trunk_fwd, 512, LDS_BYTES);
        if (per_cu < 1) fprintf(stderr, "kernel_launch: occupancy query reports %d\n", per_cu);
        (void)hipGetLastError();
        grid = cus;
    }
    if (grid < 0) return;
    (void)hipMemsetAsync((char*)d_ws + WS_RSS, 0, 16384, stream);
    P a{};
    const void** pp = (const void**)&a;
    for (int i = 0; i < 29; ++i) pp[i] = d_in[i];
    a.out = (float*)d_out; a.ws = (unsigned char*)d_ws;
    void* args[] = {&a};
    hipError_t e = hipLaunchCooperativeKernel((const void*)trunk_fwd, dim3(grid), dim3(512), args, LDS_BYTES, stream);
    if (e != hipSuccess) fprintf(stderr, "cooperative launch failed: %s (grid %d)\n", hipGetErrorString(e), grid);
}
```

```cpp
#include <hip/hip_runtime.h>
#include <cstdio>
#include <cstdint>
namespace pg8 {
#define PG8_LAS __attribute__((address_space(3)))
typedef unsigned short bf16_t;
typedef short bf16x8 __attribute__((ext_vector_type(8)));
typedef float f32x4 __attribute__((ext_vector_type(4)));
typedef unsigned u32x4 __attribute__((ext_vector_type(4)));
constexpr int BM = 256, BK = 64, HALF = 128, HTB = HALF * BK * 2  , STAGE_BYTES = 8 * HTB, NXCD = 8, WGM = 8;

__host__ __device__ __forceinline__ int lds_byte(int r, int c) { const int st = (r >> 4) * 2 + (c >> 5), rr = r & 15, cc = c & 31, ob = rr * 64 + cc * 2; return st * 1024 + (ob ^ (((ob >> 9) & 1) << 5)); }
__host__ __device__ __forceinline__ void stage_rc(int b, int& R, int& C) { const int st = b / 1024, sb = b % 1024, swz = sb ^ (((sb >> 9) & 1) << 5); R = (st >> 1) * 16 + swz / 64; C = (st & 1) * 32 + (swz % 64) / 2; }
__host__ __device__ __forceinline__ int perm32(int rho) { const int n = rho >> 4, i = rho & 15; return 8 * (i >> 2) + 4 * n + (i & 3); }

struct Unit { int pm, pn; };
struct Gemm { const bf16_t* A; const bf16_t* Bt; int M, N, K; };

struct StaticOrder {
    int nM, nN, nwg, G, c;
    __host__ __device__ void init(int M, int N, int G_, int c_) { nM = M / BM; nN = N / BM; nwg = nM * nN; G = G_; c = c_; }
    __host__ __device__ bool next(int i, Unit& u) const {
        const long L = (long)i * G + c; if (L >= nwg) return false;
        int wgid = (int)L; { const int q = nwg / NXCD, r = nwg % NXCD, xcd = wgid % NXCD, off = wgid / NXCD; wgid = (xcd < r ? xcd * (q + 1) : r * (q + 1) + (xcd - r) * q) + off; }
        const int nig = WGM * nN, gid = wgid / nig, fm = gid * WGM, gsz = (nM - fm) < WGM ? (nM - fm) : WGM;
        u.pm = fm + ((wgid % nig) % gsz); u.pn = (wgid % nig) / gsz; return true;
    }
    __device__ __forceinline__ void a_ready(const Unit&) const {}
    __device__ __forceinline__ void done(const Unit&) const {}
};

__device__ __forceinline__ unsigned cvt_pk_bf16(float lo, float hi) { unsigned r; asm volatile("v_cvt_pk_bf16_f32 %0, %1, %2" : "=v"(r) : "v"(lo), "v"(hi)); return r; }
typedef float f32x2 __attribute__((ext_vector_type(2)));
__device__ __forceinline__ f32x2 gelu_pk(f32x2 v) {
    const f32x2 av = __builtin_elementwise_abs(v), d = av * 0.2316418882f + 1.0f;
    f32x2 t; t.x = __builtin_amdgcn_rcpf(d.x); t.y = __builtin_amdgcn_rcpf(d.y);
    f32x2 q = t * 0.5307027145f + (-0.7265760135f); q = q * t + 0.7107068705f; q = q * t + (-0.142248368f); q = q * t + 0.127414796f; q = q * t;
    const f32x2 s = (v * v) * (-0.72134752044f);
    f32x2 e; e.x = __builtin_amdgcn_exp2f(s.x); e.y = __builtin_amdgcn_exp2f(s.y);
    const f32x2 m = v * (q * e), r = v - m;
    f32x2 o; o.x = v.x < 0.f ? m.x : r.x; o.y = v.y < 0.f ? m.y : r.y; return o;
}

template <int ACT  > struct EpiBf16 {
    static constexpr bool PERM = true, AFTER_DRAIN = false; static_assert(ACT == 0 || ACT == 1, "EpiBf16: ACT is 0 (none) or 1 (gelu_pk)");
    bf16_t* O; int ldc; const float* bias; int split_cols; size_t split_stride; float scale0;
    __device__ __forceinline__ void operator()(const f32x4 (&acc)[2][2][4][2], const Unit& u, int wr, int wc, int fr, int fq) const {
        const int row0 = u.pm * BM + wr * 64 + fr; int colt = u.pn * BM; bf16_t* base = O;
        float sc = 1.f; if (split_cols) { const int t = colt / split_cols; base += (size_t)t * split_stride; colt -= t * split_cols; if (t == 0) sc = scale0; }
        const int col0 = colt + wc * 32 + 8 * fq, bcol0 = u.pn * BM + wc * 32 + 8 * fq;
        f32x4 bv[2][2];
#pragma unroll
        for (int bj = 0; bj < 2; ++bj)
#pragma unroll
            for (int n = 0; n < 2; ++n) bv[bj][n] = bias ? *(const f32x4*)(bias + bcol0 + bj * HALF + 4 * n) : (f32x4){0.f, 0.f, 0.f, 0.f};
#pragma unroll
        for (int ai = 0; ai < 2; ++ai)
#pragma unroll
            for (int m = 0; m < 4; ++m) { bf16_t* rowp = base + (size_t)(row0 + ai * HALF + m * 16) * ldc + col0;
#pragma unroll
                for (int bj = 0; bj < 2; ++bj) { f32x4 v0 = acc[ai][bj][m][0] + bv[bj][0], v1 = acc[ai][bj][m][1] + bv[bj][1];
                    if (ACT == 1) { f32x2 a = gelu_pk((f32x2){v0[0], v0[1]}), b = gelu_pk((f32x2){v0[2], v0[3]}), c = gelu_pk((f32x2){v1[0], v1[1]}), d = gelu_pk((f32x2){v1[2], v1[3]});
                        v0 = (f32x4){a.x, a.y, b.x, b.y}; v1 = (f32x4){c.x, c.y, d.x, d.y}; }
                    v0 = v0 * sc; v1 = v1 * sc; u32x4 w; w.x = cvt_pk_bf16(v0[0], v0[1]); w.y = cvt_pk_bf16(v0[2], v0[3]); w.z = cvt_pk_bf16(v1[0], v1[1]); w.w = cvt_pk_bf16(v1[2], v1[3]);
                    *(u32x4*)(rowp + bj * HALF) = w; } }
    }
};

struct PanelStats {
    unsigned* xbuf;
    unsigned* cnt;
    unsigned* tmo;
    int ntn; float eps;
    unsigned code;
    __device__ __forceinline__ bool run(const f32x4 (&v)[2][2][4][2], const Unit& u, int wr, int wc, int fr, int fq, PG8_LAS unsigned char* lds, int wid, int lane) const {
        typedef float f32x2v __attribute__((ext_vector_type(2)));
        PG8_LAS f32x2v* P = (PG8_LAS f32x2v*)lds;
        PG8_LAS f32x2v* S = (PG8_LAS f32x2v*)(lds + 8192);
        PG8_LAS unsigned* flag = (PG8_LAS unsigned*)(lds + 8192 + 2048);
#pragma unroll
        for (int ai = 0; ai < 2; ++ai)
#pragma unroll
            for (int m = 0; m < 4; ++m) {
                float s = 0.f;
#pragma unroll
                for (int bj = 0; bj < 2; ++bj)
#pragma unroll
                    for (int n = 0; n < 2; ++n) { const f32x4 x = v[ai][bj][m][n]; s += (x[0] + x[1]) + (x[2] + x[3]); }
                s += __shfl_xor(s, 16); s += __shfl_xor(s, 32);
                const float mw = s * (1.0f / 64.0f); float q = 0.f;
#pragma unroll
                for (int bj = 0; bj < 2; ++bj)
#pragma unroll
                    for (int n = 0; n < 2; ++n) { const f32x4 d = v[ai][bj][m][n] - mw; q += (d[0] * d[0] + d[1] * d[1]) + (d[2] * d[2] + d[3] * d[3]); }
                q += __shfl_xor(q, 16); q += __shfl_xor(q, 32);
                if (fq == 0) P[(ai * HALF + wr * 64 + m * 16 + fr) * 4 + wc] = (f32x2v){mw, q};
            }
        asm volatile("s_waitcnt lgkmcnt(0)" ::: "memory"); __builtin_amdgcn_s_barrier(); asm volatile("" ::: "memory");
#if defined(BROKEN_EXCHANGE_NO_WAIT)
#warning BROKEN CONTROL BUILD: the row-statistics exchange does not wait; results are wrong by design
        if (blockIdx.x >= 64) { const long long t0_ = clock64(); while (clock64() - t0_ < 60000) __builtin_amdgcn_s_sleep(8); }
#endif
        const int row = wid * 32 + (lane & 31);
        if (lane < 32) {
            const f32x2v a = P[row * 4 + 0], b = P[row * 4 + 1], c = P[row * 4 + 2], d = P[row * 4 + 3];
            const float mt = (a.x + b.x + c.x + d.x) * 0.25f;
            const float da = a.x - mt, db = b.x - mt, dc = c.x - mt, dd = d.x - mt;
            const float m2 = (a.y + b.y) + (c.y + d.y) + 64.0f * ((da * da + db * db) + (dc * dc + dd * dd));
            unsigned long long* slot = (unsigned long long*)xbuf + ((size_t)(u.pm * BM + row) * 4 + u.pn);
            __hip_atomic_store(slot, ((unsigned long long)__float_as_uint(m2) << 32) | __float_as_uint(mt), __ATOMIC_RELAXED, __HIP_MEMORY_SCOPE_AGENT);
        }
        asm volatile("s_waitcnt vmcnt(0)" ::: "memory");
        if (lane == 0) __hip_atomic_fetch_add(cnt + 64 * u.pm, 1u, __ATOMIC_RELAXED, __HIP_MEMORY_SCOPE_AGENT);
        if (wid == 0) {
            bool dead = false; const unsigned long long t0 = __builtin_amdgcn_s_memrealtime(); const unsigned want = 8u * (unsigned)ntn;
            for (;;) {
#if defined(BROKEN_EXCHANGE_NO_WAIT)
                break;
#endif
                if ((unsigned)__builtin_amdgcn_readfirstlane(__hip_atomic_load(cnt + 64 * u.pm, __ATOMIC_RELAXED, __HIP_MEMORY_SCOPE_AGENT)) >= want) break;
                if (__builtin_amdgcn_s_memrealtime() - t0 > 2000000ull) {
                    if (lane == 0) { unsigned expect = 0u; __hip_atomic_compare_exchange_strong(tmo + 1, &expect, code | (unsigned)(u.pm & 0xff), __ATOMIC_RELAXED, __ATOMIC_RELAXED, __HIP_MEMORY_SCOPE_AGENT);
                                     __hip_atomic_store(tmo, 1u, __ATOMIC_RELAXED, __HIP_MEMORY_SCOPE_AGENT); }
                    dead = true; break; }
                __builtin_amdgcn_s_sleep(2);
            }
            __builtin_amdgcn_fence(__ATOMIC_ACQUIRE, "agent");
            if (lane == 0) flag[0] = dead ? 1u : 0u;
        }
        asm volatile("s_waitcnt vmcnt(0) lgkmcnt(0)" ::: "memory"); __builtin_amdgcn_s_barrier(); asm volatile("" ::: "memory");
        const bool bad = flag[0] != 0u;
        if (lane < 32) {
            const unsigned long long* slot = (const unsigned long long*)xbuf + (size_t)(u.pm * BM + row) * 4; float mt[4], m2[4]; float ms = 0.f;
#pragma unroll
            for (int t = 0; t < 4; ++t) { if (t < ntn) { const unsigned long long w = __hip_atomic_load(slot + t, __ATOMIC_RELAXED, __HIP_MEMORY_SCOPE_AGENT); mt[t] = __uint_as_float((unsigned)w); m2[t] = __uint_as_float((unsigned)(w >> 32)); } else { mt[t] = 0.f; m2[t] = 0.f; } ms += mt[t]; }
            const float mean = ms / (float)ntn; float q = 0.f;
#pragma unroll
            for (int t = 0; t < 4; ++t) if (t < ntn) { const float dm = mt[t] - mean; q += m2[t] + 256.0f * dm * dm; }
            S[row] = (f32x2v){mean, 1.0f / sqrtf(q / (256.0f * (float)ntn) + eps)};
        }
        asm volatile("s_waitcnt lgkmcnt(0)" ::: "memory"); __builtin_amdgcn_s_barrier(); asm volatile("" ::: "memory");
        return bad;
    }
};
struct EpiLnRes {
    static constexpr bool PERM = false, AFTER_DRAIN = true;
    const float* base; float* out; int ldc; const float* bias; PanelStats st; unsigned poison;
    __device__ __forceinline__ void fused(f32x4 (&acc)[2][2][4][2], const Unit& u, int wr, int wc, int fr, int fq, PG8_LAS unsigned char* lds, int wid, int lane) const {
        typedef float f32x2v __attribute__((ext_vector_type(2)));
        const PG8_LAS f32x2v* S = (const PG8_LAS f32x2v*)(lds + 8192);
        const int col0 = u.pn * BM + wc * 32 + 4 * fq;
#pragma unroll
        for (int bj = 0; bj < 2; ++bj)
#pragma unroll
            for (int n = 0; n < 2; ++n) { const f32x4 bv = bias ? *(const f32x4*)(bias + col0 + bj * HALF + n * 16) : (f32x4){0.f, 0.f, 0.f, 0.f};
#pragma unroll
                for (int ai = 0; ai < 2; ++ai)
#pragma unroll
                    for (int m = 0; m < 4; ++m) acc[ai][bj][m][n] += bv; }
        f32x4 pre[4][2][2];
#pragma unroll
        for (int m = 0; m < 4; ++m) { const size_t off = (size_t)(u.pm * BM + wr * 64 + m * 16 + fr) * ldc + col0;
#pragma unroll
            for (int bj = 0; bj < 2; ++bj)
#pragma unroll
                for (int n = 0; n < 2; ++n) pre[m][bj][n] = *(const f32x4*)(base + off + bj * HALF + n * 16); }
        const bool bad = st.run(acc, u, wr, wc, fr, fq, lds, wid, lane) || poison != 0u;
        const float qnan = __builtin_nanf("");
#pragma unroll
        for (int ai = 0; ai < 2; ++ai)
#pragma unroll
            for (int m = 0; m < 4; ++m) { const int r = ai * HALF + wr * 64 + m * 16 + fr; const f32x2v sr = S[r]; const size_t off = (size_t)(u.pm * BM + r) * ldc + col0;
#pragma unroll
                for (int bj = 0; bj < 2; ++bj)
#pragma unroll
                    for (int n = 0; n < 2; ++n) { const f32x4 bs = ai == 0 ? pre[m][bj][n] : *(const f32x4*)(base + off + bj * HALF + n * 16); f32x4 o = bs + (acc[ai][bj][m][n] - sr.x) * sr.y;
                        if (bad) o = (f32x4){qnan, qnan, qnan, qnan}; *(f32x4*)(out + off + bj * HALF + n * 16) = o; }
                if (m & 1) asm volatile("" ::: "memory"); }
    }
};
struct EpiLnResLn {
    static constexpr bool PERM = false, AFTER_DRAIN = true;
    const float* base; float* out; bf16_t* xn; int ldc; const float* bias; PanelStats st1, st2; unsigned poison;
    __device__ __forceinline__ void fused(f32x4 (&acc)[2][2][4][2], const Unit& u, int wr, int wc, int fr, int fq, PG8_LAS unsigned char* lds, int wid, int lane) const {
        typedef float f32x2v __attribute__((ext_vector_type(2))); typedef unsigned u32x2v __attribute__((ext_vector_type(2)));
        const PG8_LAS f32x2v* S = (const PG8_LAS f32x2v*)(lds + 8192);
        const int col0 = u.pn * BM + wc * 32 + 4 * fq;
#pragma unroll
        for (int bj = 0; bj < 2; ++bj)
#pragma unroll
            for (int n = 0; n < 2; ++n) { const f32x4 bv = bias ? *(const f32x4*)(bias + col0 + bj * HALF + n * 16) : (f32x4){0.f, 0.f, 0.f, 0.f};
#pragma unroll
                for (int ai = 0; ai < 2; ++ai)
#pragma unroll
                    for (int m = 0; m < 4; ++m) acc[ai][bj][m][n] += bv; }
        bool bad = st1.run(acc, u, wr, wc, fr, fq, lds, wid, lane) || poison != 0u;
        const float qnan = __builtin_nanf("");
#pragma unroll
        for (int ai = 0; ai < 2; ++ai)
#pragma unroll
            for (int m = 0; m < 4; ++m) { const int r = ai * HALF + wr * 64 + m * 16 + fr; const f32x2v sr = S[r]; const size_t off = (size_t)(u.pm * BM + r) * ldc + col0;
#pragma unroll
                for (int bj = 0; bj < 2; ++bj)
#pragma unroll
                    for (int n = 0; n < 2; ++n) { const f32x4 bs = *(const f32x4*)(base + off + bj * HALF + n * 16); acc[ai][bj][m][n] = bs + (acc[ai][bj][m][n] - sr.x) * sr.y; }
                asm volatile("" : "+v"(acc[ai][0][m][0]), "+v"(acc[ai][0][m][1]), "+v"(acc[ai][1][m][0]), "+v"(acc[ai][1][m][1]));
                if (m & 1) asm volatile("" ::: "memory"); }
        const bool bad1 = bad;
        bad = st2.run(acc, u, wr, wc, fr, fq, lds, wid, lane) || bad;
#pragma unroll
        for (int ai = 0; ai < 2; ++ai)
#pragma unroll
            for (int m = 0; m < 4; ++m) { const int r = ai * HALF + wr * 64 + m * 16 + fr; const f32x2v sr = S[r]; const size_t off = (size_t)(u.pm * BM + r) * ldc + col0;
#pragma unroll
                for (int bj = 0; bj < 2; ++bj)
#pragma unroll
                    for (int n = 0; n < 2; ++n) { const f32x4 x1 = acc[ai][bj][m][n]; *(f32x4*)(out + off + bj * HALF + n * 16) = bad1 ? (f32x4){qnan, qnan, qnan, qnan} : x1;
                        const f32x4 o = (x1 - sr.x) * sr.y; u32x2v w; w.x = cvt_pk_bf16(o[0], o[1]); w.y = cvt_pk_bf16(o[2], o[3]);
                        if (bad) { w.x = 0x7fc07fc0u; w.y = 0x7fc07fc0u; } *(u32x2v*)(xn + off + bj * HALF + n * 16) = w; }
                asm volatile("" ::: "memory"); }
    }
};

template <class Epi, class Sched, bool ALIGN_EPI = false, bool SP2 = false>
__device__ __forceinline__ void gemm_phase(PG8_LAS unsigned char* lds, const Gemm g, const Sched& S, const Epi& E) {
    int tid_ = threadIdx.x; asm volatile("" : "+v"(tid_));
    const int tid = tid_, wid = __builtin_amdgcn_readfirstlane(tid >> 6), lane = tid & 63, wr = wid >> 2, wc = wid & 3, fr = lane & 15, fq = lane >> 4;
    const int K = g.K, nt = K / BK;
    unsigned voffA[2], voffB[2];
#pragma unroll
    for (int i = 0; i < 2; ++i) { int R, C; stage_rc(tid * 16 + i * 8192, R, C); const int Rb = Epi::PERM ? ((R & ~31) + perm32(R & 31)) : R;
        voffA[i] = (unsigned)(R * K + C) * 2u; voffB[i] = (unsigned)(Rb * K + C) * 2u; }
    const size_t kstep = (size_t)(BK * 2);
    const size_t hstep = (size_t)HALF * K * 2;
    const size_t tstep = 2 * hstep;
    const unsigned ldsw = (unsigned)wid * 1024u;
    const int aoff = lds_byte(wr * 64 + fr, fq * 8), boff = lds_byte(wc * 32 + fr, fq * 8);
#define PG8_SA(b, h) (((b) * 2 + (h)) * HTB)
#define PG8_SB(b, h) ((4 + (b) * 2 + (h)) * HTB)
#define PG8_STAGE(bufoff, gbase, voff) do { _Pragma("unroll") for (int _i = 0; _i < 2; ++_i) \
        __builtin_amdgcn_global_load_lds((const unsigned*)((const char*)(gbase) + (voff)[_i]), (PG8_LAS unsigned*)(lds + (bufoff) + ldsw + _i * 8192), 16, 0, 0); } while (0)
#define PG8_LDA(dst, b, h) do { _Pragma("unroll") for (int m = 0; m < 4; ++m) _Pragma("unroll") for (int k = 0; k < 2; ++k) dst[m][k] = *(const PG8_LAS bf16x8*)(lds + PG8_SA(b, h) + aoff + m * 2048 + k * 1024); } while (0)
#define PG8_LDB(dst, b, h) do { _Pragma("unroll") for (int n = 0; n < 2; ++n) _Pragma("unroll") for (int k = 0; k < 2; ++k) dst[n][k] = *(const PG8_LAS bf16x8*)(lds + PG8_SB(b, h) + boff + n * 2048 + k * 1024); } while (0)
#define PG8_MMA(ai, bj, At, Bt) do { __builtin_amdgcn_s_setprio(1); _Pragma("unroll") for (int m = 0; m < 4; ++m) _Pragma("unroll") for (int n = 0; n < 2; ++n) _Pragma("unroll") for (int k = 0; k < 2; ++k) \
        acc[ai][bj][m][n] = __builtin_amdgcn_mfma_f32_16x16x32_bf16(Bt[n][k], At[m][k], acc[ai][bj][m][n], 0, 0, 0); __builtin_amdgcn_s_setprio(0); } while (0)
#define PG8_WAIT_V(n) asm volatile("s_waitcnt vmcnt(" #n ")" ::: "memory")
#define PG8_WAIT_L(n) asm volatile("s_waitcnt lgkmcnt(" #n ")" ::: "memory")
#define PG8_BAR __builtin_amdgcn_s_barrier()
#define PG8_SCHED __builtin_amdgcn_sched_barrier(0)
    Unit cur, nxt; int ui = 0;
    if (!S.next(0, cur)) return;
    f32x4 acc[2][2][4][2];
#pragma unroll
    for (int a = 0; a < 2; ++a)
#pragma unroll
        for (int b = 0; b < 2; ++b)
#pragma unroll
            for (int m = 0; m < 4; ++m)
#pragma unroll
                for (int n = 0; n < 2; ++n) acc[a][b][m][n] = (f32x4){0.f, 0.f, 0.f, 0.f};
    bf16x8 At[4][2], B0[2][2], B1[2][2];
    const char* cA = (const char*)g.A + (size_t)cur.pm * tstep; const char* cB = (const char*)g.Bt + (size_t)cur.pn * tstep;
    S.a_ready(cur);
    if constexpr (SP2) {
        PG8_STAGE(PG8_SB(0, 0), cB, voffB); PG8_STAGE(PG8_SB(0, 1), cB + hstep, voffB); PG8_STAGE(PG8_SA(0, 0), cA, voffA); PG8_STAGE(PG8_SA(0, 1), cA + hstep, voffA);
        if (wr == 1) PG8_BAR;
        PG8_WAIT_V(2); PG8_BAR;
        PG8_STAGE(PG8_SB(1, 0), cB + kstep, voffB); PG8_STAGE(PG8_SA(1, 0), cA + kstep, voffA); PG8_STAGE(PG8_SB(1, 1), cB + hstep + kstep, voffB);
        PG8_WAIT_V(6); PG8_BAR;
    } else {
        PG8_STAGE(PG8_SB(0, 0), cB, voffB); PG8_STAGE(PG8_SA(0, 0), cA, voffA); PG8_STAGE(PG8_SB(0, 1), cB + hstep, voffB); PG8_STAGE(PG8_SA(0, 1), cA + hstep, voffA);
        if (wr == 1) PG8_BAR;
        PG8_WAIT_V(4); PG8_BAR;
        PG8_STAGE(PG8_SB(1, 0), cB + kstep, voffB); PG8_STAGE(PG8_SA(1, 0), cA + kstep, voffA); PG8_STAGE(PG8_SB(1, 1), cB + hstep + kstep, voffB);
        PG8_WAIT_V(6); PG8_BAR;
    }
    for (;;) {
        const bool has_next = S.next(ui + 1, nxt);
        const char* nA = has_next ? (const char*)g.A + (size_t)nxt.pm * tstep : cA; const char* nB = has_next ? (const char*)g.Bt + (size_t)nxt.pn * tstep : cB;
        for (int t = 0; t < nt; t += 2) {
            const bool last = (t == nt - 2);
            const char* a1 = cA + (size_t)(t + 1) * kstep;
            const char* a2 = last ? nA : cA + (size_t)(t + 2) * kstep; const char* b2 = last ? nB : cB + (size_t)(t + 2) * kstep;
            const char* a3 = a2 + kstep; const char* b3 = b2 + kstep;
            if (last && has_next) S.a_ready(nxt);
            if constexpr (SP2) {
            PG8_LDB(B0, 0, 0); PG8_LDB(B1, 0, 1); PG8_SCHED; PG8_LDA(At, 0, 0); PG8_STAGE(PG8_SA(1, 1), a1 + hstep, voffA);
            PG8_WAIT_V(8); PG8_WAIT_L(0); PG8_BAR; PG8_MMA(0, 0, At, B0); PG8_MMA(0, 1, At, B1); PG8_BAR; PG8_SCHED;
            PG8_LDA(At, 0, 1); PG8_STAGE(PG8_SB(0, 0), b2, voffB); PG8_STAGE(PG8_SB(0, 1), b2 + hstep, voffB); PG8_STAGE(PG8_SA(0, 0), a2, voffA);
            PG8_WAIT_V(8); PG8_WAIT_L(0); PG8_BAR; PG8_MMA(1, 0, At, B0); PG8_MMA(1, 1, At, B1); PG8_BAR; PG8_SCHED;
            PG8_LDB(B0, 1, 0); PG8_LDB(B1, 1, 1); PG8_SCHED; PG8_LDA(At, 1, 0); PG8_STAGE(PG8_SA(0, 1), a2 + hstep, voffA);
            PG8_WAIT_V(8); PG8_WAIT_L(0); PG8_BAR; PG8_MMA(0, 0, At, B0); PG8_MMA(0, 1, At, B1); PG8_BAR; PG8_SCHED;
            PG8_LDA(At, 1, 1); PG8_STAGE(PG8_SB(1, 0), b3, voffB); PG8_STAGE(PG8_SB(1, 1), b3 + hstep, voffB); PG8_STAGE(PG8_SA(1, 0), a3, voffA);
            PG8_WAIT_V(8); PG8_WAIT_L(0); PG8_BAR; PG8_MMA(1, 0, At, B0); PG8_MMA(1, 1, At, B1); PG8_BAR; PG8_SCHED;
            } else {
            PG8_LDB(B0, 0, 0); PG8_SCHED; PG8_LDA(At, 0, 0); PG8_STAGE(PG8_SA(1, 1), a1 + hstep, voffA);
            PG8_WAIT_L(8); PG8_BAR; PG8_WAIT_L(0); PG8_MMA(0, 0, At, B0); PG8_BAR; PG8_SCHED;
            PG8_LDB(B1, 0, 1); PG8_STAGE(PG8_SB(0, 0), b2, voffB);
            PG8_BAR; PG8_WAIT_L(0); PG8_MMA(0, 1, At, B1); PG8_BAR;
            PG8_LDA(At, 0, 1); PG8_STAGE(PG8_SA(0, 0), a2, voffA);
            PG8_BAR; PG8_WAIT_L(0); PG8_MMA(1, 0, At, B0); PG8_BAR; PG8_SCHED;
            PG8_STAGE(PG8_SB(0, 1), b2 + hstep, voffB);
            PG8_WAIT_V(6); PG8_BAR; PG8_MMA(1, 1, At, B1); PG8_BAR;
            PG8_LDB(B0, 1, 0); PG8_SCHED; PG8_LDA(At, 1, 0); PG8_STAGE(PG8_SA(0, 1), a2 + hstep, voffA);
            PG8_WAIT_L(8); PG8_BAR; PG8_WAIT_L(0); PG8_MMA(0, 0, At, B0); PG8_BAR; PG8_SCHED;
            PG8_LDB(B1, 1, 1); PG8_STAGE(PG8_SB(1, 0), b3, voffB);
            PG8_BAR; PG8_WAIT_L(0); PG8_MMA(0, 1, At, B1); PG8_BAR;
            PG8_LDA(At, 1, 1); PG8_STAGE(PG8_SA(1, 0), a3, voffA);
            PG8_BAR; PG8_WAIT_L(0); PG8_MMA(1, 0, At, B0); PG8_BAR; PG8_SCHED;
            PG8_STAGE(PG8_SB(1, 1), b3 + hstep, voffB);
            PG8_WAIT_V(6); PG8_BAR; PG8_MMA(1, 1, At, B1); PG8_BAR;
            }
        }
        if constexpr (ALIGN_EPI) { if (wr == 0) PG8_BAR; }
        if constexpr (!Epi::AFTER_DRAIN) { E(acc, cur, wr, wc, fr, fq); S.done(cur); }
        if (!has_next) break;
#pragma unroll
        for (int a = 0; a < 2; ++a)
#pragma unroll
            for (int b = 0; b < 2; ++b)
#pragma unroll
                for (int m = 0; m < 4; ++m)
#pragma unroll
                    for (int n = 0; n < 2; ++n) acc[a][b][m][n] = (f32x4){0.f, 0.f, 0.f, 0.f};
        cur = nxt; cA = nA; cB = nB; ++ui;
        if constexpr (ALIGN_EPI) { if (wr == 1) PG8_BAR; }
    }
    PG8_WAIT_V(0);
    if constexpr (!ALIGN_EPI) { if (wr == 0) PG8_BAR; }
    PG8_BAR;
    if constexpr (Epi::AFTER_DRAIN) { E.fused(acc, cur, wr, wc, fr, fq, lds, wid, lane); S.done(cur); }
#undef PG8_SA
#undef PG8_SB
#undef PG8_STAGE
#undef PG8_LDA
#undef PG8_LDB
#undef PG8_MMA
#undef PG8_WAIT_V
#undef PG8_WAIT_L
#undef PG8_BAR
#undef PG8_SCHED
}
}

#include <hip/hip_cooperative_groups.h>
namespace cg = cooperative_groups;
#define LAS __attribute__((address_space(3)))
typedef unsigned short bf16_t;
using pg8::f32x4; using pg8::bf16x8; using pg8::u32x4;
typedef float f32x2_t __attribute__((ext_vector_type(2))); typedef __bf16 bf16x2_t __attribute__((ext_vector_type(2)));
__device__ __forceinline__ unsigned cvt_pk_bf16(float lo, float hi) { f32x2_t v = {lo, hi}; bf16x2_t b = __builtin_convertvector(v, bf16x2_t); return __builtin_bit_cast(unsigned, b); }
typedef float f32x16 __attribute__((ext_vector_type(16)));
typedef short s16x4 __attribute__((ext_vector_type(4)));
typedef unsigned u32x2 __attribute__((ext_vector_type(2)));

constexpr int M = 16384, DM = 1024, SEQ = 2048, NB = 8, DEPTH = 4;
constexpr int NIN = 3840;
constexpr int DFF = 2816;
constexpr float EPS = 1e-6f;
constexpr float LOG2E = 1.4426950408889634f;
constexpr int LDS_BYTES = 147456;

struct P {
    const float *x, *mem; const int* pos;
    const float *norm_mix, *w_in, *ssm_conv_w, *ssm_conv_b, *dt_bias, *a_log, *d_skip, *ssm_norm, *q_norm, *w_uq, *kv_norm, *w_ukv, *attn_out_norm, *w_out,
                *norm_mem_q, *norm_mem_kv, *w_mq, *w_mk, *w_mv, *w_mo, *norm_ffn, *w_up, *ffn_conv_w, *ffn_conv_b, *w_down, *final_norm;
    float* out; unsigned char* ws;
};

constexpr size_t KiB = 1024, MiB = 1024 * 1024;
constexpr size_t WS_RSS = 0, WS_COS = 1 * MiB, WS_SIN = 2 * MiB, WS_DT = 3 * MiB, WS_KPE = 4 * MiB;
constexpr size_t WS_WIN = 6144 * KiB, WS_WUQ = 13824 * KiB, WS_WUKV = 14976 * KiB, WS_WOUT = 16000 * KiB, WS_WMQ = 20096 * KiB, WS_WMO = 22144 * KiB,
                 WS_WUP = 24192 * KiB, WS_WDN0 = 35456 * KiB, WS_WDN1 = 41088 * KiB;
constexpr size_t WS_WMKV = 46 * MiB, WS_KMVM = 62 * MiB, WS_MEMN = 94 * MiB, WS_XB = 98 * MiB, WS_VB = 98 * MiB;
constexpr size_t WS_Z = 130 * MiB, WS_QM = 130 * MiB, WS_U = 130 * MiB;
constexpr size_t WS_WUKV1 = 5 * MiB;
constexpr size_t WS_XBCPRE = 162 * MiB, WS_YC = 162 * MiB, WS_OM = 162 * MiB;
constexpr size_t WS_ACT = 218 * MiB;
constexpr size_t WS_SM = 226 * MiB, WS_XBC = 250 * MiB, WS_QB = 250 * MiB, WS_CQN = 314 * MiB, WS_CKVN = 326 * MiB, WS_RSP = 334 * MiB, WS_HALO = 337 * MiB, WS_PART = 340 * MiB, WS_KN = 343 * MiB, WS_END = 375 * MiB;

__device__ __forceinline__ float bflo(unsigned w) { return __uint_as_float(w << 16); }
__device__ __forceinline__ float bfhi(unsigned w) { return __uint_as_float(w & 0xffff0000u); }
__device__ __forceinline__ float bf1(bf16_t h) { return __uint_as_float((unsigned)h << 16); }
__device__ __forceinline__ bf16_t tobf(float f) { return (bf16_t)(cvt_pk_bf16(f, 0.f) & 0xffffu); }
__device__ __forceinline__ float wave_sum(float v) {
#pragma unroll
    for (int o = 1; o < 64; o <<= 1) v += __shfl_xor(v, o);
    return v;
}
__device__ __forceinline__ float silu_f(float v) { return v * __builtin_amdgcn_rcpf(1.f + __expf(-v)); }
__device__ __forceinline__ int crow(int r, int hi) { return (r & 3) + 8 * (r >> 2) + 4 * hi; }
#define LDS_WAIT() asm volatile("s_waitcnt lgkmcnt(0)" ::: "memory")
__device__ __forceinline__ int fresh_tid() { int t = threadIdx.x; asm volatile("" : "+v"(t)); return t; }
__device__ __forceinline__ float rss16(const float* rsp, int row) { const f32x4 a = *(const f32x4*)(rsp + (size_t)row * 4), b = *(const f32x4*)(rsp + (size_t)M * 4 + (size_t)row * 4), c = *(const f32x4*)(rsp + (size_t)M * 8 + (size_t)row * 4), d = *(const f32x4*)(rsp + (size_t)M * 12 + (size_t)row * 4);
    return (((a[0] + a[1]) + (a[2] + a[3])) + ((b[0] + b[1]) + (b[2] + b[3]))) + (((c[0] + c[1]) + (c[2] + c[3])) + ((d[0] + d[1]) + (d[2] + d[3]))); }

struct EpiRoute {
    static constexpr bool PERM = true, AFTER_DRAIN = false;
    bf16_t *b0, *b1, *b2; int ld0, ld1, ld2, t1, t2; const float* rss; float invk, mul;
    __device__ __forceinline__ void operator()(const f32x4 (&acc)[2][2][4][2], const pg8::Unit& u, int wr_, int wc_, int fr_, int fq_) const {
        const int t_ = fresh_tid(), wid_ = __builtin_amdgcn_readfirstlane(t_ >> 6), wr = wid_ >> 2, wc = wid_ & 3, fr = t_ & 15, fq = (t_ >> 4) & 3;
        bf16_t* base; int ld, colt;
        if (u.pn < t1) { base = b0; ld = ld0; colt = u.pn * 256; } else if (u.pn < t2) { base = b1; ld = ld1; colt = (u.pn - t1) * 256; } else { base = b2; ld = ld2; colt = (u.pn - t2) * 256; }
        const int col0 = colt + wc * 32 + 8 * fq;
#pragma unroll
        for (int ai = 0; ai < 2; ++ai)
#pragma unroll
            for (int m = 0; m < 4; ++m) {
                const int row = u.pm * 256 + ai * 128 + wr * 64 + m * 16 + fr;
                float s = mul; if (rss) s *= rsqrtf(rss16(rss, row) * invk + EPS);
                bf16_t* rowp = base + (size_t)row * ld + col0;
#pragma unroll
                for (int bj = 0; bj < 2; ++bj) { const f32x4 v0 = acc[ai][bj][m][0] * s, v1 = acc[ai][bj][m][1] * s;
                    u32x4 w; w.x = cvt_pk_bf16(v0[0], v0[1]); w.y = cvt_pk_bf16(v0[2], v0[3]); w.z = cvt_pk_bf16(v1[0], v1[1]); w.w = cvt_pk_bf16(v1[2], v1[3]);
                    *(u32x4*)(rowp + bj * 128) = w; }
                asm volatile("" ::: "memory");
            }
    }
};
struct EpiRope {
    static constexpr bool PERM = false, AFTER_DRAIN = false;
    bf16_t* YCq; bf16_t* QPE; const float* cs; const float* sn; float mul;
    __device__ __forceinline__ void operator()(const f32x4 (&acc)[2][2][4][2], const pg8::Unit& u, int wr_, int wc_, int fr_, int fq_) const {
        const int t_ = fresh_tid(), wid_ = __builtin_amdgcn_readfirstlane(t_ >> 6), wr = wid_ >> 2, wc = wid_ & 3, fr = t_ & 15, fq = (t_ >> 4) & 3;
#pragma unroll
        for (int ai = 0; ai < 2; ++ai)
#pragma unroll
            for (int m = 0; m < 4; ++m) {
                const int row = u.pm * 256 + ai * 128 + wr * 64 + m * 16 + fr;
                const f32x4 c = *(const f32x4*)(cs + (size_t)row * 16 + 4 * fq), s = *(const f32x4*)(sn + (size_t)row * 16 + 4 * fq);
#pragma unroll
                for (int bj = 0; bj < 2; ++bj) { const int gb = u.pn * 256 + bj * 128 + wc * 32; const int head = gb / 96, within = gb - head * 96; const bool rope = within == 64;
                    f32x4 a = acc[ai][bj][m][0], b = acc[ai][bj][m][1];
                    if (rope) { const f32x4 a2 = a * c - b * s, b2 = b * c + a * s; a = a2; b = b2; }
                    a = a * mul; b = b * mul;
                    bf16_t* dst = rope ? (QPE + (size_t)row * 512 + 32 * head + 4 * fq) : (YCq + (size_t)row * 2048 + 1024 + 64 * head + within + 4 * fq);
                    u32x2 w0, w1; w0.x = cvt_pk_bf16(a[0], a[1]); w0.y = cvt_pk_bf16(a[2], a[3]); w1.x = cvt_pk_bf16(b[0], b[1]); w1.y = cvt_pk_bf16(b[2], b[3]);
                    *(u32x2*)dst = w0; *(u32x2*)(dst + 16) = w1; }
                asm volatile("" ::: "memory");
            }
    }
};
struct EpiRes {
    static constexpr bool PERM = false, AFTER_DRAIN = false;
    const float* xin; float* xout; bf16_t* xb; float* rss;
    __device__ __forceinline__ void operator()(const f32x4 (&acc)[2][2][4][2], const pg8::Unit& u, int wr_, int wc_, int fr_, int fq_) const {
        const int t_ = fresh_tid(), wid_ = __builtin_amdgcn_readfirstlane(t_ >> 6), wr = wid_ >> 2, wc = wid_ & 3, fr = t_ & 15, fq = (t_ >> 4) & 3;
#pragma unroll
        for (int ai = 0; ai < 2; ++ai)
#pragma unroll
            for (int m = 0; m < 4; ++m) {
                const int row = u.pm * 256 + ai * 128 + wr * 64 + m * 16 + fr; float ss = 0.f;
#pragma unroll
                for (int bj = 0; bj < 2; ++bj)
#pragma unroll
                    for (int n = 0; n < 2; ++n) { const size_t off = (size_t)row * 1024 + u.pn * 256 + bj * 128 + wc * 32 + 16 * n + 4 * fq;
                        const f32x4 v = *(const f32x4*)(xin + off) + acc[ai][bj][m][n];
                        *(f32x4*)(xout + off) = v; u32x2 w; w.x = cvt_pk_bf16(v[0], v[1]); w.y = cvt_pk_bf16(v[2], v[3]); *(u32x2*)(xb + off) = w;
                        ss += (v[0] * v[0] + v[1] * v[1]) + (v[2] * v[2] + v[3] * v[3]); }
                ss += __shfl_xor(ss, 16); ss += __shfl_xor(ss, 32);
                if (fq == 0) rss[(size_t)u.pn * M * 4 + (size_t)row * 4 + wc] = ss;
                asm volatile("" ::: "memory");
            }
    }
};


template <int CTRL> __device__ __forceinline__ float dpp_mov(float old, float src) {
    return __builtin_bit_cast(float, __builtin_amdgcn_update_dpp(__builtin_bit_cast(int, old), __builtin_bit_cast(int, src), CTRL, 0xf, 0xf, false)); }
struct EpiGlu {
    static constexpr bool PERM = true, AFTER_DRAIN = false;
    bf16_t* ACT; const float* rss; const float* cw; const float* cb; float* HALO; float* PART; LAS float* H;
    __device__ __forceinline__ void operator()(const f32x4 (&acc)[2][2][4][2], const pg8::Unit& u, int wr_, int wc_, int fr_, int fq_) const {
        typedef float f32x2v __attribute__((ext_vector_type(2)));
        typedef __attribute__((address_space(1))) f32x4 gf4; typedef __attribute__((address_space(1))) f32x2v gf2; typedef __attribute__((address_space(1))) u32x2 gu2;
        const int t_ = fresh_tid(), wid_ = __builtin_amdgcn_readfirstlane(t_ >> 6), wr = wid_ >> 2, wc = wid_ & 3, fr = t_ & 15, fq = (t_ >> 4) & 3;
        const int pm = u.pm, pn = u.pn;
        LAS float* RS = H + 2048; LAS float* WT = H + 2304;
        if (t_ < 256) { RS[t_] = rsqrtf(rss16(rss, pm * 256 + t_) * (1.f / 1024.f) + EPS);
            const unsigned gcol = (unsigned)((t_ >> 7) * 2816 + 128 * pn + (t_ & 127));
            WT[t_] = cw[gcol]; WT[256 + t_] = cw[5632u + gcol]; WT[512 + t_] = cw[11264u + gcol]; WT[768 + t_] = cb[gcol]; }
        asm volatile("s_waitcnt lgkmcnt(0)" ::: "memory"); __builtin_amdgcn_s_barrier(); asm volatile("" ::: "memory");
        const LAS float* RSl = RS + wr * 64 + fr;
        const int lc = wc * 32 + 8 * fq;
        if (fr >= 14) {
#pragma unroll
            for (int ai = 0; ai < 2; ++ai)
#pragma unroll
                for (int bj = 0; bj < 2; ++bj)
#pragma unroll
                    for (int n = 0; n < 2; ++n) { const f32x4 v = acc[ai][bj][3][n] * RSl[ai * 128 + 48];
                        *(LAS f32x4*)(H + ((ai * 2 + wr) * 2 + (fr - 14)) * 256 + bj * 128 + lc + 4 * n) = v;
                        if (ai == 1 && wr == 1) *(gf4*)(HALO + (unsigned)((pm * 2 + (fr - 14)) * 5632 + bj * 2816 + 128 * pn + lc + 4 * n)) = v; }
        }
        asm volatile("s_waitcnt lgkmcnt(0)" ::: "memory"); __builtin_amdgcn_s_barrier(); asm volatile("" ::: "memory");
#pragma unroll
        for (int n = 0; n < 2; ++n)
#pragma unroll
            for (int ai = 0; ai < 2; ++ai) {
                const int src = ai * 2 + wr - 1;
                unsigned res0[4];
#pragma unroll
                for (int jp = 0; jp < 2; ++jp) {
                    const int lcc = lc + 4 * n + 2 * jp;
                    const f32x2v w0g = *(const LAS f32x2v*)(WT + lcc), w1g = *(const LAS f32x2v*)(WT + 256 + lcc), w2g = *(const LAS f32x2v*)(WT + 512 + lcc), bg = *(const LAS f32x2v*)(WT + 768 + lcc);
                    const f32x2v w0v = *(const LAS f32x2v*)(WT + 128 + lcc), w1v = *(const LAS f32x2v*)(WT + 384 + lcc), w2v = *(const LAS f32x2v*)(WT + 640 + lcc), bv = *(const LAS f32x2v*)(WT + 896 + lcc);
                    f32x2v pg = (f32x2v){0.f, 0.f}, pv = (f32x2v){0.f, 0.f};
                    if (src >= 0) { const LAS float* hp = H + (src * 2 + (fr & 1)) * 256 + lcc; pg = *(const LAS f32x2v*)hp; pv = *(const LAS f32x2v*)(hp + 128); }
                    const unsigned gc = (unsigned)(128 * pn + lcc);
#pragma unroll
                    for (int m = 0; m < 4; ++m) {
                        const float sm_ = RSl[ai * 128 + m * 16];
                        const f32x2v cg = (f32x2v){acc[ai][0][m][n][2 * jp] * sm_, acc[ai][0][m][n][2 * jp + 1] * sm_}, cv = (f32x2v){acc[ai][1][m][n][2 * jp] * sm_, acc[ai][1][m][n][2 * jp + 1] * sm_};
                        f32x2v og, ov;
#pragma unroll
                        for (int j = 0; j < 2; ++j) {
                            const float g1 = dpp_mov<0x111>(dpp_mov<0x121>(pg[j], pg[j]), cg[j]), g2 = dpp_mov<0x112>(dpp_mov<0x122>(pg[j], pg[j]), cg[j]);
                            const float v1 = dpp_mov<0x111>(dpp_mov<0x121>(pv[j], pv[j]), cv[j]), v2 = dpp_mov<0x112>(dpp_mov<0x122>(pv[j], pv[j]), cv[j]);
                            og[j] = bg[j] + w2g[j] * cg[j] + w1g[j] * g1 + w0g[j] * g2;
                            ov[j] = bv[j] + w2v[j] * cv[j] + w1v[j] * v1 + w0v[j] * v2; }
                        pg = cg; pv = cv;
                        const int row = pm * 256 + ai * 128 + wr * 64 + m * 16 + fr;
                        const bool partial = (ai == 0) && (m == 0) && (wr == 0) && (fr < 2) && ((pm & 7) != 0);
                        if (partial) { *(gf2*)(PART + ((unsigned)(((pm * 2 + fr) * 2 + 0) * 2816) + gc)) = og; *(gf2*)(PART + ((unsigned)(((pm * 2 + fr) * 2 + 1) * 2816) + gc)) = ov; }
                        const unsigned pk = cvt_pk_bf16(silu_f(og[0]) * ov[0], silu_f(og[1]) * ov[1]);
                        if (jp == 0) res0[m] = pk;
                        else if (!partial) { u32x2 o; o.x = res0[m]; o.y = pk; *(gu2*)(ACT + ((unsigned)(row * DFF) + gc - 2u)) = o; }
                    }
                    asm volatile("" ::: "memory");
                }
            }
    }
};
__device__ __forceinline__ void ffn_fixup(const P& p, int L, int pm) {
    if ((pm & 7) == 0) return;
    unsigned char* ws = p.ws; asm volatile("" : "+s"(ws));
    const float* HALO = (const float*)(ws + WS_HALO); const float* PART = (const float*)(ws + WS_PART); bf16_t* ACT = (bf16_t*)(ws + WS_ACT);
    const float* cw = p.ffn_conv_w + (size_t)L * 3 * 5632;
    const int tid = fresh_tid();
    for (int idx = tid; idx < 2 * DFF; idx += 512) { const int r = idx / DFF, c = idx - r * DFF;
        float g = PART[(((size_t)pm * 2 + r) * 2 + 0) * 2816 + c], v = PART[(((size_t)pm * 2 + r) * 2 + 1) * 2816 + c];
        const float hg0 = HALO[((size_t)(pm - 1) * 2 + 0) * 5632 + c], hg1 = HALO[((size_t)(pm - 1) * 2 + 1) * 5632 + c];
        const float hv0 = HALO[((size_t)(pm - 1) * 2 + 0) * 5632 + 2816 + c], hv1 = HALO[((size_t)(pm - 1) * 2 + 1) * 5632 + 2816 + c];
        if (r == 0) { g += cw[5632 + c] * hg1 + cw[c] * hg0; v += cw[5632 + 2816 + c] * hv1 + cw[2816 + c] * hv0; }
        else { g += cw[c] * hg1; v += cw[2816 + c] * hv1; }
        ACT[((size_t)pm * 256 + r) * DFF + c] = tobf(silu_f(g) * v); }
    asm volatile("s_waitcnt vmcnt(0)" ::: "memory");
    __syncthreads();
}

template <class Epi>
__device__ __forceinline__ void run_gemm_on(LAS unsigned char* lds, const bf16_t* A, const bf16_t* Bt, int m, int n, int k, const Epi& E, int G_, int c_) {
    pg8::Gemm g{A, Bt, m, n, k}; pg8::StaticOrder S; S.init(m, n, G_, c_);
    pg8::gemm_phase<Epi, pg8::StaticOrder, true, true>(lds, g, S, E);
}
template <class Epi>
__device__ __forceinline__ void run_gemm(LAS unsigned char* lds, const bf16_t* A, const bf16_t* Bt, int m, int n, int k, const Epi& E) {
    pg8::Gemm g{A, Bt, m, n, k}; pg8::StaticOrder S; S.init(m, n, (int)gridDim.x, (int)blockIdx.x);
    pg8::gemm_phase<Epi, pg8::StaticOrder, true, true>(lds, g, S, E);
}

template <class SrcCol, class Gain>
__device__ __forceinline__ void tr_item(const float* W, int K, int Nsrc, bf16_t* WT, int nblk, LAS float* scr, int item, int lane, SrcCol srccol, Gain gain) {
    const int kb = item / nblk, nb = item % nblk, k0 = 64 * kb, n0 = 32 * nb;
    const int sc = srccol(n0 + (lane & 31));
#pragma unroll
    for (int i = 0; i < 32; ++i) { const int kk = 2 * i + (lane >> 5);
        float v = 0.f; if (sc >= 0) v = W[(size_t)(k0 + kk) * Nsrc + sc] * gain(k0 + kk);
        scr[kk * 33 + (lane & 31)] = v; }
    LDS_WAIT(); asm volatile("" ::: "memory");
    const int c = lane & 7;
#pragma unroll
    for (int j = 0; j < 4; ++j) { const int n = (lane >> 3) + 8 * j; const LAS float* s = scr + (8 * c) * 33 + n;
        u32x4 o; o.x = cvt_pk_bf16(s[0 * 33], s[1 * 33]); o.y = cvt_pk_bf16(s[2 * 33], s[3 * 33]); o.z = cvt_pk_bf16(s[4 * 33], s[5 * 33]); o.w = cvt_pk_bf16(s[6 * 33], s[7 * 33]);
        *(u32x4*)(WT + (size_t)(n0 + n) * K + k0 + 8 * c) = o; }
    LDS_WAIT(); asm volatile("" ::: "memory");
}

__device__ __forceinline__ void convert_layer(const P& p, int Lw, int Lq, int Lu, int L, LAS float* scr, int gw, int NGW, int lane_unused) {
    const int lane = fresh_tid() & 63;
    unsigned char* ws = p.ws; asm volatile("" : "+s"(ws));
    constexpr int I_IN = 16 * 120, I_UQ = 6 * 48, I_UKV = 4 * 64, I_OUT = 32 * 32, I_MQ = 16 * 32, I_MO = 16 * 32, I_UP = 16 * 176, I_DN = 44 * 32;
    constexpr int NIT = I_IN + I_UQ + I_UKV + I_OUT + I_MQ + I_MO + I_UP + I_DN;
    for (int it = gw; it < NIT; it += NGW) {
        int r = it;
        if (r < I_IN) { if (Lw < 0 || Lw >= DEPTH) continue; const float* g = p.norm_mix + Lw * 1024;
            tr_item(p.w_in + (size_t)Lw * 1024 * 3760, 1024, 3760, (bf16_t*)(ws + WS_WIN), 120, scr, r, lane,
                    [](int n) { return n < 3072 ? n : (n < 3744 ? n + 16 : (n < 3760 ? n - 672 : -1)); }, [g](int k) { return g[k]; }); continue; } r -= I_IN;
        if (r < I_UQ) { if (Lq < 0 || Lq >= DEPTH) continue; const float* g = p.q_norm + Lq * 384;
            tr_item(p.w_uq + (size_t)Lq * 384 * 1536, 384, 1536, (bf16_t*)(ws + WS_WUQ), 48, scr, r, lane, [](int n) { return n; }, [g](int k) { return g[k]; }); continue; } r -= I_UQ;
        if (r < I_UKV) { if (Lq < 0 || Lq >= DEPTH) continue; const float* g = p.kv_norm + Lq * 256;
            tr_item(p.w_ukv + (size_t)Lq * 256 * 2048, 256, 2048, (bf16_t*)(ws + WS_WUKV), 64, scr, r, lane,
                    [](int n) { return n < 1024 ? 128 * (n >> 6) + (n & 63) : 128 * ((n - 1024) >> 6) + 64 + (n & 63); }, [g](int k) { return g[k]; }); continue; } r -= I_UKV;
        if (r < I_OUT) { if (L < 0) continue; const float* g1 = p.ssm_norm + L * 1024; const float* g2 = p.attn_out_norm + L * 1024;
            tr_item(p.w_out + (size_t)L * 2048 * 1024, 2048, 1024, (bf16_t*)(ws + WS_WOUT), 32, scr, r, lane, [](int n) { return n; }, [g1, g2](int k) { return k < 1024 ? g1[k] : g2[k - 1024]; }); continue; } r -= I_OUT;
        if (r < I_MQ) { if (L < 0) continue; const float* g = p.norm_mem_q + L * 1024;
            tr_item(p.w_mq + (size_t)L * 1024 * 1024, 1024, 1024, (bf16_t*)(ws + WS_WMQ), 32, scr, r, lane, [](int n) { return n; }, [g](int k) { return g[k]; }); continue; } r -= I_MQ;
        if (r < I_MO) { if (L < 0) continue;
            tr_item(p.w_mo + (size_t)L * 1024 * 1024, 1024, 1024, (bf16_t*)(ws + WS_WMO), 32, scr, r, lane, [](int n) { return n; }, [](int) { return 1.f; }); continue; } r -= I_MO;
        if (r < I_UP) { if (Lu < 0 || Lu >= DEPTH) continue; const float* g = p.norm_ffn + Lu * 1024;
            tr_item(p.w_up + (size_t)Lu * 1024 * 5632, 1024, 5632, (bf16_t*)(ws + WS_WUP), 176, scr, r, lane, [](int n) { return (n & 128) ? 2816 + 128 * (n >> 8) + (n & 127) : 128 * (n >> 8) + (n & 127); }, [g](int k) { return g[k]; }); continue; } r -= I_UP;
        if (L < 0) continue;
        tr_item(p.w_down + (size_t)L * 2816 * 1024, 2816, 1024, (bf16_t*)(ws + ((L & 1) ? WS_WDN1 : WS_WDN0)), 32, scr, r, lane, [](int n) { return n; }, [](int) { return 1.f; });
    }
}

__device__ __forceinline__ void prologue(const P& p, LAS float* scr, int gw, int NGW, int lane_unused) {
    const int lane = fresh_tid() & 63;
    unsigned char* ws = p.ws; asm volatile("" : "+s"(ws));
    float* rss = (float*)(ws + WS_RSP);
    bf16_t* XB = (bf16_t*)(ws + WS_XB);
    for (int m = gw; m < M; m += NGW) {
        const f32x4* xr = (const f32x4*)(p.x + (size_t)m * 1024) + lane; float ss = 0.f;
#pragma unroll
        for (int j = 0; j < 4; ++j) { const f32x4 v = xr[64 * j]; ss += (v[0] * v[0] + v[1] * v[1]) + (v[2] * v[2] + v[3] * v[3]);
            u32x2 w; w.x = cvt_pk_bf16(v[0], v[1]); w.y = cvt_pk_bf16(v[2], v[3]); *((u32x2*)(XB + (size_t)m * 1024) + lane + 64 * j) = w; }
        ss = wave_sum(ss); if (lane < 16) rss[(size_t)(lane >> 2) * M * 4 + (size_t)m * 4 + (lane & 3)] = (lane == 0) ? ss : 0.f;
    }
    bf16_t* MEMN = (bf16_t*)(ws + WS_MEMN);
    for (int m = gw; m < 2048; m += NGW) {
        const f32x4* xr = (const f32x4*)(p.mem + (size_t)m * 1024) + lane; f32x4 v[4]; float ss = 0.f;
#pragma unroll
        for (int j = 0; j < 4; ++j) { v[j] = xr[64 * j]; ss += (v[j][0] * v[j][0] + v[j][1] * v[j][1]) + (v[j][2] * v[j][2] + v[j][3] * v[j][3]); }
        const float rs = rsqrtf(wave_sum(ss) * (1.f / 1024.f) + EPS);
#pragma unroll
        for (int j = 0; j < 4; ++j) { u32x2 w; w.x = cvt_pk_bf16(v[j][0] * rs, v[j][1] * rs); w.y = cvt_pk_bf16(v[j][2] * rs, v[j][3] * rs); *((u32x2*)(MEMN + (size_t)m * 1024) + lane + 64 * j) = w; }
    }
    float* COS = (float*)(ws + WS_COS); float* SIN = (float*)(ws + WS_SIN);
    for (int i = gw * 64 + lane; i < M * 16; i += NGW * 64) { const int m = i >> 4, k = i & 15;
        const float inv = powf(10000.f, -(float)(2 * k) / 32.f); const float ang = (float)p.pos[m] * inv;
        COS[i] = cosf(ang); SIN[i] = sinf(ang); }
    for (int it = gw; it < 4 * 2 * 512; it += NGW) { const int L = it >> 10, kv = (it >> 9) & 1, r = it & 511; const float* g = p.norm_mem_kv + L * 1024;
        tr_item((kv ? p.w_mv : p.w_mk) + (size_t)L * 1024 * 1024, 1024, 1024, (bf16_t*)(ws + WS_WMKV) + (size_t)(L * 2048 + kv * 1024) * 1024, 32, scr, r, lane, [](int n) { return n; }, [g](int k) { return g[k]; }); }
    convert_layer(p, 0, 0, -1, -1, scr, gw, NGW, lane);
}

__device__ __forceinline__ void pass_l2(const P& p, int L, int gw, int NGW, int lane_unused) {
    const int lane = fresh_tid() & 63;
    unsigned char* ws = p.ws; asm volatile("" : "+s"(ws));
    const bf16_t* XP = (const bf16_t*)(ws + WS_XBCPRE); bf16_t* XO = (bf16_t*)(ws + WS_XBC); const bf16_t* SM = (const bf16_t*)(ws + WS_SM);
    bf16_t* CQN = (bf16_t*)(ws + WS_CQN); bf16_t* CKVN = (bf16_t*)(ws + WS_CKVN); bf16_t* KPE = (bf16_t*)(ws + WS_KPE); float* DT = (float*)(ws + WS_DT);
    const float* COS = (const float*)(ws + WS_COS); const float* SIN = (const float*)(ws + WS_SIN);
    const float* cw = p.ssm_conv_w + (size_t)L * 4 * 2048; const float* cb = p.ssm_conv_b + (size_t)L * 2048;
    for (int blk = gw; blk < M / 8; blk += NGW) {
        const int m0 = blk * 8, t0 = m0 & (SEQ - 1);
#pragma unroll 2
        for (int j = 0; j < 4; ++j) {
            const int c = lane * 8 + 512 * j;
            const f32x4 b0 = *(const f32x4*)(cb + c), b1 = *(const f32x4*)(cb + c + 4);
            f32x4 w0[4], w1[4];
#pragma unroll
            for (int k = 0; k < 4; ++k) { w0[k] = *(const f32x4*)(cw + k * 2048 + c); w1[k] = *(const f32x4*)(cw + k * 2048 + c + 4); }
            u32x4 xr[11];
#pragma unroll
            for (int i = 0; i < 11; ++i) { if (t0 - 3 + i >= 0) xr[i] = *(const u32x4*)(XP + (size_t)(m0 - 3 + i) * 2048 + c); else xr[i] = (u32x4){0u, 0u, 0u, 0u}; }
#pragma unroll
            for (int r = 0; r < 8; ++r) {
                f32x4 a0 = b0, a1 = b1;
#pragma unroll
                for (int k = 0; k < 4; ++k) { const u32x4 v = xr[r + k];
                    a0[0] += w0[k][0] * bflo(v.x); a0[1] += w0[k][1] * bfhi(v.x); a0[2] += w0[k][2] * bflo(v.y); a0[3] += w0[k][3] * bfhi(v.y);
                    a1[0] += w1[k][0] * bflo(v.z); a1[1] += w1[k][1] * bfhi(v.z); a1[2] += w1[k][2] * bflo(v.w); a1[3] += w1[k][3] * bfhi(v.w); }
                u32x4 o; o.x = cvt_pk_bf16(silu_f(a0[0]), silu_f(a0[1])); o.y = cvt_pk_bf16(silu_f(a0[2]), silu_f(a0[3]));
                o.z = cvt_pk_bf16(silu_f(a1[0]), silu_f(a1[1])); o.w = cvt_pk_bf16(silu_f(a1[2]), silu_f(a1[3]));
                *(u32x4*)(XO + (size_t)(m0 + r) * 2048 + c) = o;
            }
        }
    }
    for (int m = gw; m < M; m += NGW) {
        const unsigned* sm = (const unsigned*)(SM + (size_t)m * 768);
        {
            unsigned w[3]; float ss = 0.f;
#pragma unroll
            for (int i = 0; i < 3; ++i) { w[i] = sm[lane + 64 * i]; const float a = bflo(w[i]), b = bfhi(w[i]); ss += a * a + b * b; }
            const float rs = rsqrtf(wave_sum(ss) * (1.f / 384.f) + EPS);
#pragma unroll
            for (int i = 0; i < 3; ++i) ((unsigned*)(CQN + (size_t)m * 384))[lane + 64 * i] = cvt_pk_bf16(bflo(w[i]) * rs, bfhi(w[i]) * rs);
        }
        {
            unsigned w[2]; float ss = 0.f;
#pragma unroll
            for (int i = 0; i < 2; ++i) { w[i] = sm[192 + lane + 64 * i]; const float a = bflo(w[i]), b = bfhi(w[i]); ss += a * a + b * b; }
            const float rs = rsqrtf(wave_sum(ss) * (1.f / 256.f) + EPS);
#pragma unroll
            for (int i = 0; i < 2; ++i) ((unsigned*)(CKVN + (size_t)m * 256))[lane + 64 * i] = cvt_pk_bf16(bflo(w[i]) * rs, bfhi(w[i]) * rs);
        }
        {
            const bf16_t* sr = SM + (size_t)m * 768;
            const float v = bf1(sr[640 + (lane & 31)]); const float pr = __shfl_xor(v, 16); const int i = lane & 15;
            const float c = COS[(size_t)m * 16 + i], s = SIN[(size_t)m * 16 + i];
            const float o = (lane & 16) ? (v * c + pr * s) : (v * c - pr * s);
            if (lane < 32) KPE[(size_t)m * 32 + lane] = tobf(o);
            const float d = bf1(sr[672 + (lane & 15)]) + p.dt_bias[L * 16 + (lane & 15)];
            const float sp = fmaxf(d, 0.f) + __logf(1.f + __expf(-fabsf(d)));
            if (lane < 16) DT[(size_t)m * 16 + lane] = sp;
        }
    }
}

__device__ __forceinline__ void pass_ycnorm(const P& p, int gw, int NGW, int lane_unused) {
    const int lane = fresh_tid() & 63;
    unsigned char* ws = p.ws; asm volatile("" : "+s"(ws));
    bf16_t* YC = (bf16_t*)(ws + WS_YC);
    for (int m0 = gw; m0 < M; m0 += 2 * NGW) {
        u32x4 v[2][4];
#pragma unroll
        for (int q = 0; q < 2; ++q) { const int m = m0 + q * NGW; if (m < M) {
#pragma unroll
            for (int j = 0; j < 4; ++j) v[q][j] = ((const u32x4*)(YC + (size_t)m * 2048))[lane + 64 * j]; } }
#pragma unroll
        for (int q = 0; q < 2; ++q) { const int m = m0 + q * NGW; if (m < M) {
            u32x4* row = (u32x4*)(YC + (size_t)m * 2048); float s[2] = {0.f, 0.f};
#pragma unroll
            for (int j = 0; j < 4; ++j) { const u32x4 w = v[q][j]; float a = 0.f;
                a += bflo(w.x) * bflo(w.x) + bfhi(w.x) * bfhi(w.x); a += bflo(w.y) * bflo(w.y) + bfhi(w.y) * bfhi(w.y);
                a += bflo(w.z) * bflo(w.z) + bfhi(w.z) * bfhi(w.z); a += bflo(w.w) * bflo(w.w) + bfhi(w.w) * bfhi(w.w);
                s[j >> 1] += a; }
            const float r0 = rsqrtf(wave_sum(s[0]) * (1.f / 1024.f) + EPS), r1 = rsqrtf(wave_sum(s[1]) * (1.f / 1024.f) + EPS);
#pragma unroll
            for (int j = 0; j < 4; ++j) { const float r = (j < 2) ? r0 : r1; const u32x4 w = v[q][j]; u32x4 o;
                o.x = cvt_pk_bf16(bflo(w.x) * r, bfhi(w.x) * r); o.y = cvt_pk_bf16(bflo(w.y) * r, bfhi(w.y) * r);
                o.z = cvt_pk_bf16(bflo(w.z) * r, bfhi(w.z) * r); o.w = cvt_pk_bf16(bflo(w.w) * r, bfhi(w.w) * r);
                row[lane + 64 * j] = o; } } }
    }
}

__device__ __forceinline__ void pass_ffnact(const P& p, int L, int half, int gw, int NGW, int lane_unused) {
    const int lane = fresh_tid() & 63;
    unsigned char* ws = p.ws; asm volatile("" : "+s"(ws));
    const bf16_t* U = (const bf16_t*)(ws + WS_U); bf16_t* ACT = (bf16_t*)(ws + WS_ACT) + (size_t)half * 8192 * DFF;
    const float* cw = p.ffn_conv_w + (size_t)L * 3 * 5632; const float* cb = p.ffn_conv_b + (size_t)L * 5632;
    for (int blk = gw; blk < 8192 / 4; blk += NGW) {
        const int m0 = blk * 4, t0 = m0 & (SEQ - 1);
        for (int ch = lane; ch < DFF / 8; ch += 64) {
            const int c = ch * 8;
            const f32x4 bg0 = *(const f32x4*)(cb + c), bg1 = *(const f32x4*)(cb + c + 4), bv0 = *(const f32x4*)(cb + DFF + c), bv1 = *(const f32x4*)(cb + DFF + c + 4);
            f32x4 wg0[3], wg1[3], wv0[3], wv1[3];
#pragma unroll
            for (int k = 0; k < 3; ++k) { const float* wk = cw + k * 5632; wg0[k] = *(const f32x4*)(wk + c); wg1[k] = *(const f32x4*)(wk + c + 4); wv0[k] = *(const f32x4*)(wk + DFF + c); wv1[k] = *(const f32x4*)(wk + DFF + c + 4); }
            u32x4 ug[6], uv[6];
#pragma unroll
            for (int i = 0; i < 6; ++i) { if (t0 - 2 + i >= 0) { const bf16_t* ur = U + (size_t)(m0 - 2 + i) * 5632; ug[i] = *(const u32x4*)(ur + c); uv[i] = *(const u32x4*)(ur + DFF + c); }
                else { ug[i] = (u32x4){0u, 0u, 0u, 0u}; uv[i] = (u32x4){0u, 0u, 0u, 0u}; } }
#pragma unroll
            for (int r = 0; r < 4; ++r) {
                f32x4 g0 = bg0, g1 = bg1, v0 = bv0, v1 = bv1;
#pragma unroll
                for (int k = 0; k < 3; ++k) { const u32x4 a = ug[r + k], b = uv[r + k];
                    g0[0] += wg0[k][0] * bflo(a.x); g0[1] += wg0[k][1] * bfhi(a.x); g0[2] += wg0[k][2] * bflo(a.y); g0[3] += wg0[k][3] * bfhi(a.y);
                    g1[0] += wg1[k][0] * bflo(a.z); g1[1] += wg1[k][1] * bfhi(a.z); g1[2] += wg1[k][2] * bflo(a.w); g1[3] += wg1[k][3] * bfhi(a.w);
                    v0[0] += wv0[k][0] * bflo(b.x); v0[1] += wv0[k][1] * bfhi(b.x); v0[2] += wv0[k][2] * bflo(b.y); v0[3] += wv0[k][3] * bfhi(b.y);
                    v1[0] += wv1[k][0] * bflo(b.z); v1[1] += wv1[k][1] * bfhi(b.z); v1[2] += wv1[k][2] * bflo(b.w); v1[3] += wv1[k][3] * bfhi(b.w); }
                u32x4 o; o.x = cvt_pk_bf16(silu_f(g0[0]) * v0[0], silu_f(g0[1]) * v0[1]); o.y = cvt_pk_bf16(silu_f(g0[2]) * v0[2], silu_f(g0[3]) * v0[3]);
                o.z = cvt_pk_bf16(silu_f(g1[0]) * v1[0], silu_f(g1[1]) * v1[1]); o.w = cvt_pk_bf16(silu_f(g1[2]) * v1[2], silu_f(g1[3]) * v1[3]);
                *(u32x4*)(ACT + (size_t)(m0 + r) * DFF + c) = o;
            }
        }
    }
}

__device__ __forceinline__ void pass_final(const P& p, int gw, int NGW, int lane_unused) {
    const int lane = fresh_tid() & 63;
    const float* rss = (const float*)(p.ws + WS_RSP);
    for (int m = gw; m < M; m += NGW) {
        const float rs = rsqrtf(rss16(rss, m) * (1.f / 1024.f) + EPS);
        f32x4* xr = (f32x4*)(p.out + (size_t)m * 1024) + lane; const f32x4* g = (const f32x4*)p.final_norm + lane;
#pragma unroll
        for (int j = 0; j < 4; ++j) { f32x4 v = xr[64 * j]; v = v * rs * g[64 * j]; xr[64 * j] = v; }
    }
}

typedef short v4i16_t __attribute__((ext_vector_type(4)));
__device__ __forceinline__ s16x4 vtr(const LAS unsigned char* p) { return __builtin_bit_cast(s16x4, __builtin_amdgcn_ds_read_tr16_b64_v4i16((LAS v4i16_t*)p)); }
__device__ __forceinline__ bf16x8 join8(s16x4 lo, s16x4 hi) { return (bf16x8){lo[0], lo[1], lo[2], lo[3], hi[0], hi[1], hi[2], hi[3]}; }
__device__ __forceinline__ bf16x8 pack8(const f32x16& s, int b) {
    u32x4 w; w.x = cvt_pk_bf16(s[b], s[b + 1]); w.y = cvt_pk_bf16(s[b + 2], s[b + 3]); w.z = cvt_pk_bf16(s[b + 4], s[b + 5]); w.w = cvt_pk_bf16(s[b + 6], s[b + 7]);
    return __builtin_bit_cast(bf16x8, w);
}

template <int DQK, int DV, bool CAUSAL, bool K2>
__device__ __forceinline__ void attn_unit(LAS unsigned char* lds, const bf16_t* Q, int qpitch, const bf16_t* Qp2, int q2pitch, const bf16_t* K, int kpitch, const bf16_t* Kp2, int k2pitch,
                                          const bf16_t* V, int vpitch, bf16_t* O, int opitch, int q0, int NT) {
    constexpr int KP = (DQK + 8) * 2, VP = (DV == 64) ? 192 : 320;
    constexpr int KBUF = 64 * KP, VBUF = 64 * VP, BUF = KBUF + VBUF;
    constexpr int KCH = DQK / 8, VCH = DV / 8, NKC = 64 * KCH, NVC = 64 * VCH;
    constexpr int NKR = (NKC + 511) / 512, NVR = NVC / 512;
    const int tid = fresh_tid(), lane = tid & 63, w = __builtin_amdgcn_readfirstlane(tid >> 6), ql = lane & 31, hi = lane >> 5;
    u32x4 kreg[NKR], vreg[NVR];
    auto gload = [&](int t) {
#pragma unroll
        for (int i = 0; i < NKR; ++i) { const int id = tid + 512 * i;
            if (id < NKC) { const int row = id / KCH, c = id % KCH; const size_t kv = (size_t)(64 * t + row);
                if (K2 && c >= (DQK - 32) / 8) kreg[i] = *(const u32x4*)(Kp2 + kv * k2pitch + (c - (DQK - 32) / 8) * 8);
                else kreg[i] = *(const u32x4*)(K + kv * kpitch + c * 8); } }
#pragma unroll
        for (int i = 0; i < NVR; ++i) { const int id = tid + 512 * i; const int row = id / VCH, c = id % VCH;
            vreg[i] = *(const u32x4*)(V + (size_t)(64 * t + row) * vpitch + c * 8); }
    };
    auto lstore = [&](int b) {
        LAS unsigned char* kb = lds + b * BUF; LAS unsigned char* vb = kb + KBUF;
#pragma unroll
        for (int i = 0; i < NKR; ++i) { const int id = tid + 512 * i; if (id < NKC) { const int row = id / KCH, c = id % KCH; *(LAS u32x4*)(kb + row * KP + c * 16) = kreg[i]; } }
#pragma unroll
        for (int i = 0; i < NVR; ++i) { const int id = tid + 512 * i; const int row = id / VCH, c = id % VCH; *(LAS u32x4*)(vb + row * VP + c * 16) = vreg[i]; }
    };
    gload(0);
    bf16x8 qf[DQK / 16];
#pragma unroll
    for (int d0 = 0; d0 < DQK / 16; ++d0) {
        if (K2 && d0 >= (DQK - 32) / 16) qf[d0] = *(const bf16x8*)(Qp2 + (size_t)(32 * w + ql) * q2pitch + 16 * (d0 - (DQK - 32) / 16) + 8 * hi);
        else qf[d0] = *(const bf16x8*)(Q + (size_t)(32 * w + ql) * qpitch + 16 * d0 + 8 * hi); }
    f32x16 oacc[DV / 32];
#pragma unroll
    for (int i = 0; i < DV / 32; ++i)
#pragma unroll
        for (int r = 0; r < 16; ++r) oacc[i][r] = 0.f;
    float m_run = -INFINITY, l_run = 0.f;
    const int q0w = q0 + 32 * w, qg = q0w + ql;
    lstore(0);
    __syncthreads();
    const int vtoff = (4 * hi + ((lane & 15) >> 2)) * VP + (16 * ((lane >> 4) & 1) + 4 * (lane & 3)) * 2;
    for (int t = 0; t < NT; ++t) {
        if (t + 1 < NT) gload(t + 1);
        const bool active = !CAUSAL || (64 * t <= q0w + 31);
        if (active) {
            const LAS unsigned char* kb = lds + (t & 1) * BUF; const LAS unsigned char* vb = kb + KBUF;
            f32x16 s0, s1;
#pragma unroll
            for (int r = 0; r < 16; ++r) { s0[r] = 0.f; s1[r] = 0.f; }
#pragma unroll
            for (int d0 = 0; d0 < DQK / 16; ++d0) {
                const bf16x8 a0 = *(const LAS bf16x8*)(kb + ql * KP + (16 * d0 + 8 * hi) * 2);
                const bf16x8 a1 = *(const LAS bf16x8*)(kb + (32 + ql) * KP + (16 * d0 + 8 * hi) * 2);
                s0 = __builtin_amdgcn_mfma_f32_32x32x16_bf16(a0, qf[d0], s0, 0, 0, 0);
                s1 = __builtin_amdgcn_mfma_f32_32x32x16_bf16(a1, qf[d0], s1, 0, 0, 0);
            }
            if (CAUSAL && (64 * t + 63 > q0w)) {
#pragma unroll
                for (int r = 0; r < 16; ++r) { const int kv = 64 * t + crow(r, hi); if (kv > qg) s0[r] = -INFINITY; if (kv + 32 > qg) s1[r] = -INFINITY; }
            }
            float mx = s0[0];
#pragma unroll
            for (int r = 1; r < 16; ++r) mx = fmaxf(mx, s0[r]);
#pragma unroll
            for (int r = 0; r < 16; ++r) mx = fmaxf(mx, s1[r]);
            { const auto rr = __builtin_amdgcn_permlane32_swap(__float_as_uint(mx), __float_as_uint(mx), false, false);
              mx = fmaxf(__uint_as_float(rr[0]), __uint_as_float(rr[1])); }
            if (__any(mx > m_run + 8.f)) {
                const float m_new = fmaxf(m_run, mx);
                const float alpha = __builtin_amdgcn_exp2f(m_run - m_new);
                m_run = m_new; l_run *= alpha;
#pragma unroll
                for (int i = 0; i < DV / 32; ++i)
#pragma unroll
                    for (int r = 0; r < 16; ++r) oacc[i][r] *= alpha;
            }
            float ps = 0.f;
#pragma unroll
            for (int r = 0; r < 16; ++r) { s0[r] = __builtin_amdgcn_exp2f(s0[r] - m_run); s1[r] = __builtin_amdgcn_exp2f(s1[r] - m_run); ps += s0[r] + s1[r]; }
            l_run += ps;
            const bf16x8 p00 = pack8(s0, 0), p01 = pack8(s0, 8), p10 = pack8(s1, 0), p11 = pack8(s1, 8);
#pragma unroll
            for (int i = 0; i < DV / 32; ++i) {
                const LAS unsigned char* vp = vb + vtoff + i * 64;
                { const bf16x8 a = join8(vtr(vp + (0) * VP), vtr(vp + (8) * VP)); oacc[i] = __builtin_amdgcn_mfma_f32_32x32x16_bf16(a, p00, oacc[i], 0, 0, 0); }
                { const bf16x8 a = join8(vtr(vp + (16) * VP), vtr(vp + (24) * VP)); oacc[i] = __builtin_amdgcn_mfma_f32_32x32x16_bf16(a, p01, oacc[i], 0, 0, 0); }
                { const bf16x8 a = join8(vtr(vp + (32) * VP), vtr(vp + (40) * VP)); oacc[i] = __builtin_amdgcn_mfma_f32_32x32x16_bf16(a, p10, oacc[i], 0, 0, 0); }
                { const bf16x8 a = join8(vtr(vp + (48) * VP), vtr(vp + (56) * VP)); oacc[i] = __builtin_amdgcn_mfma_f32_32x32x16_bf16(a, p11, oacc[i], 0, 0, 0); }
            }
        }
        if (t + 1 < NT) lstore((t + 1) & 1);
        __syncthreads();
    }
    const float lt = l_run + __shfl_xor(l_run, 32); const float inv = 1.f / lt;
    bf16_t* orow = O + (size_t)(32 * w + ql) * opitch;
#pragma unroll
    for (int i = 0; i < DV / 32; ++i)
#pragma unroll
        for (int rr = 0; rr < 4; ++rr) { u32x2 o; o.x = cvt_pk_bf16(oacc[i][4 * rr] * inv, oacc[i][4 * rr + 1] * inv); o.y = cvt_pk_bf16(oacc[i][4 * rr + 2] * inv, oacc[i][4 * rr + 3] * inv);
            *(u32x2*)(orow + 32 * i + 8 * rr + 4 * hi) = o; }
}

constexpr int SS_BP = 272, SS_XP = 144;
constexpr int SS_B = 0, SS_C = 34816, SS_XD = 69632  , SS_XDD = 88064  , SS_ZI = 106496  , SS_SB = 124928, SS_CS = 142336, SS_DT = 142848;
constexpr int SS_ECS = SS_DT + 512, SS_CSD = SS_DT + 1024;
static_assert(SS_CSD + 512 <= LDS_BYTES - 64, "SSD LDS map");
__device__ __forceinline__ void ssd_unit(const P& p, int L, LAS unsigned char* lds, int b, int h) {
    unsigned char* ws = p.ws; asm volatile("" : "+s"(ws));
    const bf16_t* XBC = (const bf16_t*)(ws + WS_XBC); const bf16_t* Z = (const bf16_t*)(ws + WS_Z); const float* DT = (const float*)(ws + WS_DT); bf16_t* YC = (bf16_t*)(ws + WS_YC);
    const int tid = fresh_tid(), lane = tid & 63, w = __builtin_amdgcn_readfirstlane(tid >> 6), ql = lane & 31, hi = lane >> 5;
    const int g = h >> 2;
    const float Ah = -__expf(p.a_log[L * 16 + h]); const float dsk = p.d_skip[L * 16 + h];
    const int lb = (w < 4) ? w : (7 - w), pb = (w >> 1) & 1;
    LAS float* CS = (LAS float*)(lds + SS_CS); LAS float* DTS = (LAS float*)(lds + SS_DT);
    f32x16 sacc;
#pragma unroll
    for (int r = 0; r < 16; ++r) sacc[r] = 0.f;
    for (int i = tid; i < 64 * SS_BP / 4; i += 512) ((LAS unsigned*)(lds + SS_SB))[i] = 0u;
    u32x4 breg[4], creg[4], xreg[2], zreg[2]; float dreg[2] = {0.f, 0.f};
    auto gload = [&](int c) {
        const size_t m0 = (size_t)b * SEQ + (size_t)c * 128;
#pragma unroll
        for (int i = 0; i < 4; ++i) { const int id = tid + 512 * i, row = id >> 4, c16 = id & 15;
            breg[i] = *(const u32x4*)(XBC + (m0 + row) * 2048 + 1024 + g * 128 + 8 * c16);
            creg[i] = *(const u32x4*)(XBC + (m0 + row) * 2048 + 1536 + g * 128 + 8 * c16); }
#pragma unroll
        for (int i = 0; i < 2; ++i) { const int id = tid + 512 * i, row = id >> 3, c8 = id & 7; xreg[i] = *(const u32x4*)(XBC + (m0 + row) * 2048 + h * 64 + 8 * c8); zreg[i] = *(const u32x4*)(Z + (m0 + row) * 1024 + h * 64 + 8 * c8); }
        if (w == 0) { dreg[0] = DT[(m0 + 2 * lane) * 16 + h]; dreg[1] = DT[(m0 + 2 * lane + 1) * 16 + h]; }
    };
    gload(0);
    const int troff = (((lane & 15) >> 2)) ;
    const int tcol = 16 * ((lane >> 4) & 1) + 4 * (lane & 3);
    for (int c = 0; c < 16; ++c) {
        const size_t m0 = (size_t)b * SEQ + (size_t)c * 128;
        if (w == 0) {
            const float v0 = dreg[0] * Ah, v1 = dreg[1] * Ah; float s = v0 + v1;
#pragma unroll
            for (int o = 1; o < 64; o <<= 1) { const float t = __shfl_up(s, o); if (lane >= o) s += t; }
            CS[2 * lane] = s - v1; CS[2 * lane + 1] = s; DTS[2 * lane] = dreg[0]; DTS[2 * lane + 1] = dreg[1];
            { LAS float* ECS = (LAS float*)(lds + SS_ECS); LAS float* CSD = (LAS float*)(lds + SS_CSD);
              ECS[2 * lane] = __expf(s - v1); ECS[2 * lane + 1] = __expf(s); CSD[2 * lane] = (s - v1) - __logf(dreg[0]); CSD[2 * lane + 1] = s - __logf(dreg[1]); }
        }
#pragma unroll
        for (int i = 0; i < 4; ++i) { const int id = tid + 512 * i, row = id >> 4, c16 = id & 15;
            *(LAS u32x4*)(lds + SS_B + row * SS_BP + c16 * 16) = breg[i]; *(LAS u32x4*)(lds + SS_C + row * SS_BP + c16 * 16) = creg[i]; }
        __syncthreads();
        { const float cend = CS[127];
#pragma unroll
          for (int i = 0; i < 2; ++i) { const int id = tid + 512 * i, row = id >> 3, c8 = id & 7; const float e = DTS[row] * __expf(cend - CS[row]);
              const u32x4 v = xreg[i]; u32x4 o2;
              o2.x = cvt_pk_bf16(bflo(v.x) * e, bfhi(v.x) * e); o2.y = cvt_pk_bf16(bflo(v.y) * e, bfhi(v.y) * e); o2.z = cvt_pk_bf16(bflo(v.z) * e, bfhi(v.z) * e); o2.w = cvt_pk_bf16(bflo(v.w) * e, bfhi(v.w) * e);
              *(LAS u32x4*)(lds + SS_XD + row * SS_XP + c8 * 16) = v; *(LAS u32x4*)(lds + SS_XDD + row * SS_XP + c8 * 16) = o2; *(LAS u32x4*)(lds + SS_ZI + row * SS_XP + c8 * 16) = zreg[i]; } }
        __syncthreads();
        if (c + 1 < 16) gload(c + 1);
        f32x16 yacc, oac;
#pragma unroll
        for (int r = 0; r < 16; ++r) { yacc[r] = 0.f; oac[r] = 0.f; }
        const float cs_l = CS[32 * lb + ql];
        for (int sb = 0; sb <= lb; ++sb) {
            f32x16 gt;
#pragma unroll
            for (int r = 0; r < 16; ++r) gt[r] = 0.f;
#pragma unroll
            for (int ks = 0; ks < 8; ++ks) {
                const bf16x8 a = *(const LAS bf16x8*)(lds + SS_B + (32 * sb + ql) * SS_BP + (16 * ks + 8 * hi) * 2);
                const bf16x8 bb = *(const LAS bf16x8*)(lds + SS_C + (32 * lb + ql) * SS_BP + (16 * ks + 8 * hi) * 2);
                gt = __builtin_amdgcn_mfma_f32_32x32x16_bf16(a, bb, gt, 0, 0, 0);
            }
            const int lg = 32 * lb + ql;
#pragma unroll
            for (int r = 0; r < 16; ++r) { const int s = 32 * sb + crow(r, hi); const float e = __expf(cs_l - ((const LAS float*)(lds + SS_CSD))[s]); gt[r] = (s <= lg) ? gt[r] * e : 0.f; }
            const bf16x8 w0 = pack8(gt, 0), w1 = pack8(gt, 8);
            const LAS unsigned char* xp = lds + SS_XD + (32 * sb + 4 * hi + troff) * SS_XP + (32 * pb + tcol) * 2;
            { const bf16x8 bx = join8(vtr(xp), vtr(xp + 8 * SS_XP)); yacc = __builtin_amdgcn_mfma_f32_32x32x16_bf16(w0, bx, yacc, 0, 0, 0); }
            { const bf16x8 bx = join8(vtr(xp + 16 * SS_XP), vtr(xp + 24 * SS_XP)); yacc = __builtin_amdgcn_mfma_f32_32x32x16_bf16(w1, bx, yacc, 0, 0, 0); }
        }
#pragma unroll
        for (int ks = 0; ks < 8; ++ks) {
            const bf16x8 a = *(const LAS bf16x8*)(lds + SS_C + (32 * lb + ql) * SS_BP + (16 * ks + 8 * hi) * 2);
            const bf16x8 bb = *(const LAS bf16x8*)(lds + SS_SB + (32 * pb + ql) * SS_BP + (16 * ks + 8 * hi) * 2);
            oac = __builtin_amdgcn_mfma_f32_32x32x16_bf16(a, bb, oac, 0, 0, 0);
        }
#pragma unroll
        for (int r = 0; r < 16; ++r) { const int l = 32 * lb + crow(r, hi); const size_t m = m0 + l; const int col = h * 64 + 32 * pb + ql;
            const float xv = bf1(*(const LAS bf16_t*)(lds + SS_XD + l * SS_XP + (32 * pb + ql) * 2)); const float zv = bf1(*(const LAS bf16_t*)(lds + SS_ZI + l * SS_XP + (32 * pb + ql) * 2));
            const float y = yacc[r] + oac[r] * ((const LAS float*)(lds + SS_ECS))[l] + xv * dsk;
            YC[m * 2048 + col] = tobf(y * silu_f(zv)); }
        { const float dec = __expf(CS[127]);
#pragma unroll
          for (int r = 0; r < 16; ++r) sacc[r] *= dec;
#pragma unroll
          for (int st = 0; st < 8; ++st) {
              const LAS unsigned char* ap = lds + SS_XDD + (16 * st + 8 * hi + troff) * SS_XP + (32 * pb + tcol) * 2;
              const LAS unsigned char* bp = lds + SS_B + (16 * st + 8 * hi + troff) * SS_BP + (32 * lb + tcol) * 2;
              const bf16x8 a = join8(vtr(ap), vtr(ap + 4 * SS_XP)); const bf16x8 bb = join8(vtr(bp), vtr(bp + 4 * SS_BP));
              sacc = __builtin_amdgcn_mfma_f32_32x32x16_bf16(a, bb, sacc, 0, 0, 0);
          } }
        __syncthreads();
#pragma unroll
        for (int r = 0; r < 16; ++r) *(LAS bf16_t*)(lds + SS_SB + (32 * pb + crow(r, hi)) * SS_BP + (32 * lb + ql) * 2) = tobf(sacc[r]);
    }
    __syncthreads();
}

#define XB_TMO      128
#define XB_XCNT(j)  (256  + 64 * (j))
#define XB_XSUB(j)  (1280 + 64 * (j))
#define XB_XGEN(j)  (2304 + 64 * (j))
#define XB_TOP      3328
#define XB_TOPGEN   3392
#define XCD_BAR_WORDS 3456
#define XB_SPIN_CAP (1u << 18)

__device__ __forceinline__ unsigned xb_ld(unsigned* p)              { return __hip_atomic_load(p, __ATOMIC_RELAXED, __HIP_MEMORY_SCOPE_AGENT); }
__device__ __forceinline__ unsigned xb_add(unsigned* p, unsigned v) { return __hip_atomic_fetch_add(p, v, __ATOMIC_RELAXED, __HIP_MEMORY_SCOPE_AGENT); }
__device__ __forceinline__ unsigned xb_xcc_id() { return (unsigned)__builtin_amdgcn_s_getreg((3 << 11) | 20) & 0xFu; }
#define XB_SPIN(cond, bar) do { unsigned _sp = 0; while (cond) { __builtin_amdgcn_s_sleep(1); \
    if ((++_sp & 255u) == 0u) { if (xb_ld(&(bar)[XB_TMO])) break; if (_sp > XB_SPIN_CAP) { atomicAdd(&(bar)[XB_TMO], 1u); break; } } } } while (0)

struct XcdBarrier {
    unsigned* bar; unsigned x;
    volatile LAS unsigned* st;
};

__device__ __forceinline__ XcdBarrier xcd_barrier_post(unsigned* bar, volatile LAS unsigned* st) {
    XcdBarrier b; b.bar = bar; b.x = xb_xcc_id(); b.st = st;
    if (threadIdx.x == 0) (void)xb_add(&bar[XB_XCNT(b.x)], 1u);
    return b;
}
__device__ __forceinline__ void xcd_barrier_complete(unsigned* bar, unsigned x, unsigned& nloc, unsigned& nx) {
    const unsigned G = gridDim.x * gridDim.y * gridDim.z;
    unsigned sum, cnt, mine, sp = 0u;
    for (;;) {
        sum = 0u; cnt = 0u; mine = 0u;
#pragma unroll
        for (unsigned j = 0; j < 16; ++j) { const unsigned c = xb_ld(&bar[XB_XCNT(j)]); sum += c; cnt += (c > 0u) ? 1u : 0u; mine = (j == x) ? c : mine; }
        if (sum == G) break;
        __builtin_amdgcn_s_sleep(1);
        if ((++sp & 255u) == 0u) { if (xb_ld(&bar[XB_TMO])) break; if (sp > XB_SPIN_CAP) { atomicAdd(&bar[XB_TMO], 1u); break; } }
    }
    nloc = mine > 0u ? mine : 1u; nx = cnt > 0u ? cnt : 1u;
}

__device__ __forceinline__ void xcd_barrier(const XcdBarrier& b) {
    asm volatile("s_waitcnt vmcnt(0)" ::: "memory");
    __syncthreads();
    if (threadIdx.x == 0) {
        unsigned* bar = b.bar; unsigned bx_ = b.x; asm volatile("" : "+s"(bar), "+s"(bx_));
        __builtin_amdgcn_s_waitcnt(0);
        unsigned nloc = b.st[0], nx = b.st[1];
        if (nloc == 0u) { xcd_barrier_complete(bar, bx_, nloc, nx); b.st[0] = nloc; b.st[1] = nx; }
        const unsigned old = xb_add(&bar[XB_XSUB(bx_)], 1u);
        const unsigned gen = old / nloc;
        if (old + 1u == (gen + 1u) * nloc) {
            __builtin_amdgcn_fence(__ATOMIC_RELEASE, "agent");
            asm volatile("s_waitcnt vmcnt(0)" ::: "memory");
            const unsigned og = xb_add(&bar[XB_TOP], 1u);
            const unsigned tg = og / nx;
            if (og + 1u == (tg + 1u) * nx) xb_add(&bar[XB_TOPGEN], 1u);
            else XB_SPIN(xb_ld(&bar[XB_TOPGEN]) == tg, bar);
            __builtin_amdgcn_fence(__ATOMIC_ACQUIRE, "agent");
            xb_add(&bar[XB_XGEN(bx_)], 1u);
            asm volatile("s_waitcnt vmcnt(0)" ::: "memory");
        } else {
            XB_SPIN(xb_ld(&bar[XB_XGEN(bx_)]) == gen, bar);
            __builtin_amdgcn_fence(__ATOMIC_ACQUIRE, "agent");
            asm volatile("s_waitcnt vmcnt(0)" ::: "memory");
        }
    }
    __syncthreads();
}

__device__ __forceinline__ void my_grid_sync(unsigned* bar, unsigned& gen) {
    asm volatile("s_waitcnt vmcnt(0) lgkmcnt(0)" ::: "memory");
    __syncthreads();
    gen += 1u;
    if (threadIdx.x == 0) {
        __builtin_amdgcn_fence(__ATOMIC_RELEASE, "agent");
        asm volatile("s_waitcnt vmcnt(0)" ::: "memory");
        __hip_atomic_fetch_add(bar, 1u, __ATOMIC_RELAXED, __HIP_MEMORY_SCOPE_AGENT);
        const unsigned target = gen * gridDim.x;
        while (__hip_atomic_load(bar, __ATOMIC_RELAXED, __HIP_MEMORY_SCOPE_AGENT) < target) __builtin_amdgcn_s_sleep(1);
        __builtin_amdgcn_fence(__ATOMIC_ACQUIRE, "agent");
        asm volatile("s_waitcnt vmcnt(0)" ::: "memory");
    }
    __syncthreads();
    asm volatile("buffer_inv sc1\n\ts_waitcnt vmcnt(0)" ::: "memory");
}
#ifdef DUP_SYNC
#define SYNC2() xcd_barrier(xbar)
#else
#define SYNC2() do {} while (0)
#endif
#define GRID_SYNC() do { xcd_barrier(xbar); SYNC2(); ws = p.ws; asm volatile("" : "+s"(ws)); RSS = (float*)(ws + WS_RSP); XB = (bf16_t*)(ws + WS_XB); } while (0)
__global__ void __launch_bounds__(512, 2) trunk_fwd(P p) {
    extern __shared__ __attribute__((aligned(16))) unsigned char lds_raw[];
    cg::grid_group grid = cg::this_grid();
    LAS unsigned char* lds = (LAS unsigned char*)lds_raw;
    const int tid = threadIdx.x, lane = tid & 63, wave = __builtin_amdgcn_readfirstlane(tid >> 6);
    const int G = gridDim.x, gw = blockIdx.x * 8 + wave, NGW = G * 8;
    LAS float* scr = (LAS float*)(lds + wave * 16384);
    const int vcu = (G % 8 == 0) ? ((int)blockIdx.x % 8) * (G / 8) + (int)blockIdx.x / 8 : (int)blockIdx.x;
    unsigned char* ws = p.ws; asm volatile("" : "+s"(ws));
    float* RSS = (float*)(ws + WS_RSP);
    bf16_t* XB = (bf16_t*)(ws + WS_XB);

    volatile LAS unsigned* bst = (volatile LAS unsigned*)(lds + (LDS_BYTES - 64));
    if (tid < 2) bst[tid] = 0u;
    __syncthreads();
    grid.sync();
    XcdBarrier xbar = xcd_barrier_post((unsigned*)(p.ws + WS_RSS), bst);
#ifndef SKIP_PRO
    prologue(p, scr, gw, NGW, lane);
#endif
    GRID_SYNC();
    { EpiRoute E{(bf16_t*)(ws + WS_KMVM), nullptr, nullptr, 8192, 0, 0, 1 << 30, 1 << 30, nullptr, 0.f, 1.f};
      run_gemm(lds, (const bf16_t*)(ws + WS_MEMN), (const bf16_t*)(ws + WS_WMKV), 2048, 8192, 1024, E); }

    for (int L = 0; L < DEPTH; ++L) {
        { EpiRoute E{(bf16_t*)(ws + WS_Z), (bf16_t*)(ws + WS_XBCPRE), (bf16_t*)(ws + WS_SM), 1024, 2048, 768, 4, 12, RSS, 1.f / 1024.f, 1.f};
          run_gemm(lds, XB, (const bf16_t*)(ws + WS_WIN), M, NIN, 1024, E); }
#ifdef DUP_G1
        { EpiRoute E{(bf16_t*)(ws + WS_Z), (bf16_t*)(ws + WS_XBCPRE), (bf16_t*)(ws + WS_SM), 1024, 2048, 768, 4, 12, RSS, 1.f / 1024.f, 1.f};
          run_gemm(lds, XB, (const bf16_t*)(ws + WS_WIN), M, NIN, 1024, E); }
#endif
        GRID_SYNC();
#ifndef SKIP_L2
        pass_l2(p, L, gw, NGW, lane);
#ifdef DUP_PASS
        pass_l2(p, L, gw, NGW, lane);
#endif
#endif
        GRID_SYNC();
#if defined(DBG_STOP) && DBG_STOP == 1
        { for (size_t i = (size_t)blockIdx.x * 512 + threadIdx.x; i < (size_t)M * 1024; i += (size_t)G * 512) { const size_t mm = i >> 10; const int cc = (int)(i & 1023); p.out[i] = bf1(((const bf16_t*)(ws + WS_XBC))[mm * 2048 + cc]) + bf1(((const bf16_t*)(ws + WS_XBC))[mm * 2048 + 1024 + cc]) + bf1(((const bf16_t*)(ws + WS_CQN))[mm * 384 + cc % 384]) + bf1(((const bf16_t*)(ws + WS_CKVN))[mm * 256 + cc % 256]) + bf1(((const bf16_t*)(ws + WS_KPE))[mm * 32 + cc % 32]) + ((const float*)(ws + WS_DT))[mm * 16 + cc % 16] + bf1(((const bf16_t*)(ws + WS_Z))[mm * 1024 + cc]); } return; }
#endif

#ifndef SKIP_SSD
        if (G >= 256) {
            if (blockIdx.x < 128) { const int su = ((int)blockIdx.x & 7) * 16 + ((int)blockIdx.x >> 3); ssd_unit(p, L, lds, su >> 4, su & 15); }
            else {
                { EpiRope E{(bf16_t*)(ws + WS_YC), (bf16_t*)(ws + WS_SM), (const float*)(ws + WS_COS), (const float*)(ws + WS_SIN), 0.10206207261596575f * LOG2E};
                  run_gemm_on(lds, (const bf16_t*)(ws + WS_CQN), (const bf16_t*)(ws + WS_WUQ), M, 1536, 384, E, 128, (int)blockIdx.x - 128); }
                { EpiRoute E{(bf16_t*)(ws + WS_KN), (bf16_t*)(ws + WS_VB), nullptr, 1024, 1024, 0, 4, 1 << 30, nullptr, 0.f, 1.f};
                  run_gemm_on(lds, (const bf16_t*)(ws + WS_CKVN), (const bf16_t*)(ws + WS_WUKV), M, 2048, 256, E, 128, (int)blockIdx.x - 128); }
                convert_layer(p, -1, -1, -1, L, scr, gw - 1024, NGW - 1024, lane); } }
        else { for (int u = blockIdx.x; u < NB * 16; u += G) ssd_unit(p, L, lds, u >> 4, u & 15);
               { EpiRope E{(bf16_t*)(ws + WS_YC), (bf16_t*)(ws + WS_SM), (const float*)(ws + WS_COS), (const float*)(ws + WS_SIN), 0.10206207261596575f * LOG2E};
                 run_gemm(lds, (const bf16_t*)(ws + WS_CQN), (const bf16_t*)(ws + WS_WUQ), M, 1536, 384, E); }
               { EpiRoute E{(bf16_t*)(ws + WS_KN), (bf16_t*)(ws + WS_VB), nullptr, 1024, 1024, 0, 4, 1 << 30, nullptr, 0.f, 1.f};
                 run_gemm(lds, (const bf16_t*)(ws + WS_CKVN), (const bf16_t*)(ws + WS_WUKV), M, 2048, 256, E); }
               convert_layer(p, -1, -1, -1, L, scr, gw, NGW, lane); }
#ifdef DUP_SSD
        for (int u = blockIdx.x; u < NB * 16; u += G) ssd_unit(p, L, lds, u >> 4, u & 15);
#endif
#endif
        GRID_SYNC();
#if defined(DBG_STOP) && DBG_STOP == 2
        { for (size_t i = (size_t)blockIdx.x * 512 + threadIdx.x; i < (size_t)M * 1024; i += (size_t)G * 512) { const size_t mm = i >> 10; const int cc = (int)(i & 1023); p.out[i] = bf1(((const bf16_t*)(ws + WS_YC))[mm * 2048 + cc]); } return; }
#endif

#ifndef SKIP_MLA
#ifdef DUP_MLA
        for (int rep_ = 0; rep_ < 2; ++rep_)
#endif
        { const int v = vcu;
          for (int uu = v; uu < 256; uu += G) { const int bh = uu >> 1, half = uu & 1, b = bh >> 4, h = bh & 15;
            for (int i = 0; i < 4; ++i) { const int qb = half ? ((i == 0) ? 1 : (i == 1) ? 6 : (i == 2) ? 2 : 5) : ((i == 0) ? 0 : (i == 1) ? 7 : (i == 2) ? 3 : 4);
                const size_t r0 = (size_t)b * SEQ;
                attn_unit<96, 64, true, true>(lds, (const bf16_t*)(ws + WS_YC) + (r0 + 256 * qb) * 2048 + 1024 + 64 * h, 2048, (const bf16_t*)(ws + WS_SM) + (r0 + 256 * qb) * 512 + 32 * h, 512,
                                              (const bf16_t*)(ws + WS_KN) + r0 * 1024 + 64 * h, 1024,
                                              (const bf16_t*)(ws + WS_KPE) + r0 * 32, 32, (const bf16_t*)(ws + WS_VB) + r0 * 1024 + 64 * h, 1024,
                                              (bf16_t*)(ws + WS_YC) + (r0 + 256 * qb) * 2048 + 1024 + 64 * h, 2048, 256 * qb, 4 * (qb + 1)); } } }
#endif
        GRID_SYNC();
#if defined(DBG_STOP) && DBG_STOP == 3
        { for (size_t i = (size_t)blockIdx.x * 512 + threadIdx.x; i < (size_t)M * 1024; i += (size_t)G * 512) { const size_t mm = i >> 10; const int cc = (int)(i & 1023); p.out[i] = bf1(((const bf16_t*)(ws + WS_YC))[mm * 2048 + 1024 + cc]); } return; }
#endif

#ifndef SKIP_YCN
        pass_ycnorm(p, gw, NGW, lane);
#endif
        convert_layer(p, L + 1, L + 1, L, -1, scr, gw, NGW, lane);
        GRID_SYNC();
        { EpiRes E{L == 0 ? p.x : p.out, p.out, XB, RSS + (size_t)16 * M};
          run_gemm(lds, (const bf16_t*)(ws + WS_YC), (const bf16_t*)(ws + WS_WOUT), M, 1024, 2048, E); }
        GRID_SYNC();
#if defined(DBG_STOP) && DBG_STOP == 4
        return;
#endif

#if defined(DBG_STOP) && DBG_STOP == 9
        { for (size_t i = (size_t)blockIdx.x * 512 + threadIdx.x; i < (size_t)M * 1024; i += (size_t)G * 512) { const size_t mm = i >> 10; const int cc = (int)(i & 1023); p.out[i] = bf1(XB[mm * 1024 + cc]); } return; }
#endif

#if defined(DBG_STOP) && DBG_STOP == 10
        { for (size_t i = (size_t)blockIdx.x * 512 + threadIdx.x; i < (size_t)M * 1024; i += (size_t)G * 512) { const size_t mm = i >> 10; const int cc = (int)(i & 1023); p.out[i] = (RSS + (size_t)16 * M)[(size_t)(cc & 3) * M * 4 + mm * 4 + ((cc >> 2) & 3)]; } return; }
#endif

        { EpiRoute E{(bf16_t*)(ws + WS_QM), nullptr, nullptr, 1024, 0, 0, 1 << 30, 1 << 30, RSS + (size_t)16 * M, 1.f / 1024.f, 0.0625f * LOG2E};
          run_gemm(lds, XB, (const bf16_t*)(ws + WS_WMQ), M, 1024, 1024, E); }
#ifdef DUP_G6
        { EpiRoute E{(bf16_t*)(ws + WS_QM), nullptr, nullptr, 1024, 0, 0, 1 << 30, 1 << 30, RSS + (size_t)16 * M, 1.f / 1024.f, 0.0625f * LOG2E};
          run_gemm(lds, XB, (const bf16_t*)(ws + WS_WMQ), M, 1024, 1024, E); }
#endif
        GRID_SYNC();
#if defined(DBG_STOP) && DBG_STOP == 7
        { for (size_t i = (size_t)blockIdx.x * 512 + threadIdx.x; i < (size_t)M * 1024; i += (size_t)G * 512) { const size_t mm = i >> 10; const int cc = (int)(i & 1023); p.out[i] = bf1(((const bf16_t*)(ws + WS_QM))[mm * 1024 + cc]); } return; }
#endif

#ifndef SKIP_MEM
        for (int uu = vcu; uu < 512; uu += G) { const int dh = uu & 1, qb = (uu >> 1) & 7, mh = (uu >> 4) & 3, b = uu >> 6;
            const bf16_t* KM = (const bf16_t*)(ws + WS_KMVM) + (size_t)(b * 256) * 8192 + L * 2048 + 256 * mh;
            attn_unit<256, 128, false, false>(lds, (const bf16_t*)(ws + WS_QM) + ((size_t)b * SEQ + 256 * qb) * 1024 + 256 * mh, 1024, nullptr, 0, KM, 8192, nullptr, 0,
                                              KM + 1024 + 128 * dh, 8192, (bf16_t*)(ws + WS_OM) + ((size_t)b * SEQ + 256 * qb) * 1024 + 256 * mh + 128 * dh, 1024, 0, 4); }
#endif
        GRID_SYNC();
#if defined(DBG_STOP) && DBG_STOP == 8
        { for (size_t i = (size_t)blockIdx.x * 512 + threadIdx.x; i < (size_t)M * 1024; i += (size_t)G * 512) { const size_t mm = i >> 10; const int cc = (int)(i & 1023); p.out[i] = bf1(((const bf16_t*)(ws + WS_OM))[mm * 1024 + cc]); } return; }
#endif

        { EpiRes E{p.out, p.out, XB, RSS + (size_t)32 * M};
          run_gemm(lds, (const bf16_t*)(ws + WS_OM), (const bf16_t*)(ws + WS_WMO), M, 1024, 1024, E); }
        GRID_SYNC();
#if defined(DBG_STOP) && DBG_STOP == 5
        return;
#endif

        { EpiGlu E{(bf16_t*)(ws + WS_ACT), RSS + (size_t)32 * M, p.ffn_conv_w + (size_t)L * 3 * 5632, p.ffn_conv_b + (size_t)L * 5632, (float*)(ws + WS_HALO), (float*)(ws + WS_PART), (LAS float*)(lds + 131072)};
          run_gemm(lds, XB, (const bf16_t*)(ws + WS_WUP), M, 5632, 1024, E); }
#ifdef DUP_G8
        { EpiGlu E{(bf16_t*)(ws + WS_ACT), RSS + (size_t)32 * M, p.ffn_conv_w + (size_t)L * 3 * 5632, p.ffn_conv_b + (size_t)L * 5632, (float*)(ws + WS_HALO), (float*)(ws + WS_PART), (LAS float*)(lds + 131072)};
          run_gemm(lds, XB, (const bf16_t*)(ws + WS_WUP), M, 5632, 1024, E); }
#endif
        GRID_SYNC();
        {
          const int nM_ = M / 256, nN_ = 4, nwg_ = nM_ * nN_;
          for (int i_ = 0; (long)i_ * G + (int)blockIdx.x < nwg_; ++i_) { int wg_ = i_ * G + (int)blockIdx.x;
              { const int q_ = nwg_ / 8, r_ = nwg_ % 8, xcd_ = wg_ % 8, off_ = wg_ / 8; wg_ = (xcd_ < r_ ? xcd_ * (q_ + 1) : r_ * (q_ + 1) + (xcd_ - r_) * q_) + off_; }
              const int nig_ = 8 * nN_, gid_ = wg_ / nig_, fm_ = gid_ * 8, gsz_ = (nM_ - fm_) < 8 ? (nM_ - fm_) : 8;
              ffn_fixup(p, L, fm_ + ((wg_ % nig_) % gsz_)); }
          EpiRes E{p.out, p.out, XB, RSS};
          run_gemm(lds, (const bf16_t*)(ws + WS_ACT), (const bf16_t*)(ws + ((L & 1) ? WS_WDN1 : WS_WDN0)), M, 1024, 2816, E); }
        GRID_SYNC();
#if defined(DBG_STOP) && DBG_STOP == 6
        return;
#endif
    }
#ifndef SKIP_FIN
    pass_final(p, gw, NGW, lane);
#endif
}

extern "C" void kernel_launch(void* const* d_in, const int* in_sizes, int n_in, void* d_out, int out_size, void* d_ws, size_t ws_size, hipStream_t stream) {
    static int grid = 0;
    if (grid == 0) {
        if (n_in != 29 || out_size != M * DM || ws_size < WS_END) { fprintf(stderr, "kernel_launch: unexpected shapes (n_in %d out %d ws %zu need %zu)\n", n_in, out_size, ws_size, (size_t)WS_END); grid = -1; return; }
        int dev = 0, cus = 0, per_cu = 0;
        hipGetDevice(&dev);
        hipDeviceGetAttribute(&cus, hipDeviceAttributeMultiprocessorCount, dev);
        hipFuncSetAttribute((const void*)trunk_fwd, hipFuncAttributeMaxDynamicSharedMemorySize, LDS_BYTES);
        hipOccupancyMaxActiveBlocksPerMultiprocessor(&per_cu, (const void*)trunk_fwd, 512, LDS_BYTES);
        if (per_cu < 1) fprintf(stderr, "kernel_launch: occupancy query reports %d\n", per_cu);
        (void)hipGetLastError();
        grid = cus;
    }
    if (grid < 0) return;
    (void)hipMemsetAsync((char*)d_ws + WS_RSS, 0, 16384, stream);
    P a{};
    const void** pp = (const void**)&a;
    for (int i = 0; i < 29; ++i) pp[i] = d_in[i];
    a.out = (float*)d_out; a.ws = (unsigned char*)d_ws;
    void* args[] = {&a};
    hipError_t e = hipLaunchCooperativeKernel((const void*)trunk_fwd, dim3(grid), dim3(512), args, LDS_BYTES, stream);
    if (e != hipSuccess) fprintf(stderr, "cooperative launch failed: %s (grid %d)\n", hipGetErrorString(e), grid);
}
```

```cpp
#include <hip/hip_runtime.h>
#include <cstdio>
#include <cstdint>
namespace pg8 {
#define PG8_LAS __attribute__((address_space(3)))
typedef unsigned short bf16_t;
typedef short bf16x8 __attribute__((ext_vector_type(8)));
typedef float f32x4 __attribute__((ext_vector_type(4)));
typedef unsigned u32x4 __attribute__((ext_vector_type(4)));
constexpr int BM = 256, BK = 64, HALF = 128, HTB = HALF * BK * 2  , STAGE_BYTES = 8 * HTB, NXCD = 8, WGM = 8;

__host__ __device__ __forceinline__ int lds_byte(int r, int c) { const int st = (r >> 4) * 2 + (c >> 5), rr = r & 15, cc = c & 31, ob = rr * 64 + cc * 2; return st * 1024 + (ob ^ (((ob >> 9) & 1) << 5)); }
__host__ __device__ __forceinline__ void stage_rc(int b, int& R, int& C) { const int st = b / 1024, sb = b % 1024, swz = sb ^ (((sb >> 9) & 1) << 5); R = (st >> 1) * 16 + swz / 64; C = (st & 1) * 32 + (swz % 64) / 2; }
__host__ __device__ __forceinline__ int perm32(int rho) { const int n = rho >> 4, i = rho & 15; return 8 * (i >> 2) + 4 * n + (i & 3); }

struct Unit { int pm, pn; };
struct Gemm { const bf16_t* A; const bf16_t* Bt; int M, N, K; };

struct StaticOrder {
    int nM, nN, nwg, G, c;
    __host__ __device__ void init(int M, int N, int G_, int c_) { nM = M / BM; nN = N / BM; nwg = nM * nN; G = G_; c = c_; }
    __host__ __device__ bool next(int i, Unit& u) const {
        const long L = (long)i * G + c; if (L >= nwg) return false;
        int wgid = (int)L; { const int q = nwg / NXCD, r = nwg % NXCD, xcd = wgid % NXCD, off = wgid / NXCD; wgid = (xcd < r ? xcd * (q + 1) : r * (q + 1) + (xcd - r) * q) + off; }
        const int nig = WGM * nN, gid = wgid / nig, fm = gid * WGM, gsz = (nM - fm) < WGM ? (nM - fm) : WGM;
        u.pm = fm + ((wgid % nig) % gsz); u.pn = (wgid % nig) / gsz; return true;
    }
    __device__ __forceinline__ void a_ready(const Unit&) const {}
    __device__ __forceinline__ void done(const Unit&) const {}
};

__device__ __forceinline__ unsigned cvt_pk_bf16(float lo, float hi) { unsigned r; asm volatile("v_cvt_pk_bf16_f32 %0, %1, %2" : "=v"(r) : "v"(lo), "v"(hi)); return r; }
typedef float f32x2 __attribute__((ext_vector_type(2)));
__device__ __forceinline__ f32x2 gelu_pk(f32x2 v) {
    const f32x2 av = __builtin_elementwise_abs(v), d = av * 0.2316418882f + 1.0f;
    f32x2 t; t.x = __builtin_amdgcn_rcpf(d.x); t.y = __builtin_amdgcn_rcpf(d.y);
    f32x2 q = t * 0.5307027145f + (-0.7265760135f); q = q * t + 0.7107068705f; q = q * t + (-0.142248368f); q = q * t + 0.127414796f; q = q * t;
    const f32x2 s = (v * v) * (-0.72134752044f);
    f32x2 e; e.x = __builtin_amdgcn_exp2f(s.x); e.y = __builtin_amdgcn_exp2f(s.y);
    const f32x2 m = v * (q * e), r = v - m;
    f32x2 o; o.x = v.x < 0.f ? m.x : r.x; o.y = v.y < 0.f ? m.y : r.y; return o;
}

template <int ACT  > struct EpiBf16 {
    static constexpr bool PERM = true, AFTER_DRAIN = false; static_assert(ACT == 0 || ACT == 1, "EpiBf16: ACT is 0 (none) or 1 (gelu_pk)");
    bf16_t* O; int ldc; const float* bias; int split_cols; size_t split_stride; float scale0;
    __device__ __forceinline__ void operator()(const f32x4 (&acc)[2][2][4][2], const Unit& u, int wr, int wc, int fr, int fq) const {
        const int row0 = u.pm * BM + wr * 64 + fr; int colt = u.pn * BM; bf16_t* base = O;
        float sc = 1.f; if (split_cols) { const int t = colt / split_cols; base += (size_t)t * split_stride; colt -= t * split_cols; if (t == 0) sc = scale0; }
        const int col0 = colt + wc * 32 + 8 * fq, bcol0 = u.pn * BM + wc * 32 + 8 * fq;
        f32x4 bv[2][2];
#pragma unroll
        for (int bj = 0; bj < 2; ++bj)
#pragma unroll
            for (int n = 0; n < 2; ++n) bv[bj][n] = bias ? *(const f32x4*)(bias + bcol0 + bj * HALF + 4 * n) : (f32x4){0.f, 0.f, 0.f, 0.f};
#pragma unroll
        for (int ai = 0; ai < 2; ++ai)
#pragma unroll
            for (int m = 0; m < 4; ++m) { bf16_t* rowp = base + (size_t)(row0 + ai * HALF + m * 16) * ldc + col0;
#pragma unroll
                for (int bj = 0; bj < 2; ++bj) { f32x4 v0 = acc[ai][bj][m][0] + bv[bj][0], v1 = acc[ai][bj][m][1] + bv[bj][1];
                    if (ACT == 1) { f32x2 a = gelu_pk((f32x2){v0[0], v0[1]}), b = gelu_pk((f32x2){v0[2], v0[3]}), c = gelu_pk((f32x2){v1[0], v1[1]}), d = gelu_pk((f32x2){v1[2], v1[3]});
                        v0 = (f32x4){a.x, a.y, b.x, b.y}; v1 = (f32x4){c.x, c.y, d.x, d.y}; }
                    v0 = v0 * sc; v1 = v1 * sc; u32x4 w; w.x = cvt_pk_bf16(v0[0], v0[1]); w.y = cvt_pk_bf16(v0[2], v0[3]); w.z = cvt_pk_bf16(v1[0], v1[1]); w.w = cvt_pk_bf16(v1[2], v1[3]);
                    *(u32x4*)(rowp + bj * HALF) = w; } }
    }
};

struct PanelStats {
    unsigned* xbuf;
    unsigned* cnt;
    unsigned* tmo;
    int ntn; float eps;
    unsigned code;
    __device__ __forceinline__ bool run(const f32x4 (&v)[2][2][4][2], const Unit& u, int wr, int wc, int fr, int fq, PG8_LAS unsigned char* lds, int wid, int lane) const {
        typedef float f32x2v __attribute__((ext_vector_type(2)));
        PG8_LAS f32x2v* P = (PG8_LAS f32x2v*)lds;
        PG8_LAS f32x2v* S = (PG8_LAS f32x2v*)(lds + 8192);
        PG8_LAS unsigned* flag = (PG8_LAS unsigned*)(lds + 8192 + 2048);
#pragma unroll
        for (int ai = 0; ai < 2; ++ai)
#pragma unroll
            for (int m = 0; m < 4; ++m) {
                float s = 0.f;
#pragma unroll
                for (int bj = 0; bj < 2; ++bj)
#pragma unroll
                    for (int n = 0; n < 2; ++n) { const f32x4 x = v[ai][bj][m][n]; s += (x[0] + x[1]) + (x[2] + x[3]); }
                s += __shfl_xor(s, 16); s += __shfl_xor(s, 32);
                const float mw = s * (1.0f / 64.0f); float q = 0.f;
#pragma unroll
                for (int bj = 0; bj < 2; ++bj)
#pragma unroll
                    for (int n = 0; n < 2; ++n) { const f32x4 d = v[ai][bj][m][n] - mw; q += (d[0] * d[0] + d[1] * d[1]) + (d[2] * d[2] + d[3] * d[3]); }
                q += __shfl_xor(q, 16); q += __shfl_xor(q, 32);
                if (fq == 0) P[(ai * HALF + wr * 64 + m * 16 + fr) * 4 + wc] = (f32x2v){mw, q};
            }
        asm volatile("s_waitcnt lgkmcnt(0)" ::: "memory"); __builtin_amdgcn_s_barrier(); asm volatile("" ::: "memory");
#if defined(BROKEN_EXCHANGE_NO_WAIT)
#warning BROKEN CONTROL BUILD: the row-statistics exchange does not wait; results are wrong by design
        if (blockIdx.x >= 64) { const long long t0_ = clock64(); while (clock64() - t0_ < 60000) __builtin_amdgcn_s_sleep(8); }
#endif
        const int row = wid * 32 + (lane & 31);
        if (lane < 32) {
            const f32x2v a = P[row * 4 + 0], b = P[row * 4 + 1], c = P[row * 4 + 2], d = P[row * 4 + 3];
            const float mt = (a.x + b.x + c.x + d.x) * 0.25f;
            const float da = a.x - mt, db = b.x - mt, dc = c.x - mt, dd = d.x - mt;
            const float m2 = (a.y + b.y) + (c.y + d.y) + 64.0f * ((da * da + db * db) + (dc * dc + dd * dd));
            unsigned long long* slot = (unsigned long long*)xbuf + ((size_t)(u.pm * BM + row) * 4 + u.pn);
            __hip_atomic_store(slot, ((unsigned long long)__float_as_uint(m2) << 32) | __float_as_uint(mt), __ATOMIC_RELAXED, __HIP_MEMORY_SCOPE_AGENT);
        }
        asm volatile("s_waitcnt vmcnt(0)" ::: "memory");
        if (lane == 0) __hip_atomic_fetch_add(cnt + 64 * u.pm, 1u, __ATOMIC_RELAXED, __HIP_MEMORY_SCOPE_AGENT);
        if (wid == 0) {
            bool dead = false; const unsigned long long t0 = __builtin_amdgcn_s_memrealtime(); const unsigned want = 8u * (unsigned)ntn;
            for (;;) {
#if defined(BROKEN_EXCHANGE_NO_WAIT)
                break;
#endif
                if ((unsigned)__builtin_amdgcn_readfirstlane(__hip_atomic_load(cnt + 64 * u.pm, __ATOMIC_RELAXED, __HIP_MEMORY_SCOPE_AGENT)) >= want) break;
                if (__builtin_amdgcn_s_memrealtime() - t0 > 2000000ull) {
                    if (lane == 0) { unsigned expect = 0u; __hip_atomic_compare_exchange_strong(tmo + 1, &expect, code | (unsigned)(u.pm & 0xff), __ATOMIC_RELAXED, __ATOMIC_RELAXED, __HIP_MEMORY_SCOPE_AGENT);
                                     __hip_atomic_store(tmo, 1u, __ATOMIC_RELAXED, __HIP_MEMORY_SCOPE_AGENT); }
                    dead = true; break; }
                __builtin_amdgcn_s_sleep(2);
            }
            __builtin_amdgcn_fence(__ATOMIC_ACQUIRE, "agent");
            if (lane == 0) flag[0] = dead ? 1u : 0u;
        }
        asm volatile("s_waitcnt vmcnt(0) lgkmcnt(0)" ::: "memory"); __builtin_amdgcn_s_barrier(); asm volatile("" ::: "memory");
        const bool bad = flag[0] != 0u;
        if (lane < 32) {
            const unsigned long long* slot = (const unsigned long long*)xbuf + (size_t)(u.pm * BM + row) * 4; float mt[4], m2[4]; float ms = 0.f;
#pragma unroll
            for (int t = 0; t < 4; ++t) { if (t < ntn) { const unsigned long long w = __hip_atomic_load(slot + t, __ATOMIC_RELAXED, __HIP_MEMORY_SCOPE_AGENT); mt[t] = __uint_as_float((unsigned)w); m2[t] = __uint_as_float((unsigned)(w >> 32)); } else { mt[t] = 0.f; m2[t] = 0.f; } ms += mt[t]; }
            const float mean = ms / (float)ntn; float q = 0.f;
#pragma unroll
            for (int t = 0; t < 4; ++t) if (t < ntn) { const float dm = mt[t] - mean; q += m2[t] + 256.0f * dm * dm; }
            S[row] = (f32x2v){mean, 1.0f / sqrtf(q / (256.0f * (float)ntn) + eps)};
        }
        asm volatile("s_waitcnt lgkmcnt(0)" ::: "memory"); __builtin_amdgcn_s_barrier(); asm volatile("" ::: "memory");
        return bad;
    }
};
struct EpiLnRes {
    static constexpr bool PERM = false, AFTER_DRAIN = true;
    const float* base; float* out; int ldc; const float* bias; PanelStats st; unsigned poison;
    __device__ __forceinline__ void fused(f32x4 (&acc)[2][2][4][2], const Unit& u, int wr, int wc, int fr, int fq, PG8_LAS unsigned char* lds, int wid, int lane) const {
        typedef float f32x2v __attribute__((ext_vector_type(2)));
        const PG8_LAS f32x2v* S = (const PG8_LAS f32x2v*)(lds + 8192);
        const int col0 = u.pn * BM + wc * 32 + 4 * fq;
#pragma unroll
        for (int bj = 0; bj < 2; ++bj)
#pragma unroll
            for (int n = 0; n < 2; ++n) { const f32x4 bv = bias ? *(const f32x4*)(bias + col0 + bj * HALF + n * 16) : (f32x4){0.f, 0.f, 0.f, 0.f};
#pragma unroll
                for (int ai = 0; ai < 2; ++ai)
#pragma unroll
                    for (int m = 0; m < 4; ++m) acc[ai][bj][m][n] += bv; }
        f32x4 pre[4][2][2];
#pragma unroll
        for (int m = 0; m < 4; ++m) { const size_t off = (size_t)(u.pm * BM + wr * 64 + m * 16 + fr) * ldc + col0;
#pragma unroll
            for (int bj = 0; bj < 2; ++bj)
#pragma unroll
                for (int n = 0; n < 2; ++n) pre[m][bj][n] = *(const f32x4*)(base + off + bj * HALF + n * 16); }
        const bool bad = st.run(acc, u, wr, wc, fr, fq, lds, wid, lane) || poison != 0u;
        const float qnan = __builtin_nanf("");
#pragma unroll
        for (int ai = 0; ai < 2; ++ai)
#pragma unroll
            for (int m = 0; m < 4; ++m) { const int r = ai * HALF + wr * 64 + m * 16 + fr; const f32x2v sr = S[r]; const size_t off = (size_t)(u.pm * BM + r) * ldc + col0;
#pragma unroll
                for (int bj = 0; bj < 2; ++bj)
#pragma unroll
                    for (int n = 0; n < 2; ++n) { const f32x4 bs = ai == 0 ? pre[m][bj][n] : *(const f32x4*)(base + off + bj * HALF + n * 16); f32x4 o = bs + (acc[ai][bj][m][n] - sr.x) * sr.y;
                        if (bad) o = (f32x4){qnan, qnan, qnan, qnan}; *(f32x4*)(out + off + bj * HALF + n * 16) = o; }
                if (m & 1) asm volatile("" ::: "memory"); }
    }
};
struct EpiLnResLn {
    static constexpr bool PERM = false, AFTER_DRAIN = true;
    const float* base; float* out; bf16_t* xn; int ldc; const float* bias; PanelStats st1, st2; unsigned poison;
    __device__ __forceinline__ void fused(f32x4 (&acc)[2][2][4][2], const Unit& u, int wr, int wc, int fr, int fq, PG8_LAS unsigned char* lds, int wid, int lane) const {
        typedef float f32x2v __attribute__((ext_vector_type(2))); typedef unsigned u32x2v __attribute__((ext_vector_type(2)));
        const PG8_LAS f32x2v* S = (const PG8_LAS f32x2v*)(lds + 8192);
        const int col0 = u.pn * BM + wc * 32 + 4 * fq;
#pragma unroll
        for (int bj = 0; bj < 2; ++bj)
#pragma unroll
            for (int n = 0; n < 2; ++n) { const f32x4 bv = bias ? *(const f32x4*)(bias + col0 + bj * HALF + n * 16) : (f32x4){0.f, 0.f, 0.f, 0.f};
#pragma unroll
                for (int ai = 0; ai < 2; ++ai)
#pragma unroll
                    for (int m = 0; m < 4; ++m) acc[ai][bj][m][n] += bv; }
        bool bad = st1.run(acc, u, wr, wc, fr, fq, lds, wid, lane) || poison != 0u;
        const float qnan = __builtin_nanf("");
#pragma unroll
        for (int ai = 0; ai < 2; ++ai)
#pragma unroll
            for (int m = 0; m < 4; ++m) { const int r = ai * HALF + wr * 64 + m * 16 + fr; const f32x2v sr = S[r]; const size_t off = (size_t)(u.pm * BM + r) * ldc + col0;
#pragma unroll
                for (int bj = 0; bj < 2; ++bj)
#pragma unroll
                    for (int n = 0; n < 2; ++n) { const f32x4 bs = *(const f32x4*)(base + off + bj * HALF + n * 16); acc[ai][bj][m][n] = bs + (acc[ai][bj][m][n] - sr.x) * sr.y; }
                asm volatile("" : "+v"(acc[ai][0][m][0]), "+v"(acc[ai][0][m][1]), "+v"(acc[ai][1][m][0]), "+v"(acc[ai][1][m][1]));
                if (m & 1) asm volatile("" ::: "memory"); }
        const bool bad1 = bad;
        bad = st2.run(acc, u, wr, wc, fr, fq, lds, wid, lane) || bad;
#pragma unroll
        for (int ai = 0; ai < 2; ++ai)
#pragma unroll
            for (int m = 0; m < 4; ++m) { const int r = ai * HALF + wr * 64 + m * 16 + fr; const f32x2v sr = S[r]; const size_t off = (size_t)(u.pm * BM + r) * ldc + col0;
#pragma unroll
                for (int bj = 0; bj < 2; ++bj)
#pragma unroll
                    for (int n = 0; n < 2; ++n) { const f32x4 x1 = acc[ai][bj][m][n]; *(f32x4*)(out + off + bj * HALF + n * 16) = bad1 ? (f32x4){qnan, qnan, qnan, qnan} : x1;
                        const f32x4 o = (x1 - sr.x) * sr.y; u32x2v w; w.x = cvt_pk_bf16(o[0], o[1]); w.y = cvt_pk_bf16(o[2], o[3]);
                        if (bad) { w.x = 0x7fc07fc0u; w.y = 0x7fc07fc0u; } *(u32x2v*)(xn + off + bj * HALF + n * 16) = w; }
                asm volatile("" ::: "memory"); }
    }
};

template <class Epi, class Sched, bool ALIGN_EPI = false, bool SP2 = false>
__device__ __forceinline__ void gemm_phase(PG8_LAS unsigned char* lds, const Gemm g, const Sched& S, const Epi& E) {
    int tid_ = threadIdx.x; asm volatile("" : "+v"(tid_));
    const int tid = tid_, wid = __builtin_amdgcn_readfirstlane(tid >> 6), lane = tid & 63, wr = wid >> 2, wc = wid & 3, fr = lane & 15, fq = lane >> 4;
    const int K = g.K, nt = K / BK;
    unsigned voffA[2], voffB[2];
#pragma unroll
    for (int i = 0; i < 2; ++i) { int R, C; stage_rc(tid * 16 + i * 8192, R, C); const int Rb = Epi::PERM ? ((R & ~31) + perm32(R & 31)) : R;
        voffA[i] = (unsigned)(R * K + C) * 2u; voffB[i] = (unsigned)(Rb * K + C) * 2u; }
    const size_t kstep = (size_t)(BK * 2);
    const size_t hstep = (size_t)HALF * K * 2;
    const size_t tstep = 2 * hstep;
    const unsigned ldsw = (unsigned)wid * 1024u;
    const int aoff = lds_byte(wr * 64 + fr, fq * 8), boff = lds_byte(wc * 32 + fr, fq * 8);
#define PG8_SA(b, h) (((b) * 2 + (h)) * HTB)
#define PG8_SB(b, h) ((4 + (b) * 2 + (h)) * HTB)
#define PG8_STAGE(bufoff, gbase, voff) do { _Pragma("unroll") for (int _i = 0; _i < 2; ++_i) \
        __builtin_amdgcn_global_load_lds((const unsigned*)((const char*)(gbase) + (voff)[_i]), (PG8_LAS unsigned*)(lds + (bufoff) + ldsw + _i * 8192), 16, 0, 0); } while (0)
#define PG8_LDA(dst, b, h) do { _Pragma("unroll") for (int m = 0; m < 4; ++m) _Pragma("unroll") for (int k = 0; k < 2; ++k) dst[m][k] = *(const PG8_LAS bf16x8*)(lds + PG8_SA(b, h) + aoff + m * 2048 + k * 1024); } while (0)
#define PG8_LDB(dst, b, h) do { _Pragma("unroll") for (int n = 0; n < 2; ++n) _Pragma("unroll") for (int k = 0; k < 2; ++k) dst[n][k] = *(const PG8_LAS bf16x8*)(lds + PG8_SB(b, h) + boff + n * 2048 + k * 1024); } while (0)
#define PG8_MMA(ai, bj, At, Bt) do { __builtin_amdgcn_s_setprio(1); _Pragma("unroll") for (int m = 0; m < 4; ++m) _Pragma("unroll") for (int n = 0; n < 2; ++n) _Pragma("unroll") for (int k = 0; k < 2; ++k) \
        acc[ai][bj][m][n] = __builtin_amdgcn_mfma_f32_16x16x32_bf16(Bt[n][k], At[m][k], acc[ai][bj][m][n], 0, 0, 0); __builtin_amdgcn_s_setprio(0); } while (0)
#define PG8_WAIT_V(n) asm volatile("s_waitcnt vmcnt(" #n ")" ::: "memory")
#define PG8_WAIT_L(n) asm volatile("s_waitcnt lgkmcnt(" #n ")" ::: "memory")
#define PG8_BAR __builtin_amdgcn_s_barrier()
#define PG8_SCHED __builtin_amdgcn_sched_barrier(0)
    Unit cur, nxt; int ui = 0;
    if (!S.next(0, cur)) return;
    f32x4 acc[2][2][4][2];
#pragma unroll
    for (int a = 0; a < 2; ++a)
#pragma unroll
        for (int b = 0; b < 2; ++b)
#pragma unroll
            for (int m = 0; m < 4; ++m)
#pragma unroll
                for (int n = 0; n < 2; ++n) acc[a][b][m][n] = (f32x4){0.f, 0.f, 0.f, 0.f};
    bf16x8 At[4][2], B0[2][2], B1[2][2];
    const char* cA = (const char*)g.A + (size_t)cur.pm * tstep; const char* cB = (const char*)g.Bt + (size_t)cur.pn * tstep;
    S.a_ready(cur);
    if constexpr (SP2) {
        PG8_STAGE(PG8_SB(0, 0), cB, voffB); PG8_STAGE(PG8_SB(0, 1), cB + hstep, voffB); PG8_STAGE(PG8_SA(0, 0), cA, voffA); PG8_STAGE(PG8_SA(0, 1), cA + hstep, voffA);
        if (wr == 1) PG8_BAR;
        PG8_WAIT_V(2); PG8_BAR;
        PG8_STAGE(PG8_SB(1, 0), cB + kstep, voffB); PG8_STAGE(PG8_SA(1, 0), cA + kstep, voffA); PG8_STAGE(PG8_SB(1, 1), cB + hstep + kstep, voffB);
        PG8_WAIT_V(6); PG8_BAR;
    } else {
        PG8_STAGE(PG8_SB(0, 0), cB, voffB); PG8_STAGE(PG8_SA(0, 0), cA, voffA); PG8_STAGE(PG8_SB(0, 1), cB + hstep, voffB); PG8_STAGE(PG8_SA(0, 1), cA + hstep, voffA);
        if (wr == 1) PG8_BAR;
        PG8_WAIT_V(4); PG8_BAR;
        PG8_STAGE(PG8_SB(1, 0), cB + kstep, voffB); PG8_STAGE(PG8_SA(1, 0), cA + kstep, voffA); PG8_STAGE(PG8_SB(1, 1), cB + hstep + kstep, voffB);
        PG8_WAIT_V(6); PG8_BAR;
    }
    for (;;) {
        const bool has_next = S.next(ui + 1, nxt);
        const char* nA = has_next ? (const char*)g.A + (size_t)nxt.pm * tstep : cA; const char* nB = has_next ? (const char*)g.Bt + (size_t)nxt.pn * tstep : cB;
        for (int t = 0; t < nt; t += 2) {
            const bool last = (t == nt - 2);
            const char* a1 = cA + (size_t)(t + 1) * kstep;
            const char* a2 = last ? nA : cA + (size_t)(t + 2) * kstep; const char* b2 = last ? nB : cB + (size_t)(t + 2) * kstep;
            const char* a3 = a2 + kstep; const char* b3 = b2 + kstep;
            if (last && has_next) S.a_ready(nxt);
            if constexpr (SP2) {
            PG8_LDB(B0, 0, 0); PG8_LDB(B1, 0, 1); PG8_SCHED; PG8_LDA(At, 0, 0); PG8_STAGE(PG8_SA(1, 1), a1 + hstep, voffA);
            PG8_WAIT_V(8); PG8_WAIT_L(0); PG8_BAR; PG8_MMA(0, 0, At, B0); PG8_MMA(0, 1, At, B1); PG8_BAR; PG8_SCHED;
            PG8_LDA(At, 0, 1); PG8_STAGE(PG8_SB(0, 0), b2, voffB); PG8_STAGE(PG8_SB(0, 1), b2 + hstep, voffB); PG8_STAGE(PG8_SA(0, 0), a2, voffA);
            PG8_WAIT_V(8); PG8_WAIT_L(0); PG8_BAR; PG8_MMA(1, 0, At, B0); PG8_MMA(1, 1, At, B1); PG8_BAR; PG8_SCHED;
            PG8_LDB(B0, 1, 0); PG8_LDB(B1, 1, 1); PG8_SCHED; PG8_LDA(At, 1, 0); PG8_STAGE(PG8_SA(0, 1), a2 + hstep, voffA);
            PG8_WAIT_V(8); PG8_WAIT_L(0); PG8_BAR; PG8_MMA(0, 0, At, B0); PG8_MMA(0, 1, At, B1); PG8_BAR; PG8_SCHED;
            PG8_LDA(At, 1, 1); PG8_STAGE(PG8_SB(1, 0), b3, voffB); PG8_STAGE(PG8_SB(1, 1), b3 + hstep, voffB); PG8_STAGE(PG8_SA(1, 0), a3, voffA);
            PG8_WAIT_V(8); PG8_WAIT_L(0); PG8_BAR; PG8_MMA(1, 0, At, B0); PG8_MMA(1, 1, At, B1); PG8_BAR; PG8_SCHED;
            } else {
            PG8_LDB(B0, 0, 0); PG8_SCHED; PG8_LDA(At, 0, 0); PG8_STAGE(PG8_SA(1, 1), a1 + hstep, voffA);
            PG8_WAIT_L(8); PG8_BAR; PG8_WAIT_L(0); PG8_MMA(0, 0, At, B0); PG8_BAR; PG8_SCHED;
            PG8_LDB(B1, 0, 1); PG8_STAGE(PG8_SB(0, 0), b2, voffB);
            PG8_BAR; PG8_WAIT_L(0); PG8_MMA(0, 1, At, B1); PG8_BAR;
            PG8_LDA(At, 0, 1); PG8_STAGE(PG8_SA(0, 0), a2, voffA);
            PG8_BAR; PG8_WAIT_L(0); PG8_MMA(1, 0, At, B0); PG8_BAR; PG8_SCHED;
            PG8_STAGE(PG8_SB(0, 1), b2 + hstep, voffB);
            PG8_WAIT_V(6); PG8_BAR; PG8_MMA(1, 1, At, B1); PG8_BAR;
            PG8_LDB(B0, 1, 0); PG8_SCHED; PG8_LDA(At, 1, 0); PG8_STAGE(PG8_SA(0, 1), a2 + hstep, voffA);
            PG8_WAIT_L(8); PG8_BAR; PG8_WAIT_L(0); PG8_MMA(0, 0, At, B0); PG8_BAR; PG8_SCHED;
            PG8_LDB(B1, 1, 1); PG8_STAGE(PG8_SB(1, 0), b3, voffB);
            PG8_BAR; PG8_WAIT_L(0); PG8_MMA(0, 1, At, B1); PG8_BAR;
            PG8_LDA(At, 1, 1); PG8_STAGE(PG8_SA(1, 0), a3, voffA);
            PG8_BAR; PG8_WAIT_L(0); PG8_MMA(1, 0, At, B0); PG8_BAR; PG8_SCHED;
            PG8_STAGE(PG8_SB(1, 1), b3 + hstep, voffB);
            PG8_WAIT_V(6); PG8_BAR; PG8_MMA(1, 1, At, B1); PG8_BAR;
            }
        }
        if constexpr (ALIGN_EPI) { if (wr == 0) PG8_BAR; }
        if constexpr (!Epi::AFTER_DRAIN) { E(acc, cur, wr, wc, fr, fq); S.done(cur); }
        if (!has_next) break;
#pragma unroll
        for (int a = 0; a < 2; ++a)
#pragma unroll
            for (int b = 0; b < 2; ++b)
#pragma unroll
                for (int m = 0; m < 4; ++m)
#pragma unroll
                    for (int n = 0; n < 2; ++n) acc[a][b][m][n] = (f32x4){0.f, 0.f, 0.f, 0.f};
        cur = nxt; cA = nA; cB = nB; ++ui;
        if constexpr (ALIGN_EPI) { if (wr == 1) PG8_BAR; }
    }
    PG8_WAIT_V(0);
    if constexpr (!ALIGN_EPI) { if (wr == 0) PG8_BAR; }
    PG8_BAR;
    if constexpr (Epi::AFTER_DRAIN) { E.fused(acc, cur, wr, wc, fr, fq, lds, wid, lane); S.done(cur); }
#undef PG8_SA
#undef PG8_SB
#undef PG8_STAGE
#undef PG8_LDA
#undef PG8_LDB
#undef PG8_MMA
#undef PG8_WAIT_V
#undef PG8_WAIT_L
#undef PG8_BAR
#undef PG8_SCHED
}
}

#include <hip/hip_cooperative_groups.h>
namespace cg = cooperative_groups;
#define LAS __attribute__((address_space(3)))
typedef unsigned short bf16_t;
using pg8::f32x4; using pg8::bf16x8; using pg8::u32x4;
typedef float f32x2_t __attribute__((ext_vector_type(2))); typedef __bf16 bf16x2_t __attribute__((ext_vector_type(2)));
__device__ __forceinline__ unsigned cvt_pk_bf16(float lo, float hi) { f32x2_t v = {lo, hi}; bf16x2_t b = __builtin_convertvector(v, bf16x2_t); return __builtin_bit_cast(unsigned, b); }
typedef float f32x16 __attribute__((ext_vector_type(16)));
typedef short s16x4 __attribute__((ext_vector_type(4)));
typedef unsigned u32x2 __attribute__((ext_vector_type(2)));

constexpr int M = 16384, DM = 1024, SEQ = 2048, NB = 8, DEPTH = 4;
constexpr int NIN = 3840;
constexpr int DFF = 2816;
constexpr float EPS = 1e-6f;
constexpr float LOG2E = 1.4426950408889634f;
constexpr int LDS_BYTES = 147456;

struct P {
    const float *x, *mem; const int* pos;
    const float *norm_mix, *w_in, *ssm_conv_w, *ssm_conv_b, *dt_bias, *a_log, *d_skip, *ssm_norm, *q_norm, *w_uq, *kv_norm, *w_ukv, *attn_out_norm, *w_out,
                *norm_mem_q, *norm_mem_kv, *w_mq, *w_mk, *w_mv, *w_mo, *norm_ffn, *w_up, *ffn_conv_w, *ffn_conv_b, *w_down, *final_norm;
    float* out; unsigned char* ws;
};

constexpr size_t KiB = 1024, MiB = 1024 * 1024;
constexpr size_t WS_RSS = 0, WS_COS = 1 * MiB, WS_SIN = 2 * MiB, WS_DT = 3 * MiB, WS_KPE = 4 * MiB;
constexpr size_t WS_WIN = 6144 * KiB, WS_WUQ = 13824 * KiB, WS_WUKV = 14976 * KiB, WS_WOUT = 16000 * KiB, WS_WMQ = 20096 * KiB, WS_WMO = 22144 * KiB,
                 WS_WUP = 24192 * KiB, WS_WDN0 = 35456 * KiB, WS_WDN1 = 41088 * KiB;
constexpr size_t WS_WMKV = 46 * MiB, WS_KMVM = 62 * MiB, WS_MEMN = 94 * MiB, WS_XB = 98 * MiB, WS_VB = 98 * MiB;
constexpr size_t WS_Z = 130 * MiB, WS_QM = 130 * MiB, WS_U = 130 * MiB;
constexpr size_t WS_WUKV1 = 5 * MiB;
constexpr size_t WS_XBCPRE = 162 * MiB, WS_YC = 162 * MiB, WS_OM = 162 * MiB;
constexpr size_t WS_ACT = 218 * MiB;
constexpr size_t WS_SM = 226 * MiB, WS_XBC = 250 * MiB, WS_QB = 250 * MiB, WS_CQN = 314 * MiB, WS_CKVN = 326 * MiB, WS_RSP = 334 * MiB, WS_HALO = 337 * MiB, WS_PART = 340 * MiB, WS_KN = 343 * MiB, WS_END = 375 * MiB;

__device__ __forceinline__ float bflo(unsigned w) { return __uint_as_float(w << 16); }
__device__ __forceinline__ float bfhi(unsigned w) { return __uint_as_float(w & 0xffff0000u); }
__device__ __forceinline__ float bf1(bf16_t h) { return __uint_as_float((unsigned)h << 16); }
__device__ __forceinline__ bf16_t tobf(float f) { return (bf16_t)(cvt_pk_bf16(f, 0.f) & 0xffffu); }
__device__ __forceinline__ float wave_sum(float v) {
#pragma unroll
    for (int o = 1; o < 64; o <<= 1) v += __shfl_xor(v, o);
    return v;
}
__device__ __forceinline__ float silu_f(float v) { return v * __builtin_amdgcn_rcpf(1.f + __expf(-v)); }
__device__ __forceinline__ int crow(int r, int hi) { return (r & 3) + 8 * (r >> 2) + 4 * hi; }
#define LDS_WAIT() asm volatile("s_waitcnt lgkmcnt(0)" ::: "memory")
__device__ __forceinline__ int fresh_tid() { int t = threadIdx.x; asm volatile("" : "+v"(t)); return t; }
__device__ __forceinline__ float rss16(const float* rsp, int row) { const f32x4 a = *(const f32x4*)(rsp + (size_t)row * 4), b = *(const f32x4*)(rsp + (size_t)M * 4 + (size_t)row * 4), c = *(const f32x4*)(rsp + (size_t)M * 8 + (size_t)row * 4), d = *(const f32x4*)(rsp + (size_t)M * 12 + (size_t)row * 4);
    return (((a[0] + a[1]) + (a[2] + a[3])) + ((b[0] + b[1]) + (b[2] + b[3]))) + (((c[0] + c[1]) + (c[2] + c[3])) + ((d[0] + d[1]) + (d[2] + d[3]))); }

struct EpiRoute {
    static constexpr bool PERM = true, AFTER_DRAIN = false;
    bf16_t *b0, *b1, *b2; int ld0, ld1, ld2, t1, t2; const float* rss; float invk, mul;
    __device__ __forceinline__ void operator()(const f32x4 (&acc)[2][2][4][2], const pg8::Unit& u, int wr_, int wc_, int fr_, int fq_) const {
        const int t_ = fresh_tid(), wid_ = __builtin_amdgcn_readfirstlane(t_ >> 6), wr = wid_ >> 2, wc = wid_ & 3, fr = t_ & 15, fq = (t_ >> 4) & 3;
        bf16_t* base; int ld, colt;
        if (u.pn < t1) { base = b0; ld = ld0; colt = u.pn * 256; } else if (u.pn < t2) { base = b1; ld = ld1; colt = (u.pn - t1) * 256; } else { base = b2; ld = ld2; colt = (u.pn - t2) * 256; }
        const int col0 = colt + wc * 32 + 8 * fq;
#pragma unroll
        for (int ai = 0; ai < 2; ++ai)
#pragma unroll
            for (int m = 0; m < 4; ++m) {
                const int row = u.pm * 256 + ai * 128 + wr * 64 + m * 16 + fr;
                float s = mul; if (rss) s *= rsqrtf(rss16(rss, row) * invk + EPS);
                bf16_t* rowp = base + (size_t)row * ld + col0;
#pragma unroll
                for (int bj = 0; bj < 2; ++bj) { const f32x4 v0 = acc[ai][bj][m][0] * s, v1 = acc[ai][bj][m][1] * s;
                    u32x4 w; w.x = cvt_pk_bf16(v0[0], v0[1]); w.y = cvt_pk_bf16(v0[2], v0[3]); w.z = cvt_pk_bf16(v1[0], v1[1]); w.w = cvt_pk_bf16(v1[2], v1[3]);
                    *(u32x4*)(rowp + bj * 128) = w; }
                asm volatile("" ::: "memory");
            }
    }
};
struct EpiRope {
    static constexpr bool PERM = false, AFTER_DRAIN = false;
    bf16_t* YCq; bf16_t* QPE; const float* cs; const float* sn; float mul;
    __device__ __forceinline__ void operator()(const f32x4 (&acc)[2][2][4][2], const pg8::Unit& u, int wr_, int wc_, int fr_, int fq_) const {
        const int t_ = fresh_tid(), wid_ = __builtin_amdgcn_readfirstlane(t_ >> 6), wr = wid_ >> 2, wc = wid_ & 3, fr = t_ & 15, fq = (t_ >> 4) & 3;
#pragma unroll
        for (int ai = 0; ai < 2; ++ai)
#pragma unroll
            for (int m = 0; m < 4; ++m) {
                const int row = u.pm * 256 + ai * 128 + wr * 64 + m * 16 + fr;
                const f32x4 c = *(const f32x4*)(cs + (size_t)row * 16 + 4 * fq), s = *(const f32x4*)(sn + (size_t)row * 16 + 4 * fq);
#pragma unroll
                for (int bj = 0; bj < 2; ++bj) { const int gb = u.pn * 256 + bj * 128 + wc * 32; const int head = gb / 96, within = gb - head * 96; const bool rope = within == 64;
                    f32x4 a = acc[ai][bj][m][0], b = acc[ai][bj][m][1];
                    if (rope) { const f32x4 a2 = a * c - b * s, b2 = b * c + a * s; a = a2; b = b2; }
                    a = a * mul; b = b * mul;
                    bf16_t* dst = rope ? (QPE + (size_t)row * 512 + 32 * head + 4 * fq) : (YCq + (size_t)row * 2048 + 1024 + 64 * head + within + 4 * fq);
                    u32x2 w0, w1; w0.x = cvt_pk_bf16(a[0], a[1]); w0.y = cvt_pk_bf16(a[2], a[3]); w1.x = cvt_pk_bf16(b[0], b[1]); w1.y = cvt_pk_bf16(b[2], b[3]);
                    *(u32x2*)dst = w0; *(u32x2*)(dst + 16) = w1; }
                asm volatile("" ::: "memory");
            }
    }
};
struct EpiRes {
    static constexpr bool PERM = false, AFTER_DRAIN = false;
    const float* xin; float* xout; bf16_t* xb; float* rss;
    __device__ __forceinline__ void operator()(const f32x4 (&acc)[2][2][4][2], const pg8::Unit& u, int wr_, int wc_, int fr_, int fq_) const {
        const int t_ = fresh_tid(), wid_ = __builtin_amdgcn_readfirstlane(t_ >> 6), wr = wid_ >> 2, wc = wid_ & 3, fr = t_ & 15, fq = (t_ >> 4) & 3;
#pragma unroll
        for (int ai = 0; ai < 2; ++ai)
#pragma unroll
            for (int m = 0; m < 4; ++m) {
                const int row = u.pm * 256 + ai * 128 + wr * 64 + m * 16 + fr; float ss = 0.f;
#pragma unroll
                for (int bj = 0; bj < 2; ++bj)
#pragma unroll
                    for (int n = 0; n < 2; ++n) { const size_t off = (size_t)row * 1024 + u.pn * 256 + bj * 128 + wc * 32 + 16 * n + 4 * fq;
                        const f32x4 v = *(const f32x4*)(xin + off) + acc[ai][bj][m][n];
                        *(f32x4*)(xout + off) = v; u32x2 w; w.x = cvt_pk_bf16(v[0], v[1]); w.y = cvt_pk_bf16(v[2], v[3]); *(u32x2*)(xb + off) = w;
                        ss += (v[0] * v[0] + v[1] * v[1]) + (v[2] * v[2] + v[3] * v[3]); }
                ss += __shfl_xor(ss, 16); ss += __shfl_xor(ss, 32);
                if (fq == 0) rss[(size_t)u.pn * M * 4 + (size_t)row * 4 + wc] = ss;
                asm volatile("" ::: "memory");
            }
    }
};


template <int CTRL> __device__ __forceinline__ float dpp_mov(float old, float src) {
    return __builtin_bit_cast(float, __builtin_amdgcn_update_dpp(__builtin_bit_cast(int, old), __builtin_bit_cast(int, src), CTRL, 0xf, 0xf, false)); }
struct EpiGlu {
    static constexpr bool PERM = true, AFTER_DRAIN = false;
    bf16_t* ACT; const float* rss; const float* cw; const float* cb; float* HALO; float* PART; LAS float* H;
    __device__ __forceinline__ void operator()(const f32x4 (&acc)[2][2][4][2], const pg8::Unit& u, int wr_, int wc_, int fr_, int fq_) const {
        typedef float f32x2v __attribute__((ext_vector_type(2)));
        typedef __attribute__((address_space(1))) f32x4 gf4; typedef __attribute__((address_space(1))) f32x2v gf2; typedef __attribute__((address_space(1))) u32x2 gu2;
        const int t_ = fresh_tid(), wid_ = __builtin_amdgcn_readfirstlane(t_ >> 6), wr = wid_ >> 2, wc = wid_ & 3, fr = t_ & 15, fq = (t_ >> 4) & 3;
        const int pm = u.pm, pn = u.pn;
        LAS float* RS = H + 2048; LAS float* WT = H + 2304;
        if (t_ < 256) { RS[t_] = rsqrtf(rss16(rss, pm * 256 + t_) * (1.f / 1024.f) + EPS);
            const unsigned gcol = (unsigned)((t_ >> 7) * 2816 + 128 * pn + (t_ & 127));
            WT[t_] = cw[gcol]; WT[256 + t_] = cw[5632u + gcol]; WT[512 + t_] = cw[11264u + gcol]; WT[768 + t_] = cb[gcol]; }
        asm volatile("s_waitcnt lgkmcnt(0)" ::: "memory"); __builtin_amdgcn_s_barrier(); asm volatile("" ::: "memory");
        const LAS float* RSl = RS + wr * 64 + fr;
        const int lc = wc * 32 + 8 * fq;
        if (fr >= 14) {
#pragma unroll
            for (int ai = 0; ai < 2; ++ai)
#pragma unroll
                for (int bj = 0; bj < 2; ++bj)
#pragma unroll
                    for (int n = 0; n < 2; ++n) { const f32x4 v = acc[ai][bj][3][n] * RSl[ai * 128 + 48];
                        *(LAS f32x4*)(H + ((ai * 2 + wr) * 2 + (fr - 14)) * 256 + bj * 128 + lc + 4 * n) = v;
                        if (ai == 1 && wr == 1) *(gf4*)(HALO + (unsigned)((pm * 2 + (fr - 14)) * 5632 + bj * 2816 + 128 * pn + lc + 4 * n)) = v; }
        }
        asm volatile("s_waitcnt lgkmcnt(0)" ::: "memory"); __builtin_amdgcn_s_barrier(); asm volatile("" ::: "memory");
#pragma unroll
        for (int n = 0; n < 2; ++n)
#pragma unroll
            for (int ai = 0; ai < 2; ++ai) {
                const int src = ai * 2 + wr - 1;
                unsigned res0[4];
#pragma unroll
                for (int jp = 0; jp < 2; ++jp) {
                    const int lcc = lc + 4 * n + 2 * jp;
                    const f32x2v w0g = *(const LAS f32x2v*)(WT + lcc), w1g = *(const LAS f32x2v*)(WT + 256 + lcc), w2g = *(const LAS f32x2v*)(WT + 512 + lcc), bg = *(const LAS f32x2v*)(WT + 768 + lcc);
                    const f32x2v w0v = *(const LAS f32x2v*)(WT + 128 + lcc), w1v = *(const LAS f32x2v*)(WT + 384 + lcc), w2v = *(const LAS f32x2v*)(WT + 640 + lcc), bv = *(const LAS f32x2v*)(WT + 896 + lcc);
                    f32x2v pg = (f32x2v){0.f, 0.f}, pv = (f32x2v){0.f, 0.f};
                    if (src >= 0) { const LAS float* hp = H + (src * 2 + (fr & 1)) * 256 + lcc; pg = *(const LAS f32x2v*)hp; pv = *(const LAS f32x2v*)(hp + 128); }
                    const unsigned gc = (unsigned)(128 * pn + lcc);
#pragma unroll
                    for (int m = 0; m < 4; ++m) {
                        const float sm_ = RSl[ai * 128 + m * 16];
                        const f32x2v cg = (f32x2v){acc[ai][0][m][n][2 * jp] * sm_, acc[ai][0][m][n][2 * jp + 1] * sm_}, cv = (f32x2v){acc[ai][1][m][n][2 * jp] * sm_, acc[ai][1][m][n][2 * jp + 1] * sm_};
                        f32x2v og, ov;
#pragma unroll
                        for (int j = 0; j < 2; ++j) {
                            const float g1 = dpp_mov<0x111>(dpp_mov<0x121>(pg[j], pg[j]), cg[j]), g2 = dpp_mov<0x112>(dpp_mov<0x122>(pg[j], pg[j]), cg[j]);
                            const float v1 = dpp_mov<0x111>(dpp_mov<0x121>(pv[j], pv[j]), cv[j]), v2 = dpp_mov<0x112>(dpp_mov<0x122>(pv[j], pv[j]), cv[j]);
                            og[j] = bg[j] + w2g[j] * cg[j] + w1g[j] * g1 + w0g[j] * g2;
                            ov[j] = bv[j] + w2v[j] * cv[j] + w1v[j] * v1 + w0v[j] * v2; }
                        pg = cg; pv = cv;
                        const int row = pm * 256 + ai * 128 + wr * 64 + m * 16 + fr;
                        const bool partial = (ai == 0) && (m == 0) && (wr == 0) && (fr < 2) && ((pm & 7) != 0);
                        if (partial) { *(gf2*)(PART + ((unsigned)(((pm * 2 + fr) * 2 + 0) * 2816) + gc)) = og; *(gf2*)(PART + ((unsigned)(((pm * 2 + fr) * 2 + 1) * 2816) + gc)) = ov; }
                        const unsigned pk = cvt_pk_bf16(silu_f(og[0]) * ov[0], silu_f(og[1]) * ov[1]);
                        if (jp == 0) res0[m] = pk;
                        else if (!partial) { u32x2 o; o.x = res0[m]; o.y = pk; *(gu2*)(ACT + ((unsigned)(row * DFF) + gc - 2u)) = o; }
                    }
                    asm volatile("" ::: "memory");
                }
            }
    }
};
__device__ __forceinline__ void ffn_fixup(const P& p, int L, int pm) {
    if ((pm & 7) == 0) return;
    unsigned char* ws = p.ws; asm volatile("" : "+s"(ws));
    const float* HALO = (const float*)(ws + WS_HALO); const float* PART = (const float*)(ws + WS_PART); bf16_t* ACT = (bf16_t*)(ws + WS_ACT);
    const float* cw = p.ffn_conv_w + (size_t)L * 3 * 5632;
    const int tid = fresh_tid();
    for (int idx = tid; idx < 2 * DFF; idx += 512) { const int r = idx / DFF, c = idx - r * DFF;
        float g = PART[(((size_t)pm * 2 + r) * 2 + 0) * 2816 + c], v = PART[(((size_t)pm * 2 + r) * 2 + 1) * 2816 + c];
        const float hg0 = HALO[((size_t)(pm - 1) * 2 + 0) * 5632 + c], hg1 = HALO[((size_t)(pm - 1) * 2 + 1) * 5632 + c];
        const float hv0 = HALO[((size_t)(pm - 1) * 2 + 0) * 5632 + 2816 + c], hv1 = HALO[((size_t)(pm - 1) * 2 + 1) * 5632 + 2816 + c];
        if (r == 0) { g += cw[5632 + c] * hg1 + cw[c] * hg0; v += cw[5632 + 2816 + c] * hv1 + cw[2816 + c] * hv0; }
        else { g += cw[c] * hg1; v += cw[2816 + c] * hv1; }
        ACT[((size_t)pm * 256 + r) * DFF + c] = tobf(silu_f(g) * v); }
    asm volatile("s_waitcnt vmcnt(0)" ::: "memory");
    __syncthreads();
}

template <class Epi>
__device__ __forceinline__ void run_gemm_on(LAS unsigned char* lds, const bf16_t* A, const bf16_t* Bt, int m, int n, int k, const Epi& E, int G_, int c_) {
    pg8::Gemm g{A, Bt, m, n, k}; pg8::StaticOrder S; S.init(m, n, G_, c_);
    pg8::gemm_phase<Epi, pg8::StaticOrder, true, true>(lds, g, S, E);
}
template <class Epi>
__device__ __forceinline__ void run_gemm(LAS unsigned char* lds, const bf16_t* A, const bf16_t* Bt, int m, int n, int k, const Epi& E) {
    pg8::Gemm g{A, Bt, m, n, k}; pg8::StaticOrder S; S.init(m, n, (int)gridDim.x, (int)blockIdx.x);
    pg8::gemm_phase<Epi, pg8::StaticOrder, true, true>(lds, g, S, E);
}

template <class SrcCol, class Gain>
__device__ __forceinline__ void tr_item(const float* W, int K, int Nsrc, bf16_t* WT, int nblk, LAS float* scr, int item, int lane, SrcCol srccol, Gain gain) {
    const int kb = item / nblk, nb = item % nblk, k0 = 64 * kb, n0 = 32 * nb;
    const int sc = srccol(n0 + (lane & 31));
#pragma unroll
    for (int i = 0; i < 32; ++i) { const int kk = 2 * i + (lane >> 5);
        float v = 0.f; if (sc >= 0) v = W[(size_t)(k0 + kk) * Nsrc + sc] * gain(k0 + kk);
        scr[kk * 33 + (lane & 31)] = v; }
    LDS_WAIT(); asm volatile("" ::: "memory");
    const int c = lane & 7;
#pragma unroll
    for (int j = 0; j < 4; ++j) { const int n = (lane >> 3) + 8 * j; const LAS float* s = scr + (8 * c) * 33 + n;
        u32x4 o; o.x = cvt_pk_bf16(s[0 * 33], s[1 * 33]); o.y = cvt_pk_bf16(s[2 * 33], s[3 * 33]); o.z = cvt_pk_bf16(s[4 * 33], s[5 * 33]); o.w = cvt_pk_bf16(s[6 * 33], s[7 * 33]);
        *(u32x4*)(WT + (size_t)(n0 + n) * K + k0 + 8 * c) = o; }
    LDS_WAIT(); asm volatile("" ::: "memory");
}

__device__ __forceinline__ void convert_layer(const P& p, int Lw, int Lq, int Lu, int L, LAS float* scr, int gw, int NGW, int lane_unused) {
    const int lane = fresh_tid() & 63;
    unsigned char* ws = p.ws; asm volatile("" : "+s"(ws));
    constexpr int I_IN = 16 * 120, I_UQ = 6 * 48, I_UKV = 4 * 64, I_OUT = 32 * 32, I_MQ = 16 * 32, I_MO = 16 * 32, I_UP = 16 * 176, I_DN = 44 * 32;
    constexpr int NIT = I_IN + I_UQ + I_UKV + I_OUT + I_MQ + I_MO + I_UP + I_DN;
    for (int it = gw; it < NIT; it += NGW) {
        int r = it;
        if (r < I_IN) { if (Lw < 0 || Lw >= DEPTH) continue; const float* g = p.norm_mix + Lw * 1024;
            tr_item(p.w_in + (size_t)Lw * 1024 * 3760, 1024, 3760, (bf16_t*)(ws + WS_WIN), 120, scr, r, lane,
                    [](int n) { return n < 3072 ? n : (n < 3744 ? n + 16 : (n < 3760 ? n - 672 : -1)); }, [g](int k) { return g[k]; }); continue; } r -= I_IN;
        if (r < I_UQ) { if (Lq < 0 || Lq >= DEPTH) continue; const float* g = p.q_norm + Lq * 384;
            tr_item(p.w_uq + (size_t)Lq * 384 * 1536, 384, 1536, (bf16_t*)(ws + WS_WUQ), 48, scr, r, lane, [](int n) { return n; }, [g](int k) { return g[k]; }); continue; } r -= I_UQ;
        if (r < I_UKV) { if (Lq < 0 || Lq >= DEPTH) continue; const float* g = p.kv_norm + Lq * 256;
            tr_item(p.w_ukv + (size_t)Lq * 256 * 2048, 256, 2048, (bf16_t*)(ws + WS_WUKV), 64, scr, r, lane,
                    [](int n) { return n < 1024 ? 128 * (n >> 6) + (n & 63) : 128 * ((n - 1024) >> 6) + 64 + (n & 63); }, [g](int k) { return g[k]; }); continue; } r -= I_UKV;
        if (r < I_OUT) { if (L < 0) continue; const float* g1 = p.ssm_norm + L * 1024; const float* g2 = p.attn_out_norm + L * 1024;
            tr_item(p.w_out + (size_t)L * 2048 * 1024, 2048, 1024, (bf16_t*)(ws + WS_WOUT), 32, scr, r, lane, [](int n) { return n; }, [g1, g2](int k) { return k < 1024 ? g1[k] : g2[k - 1024]; }); continue; } r -= I_OUT;
        if (r < I_MQ) { if (L < 0) continue; const float* g = p.norm_mem_q + L * 1024;
            tr_item(p.w_mq + (size_t)L * 1024 * 1024, 1024, 1024, (bf16_t*)(ws + WS_WMQ), 32, scr, r, lane, [](int n) { return n; }, [g](int k) { return g[k]; }); continue; } r -= I_MQ;
        if (r < I_MO) { if (L < 0) continue;
            tr_item(p.w_mo + (size_t)L * 1024 * 1024, 1024, 1024, (bf16_t*)(ws + WS_WMO), 32, scr, r, lane, [](int n) { return n; }, [](int) { return 1.f; }); continue; } r -= I_MO;
        if (r < I_UP) { if (Lu < 0 || Lu >= DEPTH) continue; const float* g = p.norm_ffn + Lu * 1024;
            tr_item(p.w_up + (size_t)Lu * 1024 * 5632, 1024, 5632, (bf16_t*)(ws + WS_WUP), 176, scr, r, lane, [](int n) { return (n & 128) ? 2816 + 128 * (n >> 8) + (n & 127) : 128 * (n >> 8) + (n & 127); }, [g](int k) { return g[k]; }); continue; } r -= I_UP;
        if (L < 0) continue;
        tr_item(p.w_down + (size_t)L * 2816 * 1024, 2816, 1024, (bf16_t*)(ws + ((L & 1) ? WS_WDN1 : WS_WDN0)), 32, scr, r, lane, [](int n) { return n; }, [](int) { return 1.f; });
    }
}

__device__ __forceinline__ void prologue(const P& p, LAS float* scr, int gw, int NGW, int lane_unused) {
    const int lane = fresh_tid() & 63;
    unsigned char* ws = p.ws; asm volatile("" : "+s"(ws));
    float* rss = (float*)(ws + WS_RSP);
    bf16_t* XB = (bf16_t*)(ws + WS_XB);
    for (int m = gw; m < M; m += NGW) {
        const f32x4* xr = (const f32x4*)(p.x + (size_t)m * 1024) + lane; float ss = 0.f;
#pragma unroll
        for (int j = 0; j < 4; ++j) { const f32x4 v = xr[64 * j]; ss += (v[0] * v[0] + v[1] * v[1]) + (v[2] * v[2] + v[3] * v[3]);
            u32x2 w; w.x = cvt_pk_bf16(v[0], v[1]); w.y = cvt_pk_bf16(v[2], v[3]); *((u32x2*)(XB + (size_t)m * 1024) + lane + 64 * j) = w; }
        ss = wave_sum(ss); if (lane < 16) rss[(size_t)(lane >> 2) * M * 4 + (size_t)m * 4 + (lane & 3)] = (lane == 0) ? ss : 0.f;
    }
    bf16_t* MEMN = (bf16_t*)(ws + WS_MEMN);
    for (int m = gw; m < 2048; m += NGW) {
        const f32x4* xr = (const f32x4*)(p.mem + (size_t)m * 1024) + lane; f32x4 v[4]; float ss = 0.f;
#pragma unroll
        for (int j = 0; j < 4; ++j) { v[j] = xr[64 * j]; ss += (v[j][0] * v[j][0] + v[j][1] * v[j][1]) + (v[j][2] * v[j][2] + v[j][3] * v[j][3]); }
        const float rs = rsqrtf(wave_sum(ss) * (1.f / 1024.f) + EPS);
#pragma unroll
        for (int j = 0; j < 4; ++j) { u32x2 w; w.x = cvt_pk_bf16(v[j][0] * rs, v[j][1] * rs); w.y = cvt_pk_bf16(v[j][2] * rs, v[j][3] * rs); *((u32x2*)(MEMN + (size_t)m * 1024) + lane + 64 * j) = w; }
    }
    float* COS = (float*)(ws + WS_COS); float* SIN = (float*)(ws + WS_SIN);
    for (int i = gw * 64 + lane; i < M * 16; i += NGW * 64) { const int m = i >> 4, k = i & 15;
        const float inv = powf(10000.f, -(float)(2 * k) / 32.f); const float ang = (float)p.pos[m] * inv;
        COS[i] = cosf(ang); SIN[i] = sinf(ang); }
    for (int it = gw; it < 4 * 2 * 512; it += NGW) { const int L = it >> 10, kv = (it >> 9) & 1, r = it & 511; const float* g = p.norm_mem_kv + L * 1024;
        tr_item((kv ? p.w_mv : p.w_mk) + (size_t)L * 1024 * 1024, 1024, 1024, (bf16_t*)(ws + WS_WMKV) + (size_t)(L * 2048 + kv * 1024) * 1024, 32, scr, r, lane, [](int n) { return n; }, [g](int k) { return g[k]; }); }
    convert_layer(p, 0, 0, -1, -1, scr, gw, NGW, lane);
}

__device__ __forceinline__ void pass_l2(const P& p, int L, int gw, int NGW, int lane_unused) {
    const int lane = fresh_tid() & 63;
    unsigned char* ws = p.ws; asm volatile("" : "+s"(ws));
    const bf16_t* XP = (const bf16_t*)(ws + WS_XBCPRE); bf16_t* XO = (bf16_t*)(ws + WS_XBC); const bf16_t* SM = (const bf16_t*)(ws + WS_SM);
    bf16_t* CQN = (bf16_t*)(ws + WS_CQN); bf16_t* CKVN = (bf16_t*)(ws + WS_CKVN); bf16_t* KPE = (bf16_t*)(ws + WS_KPE); float* DT = (float*)(ws + WS_DT);
    const float* COS = (const float*)(ws + WS_COS); const float* SIN = (const float*)(ws + WS_SIN);
    const float* cw = p.ssm_conv_w + (size_t)L * 4 * 2048; const float* cb = p.ssm_conv_b + (size_t)L * 2048;
    for (int blk = gw; blk < M / 8; blk += NGW) {
        const int m0 = blk * 8, t0 = m0 & (SEQ - 1);
#pragma unroll 2
        for (int j = 0; j < 4; ++j) {
            const int c = lane * 8 + 512 * j;
            const f32x4 b0 = *(const f32x4*)(cb + c), b1 = *(const f32x4*)(cb + c + 4);
            f32x4 w0[4], w1[4];
#pragma unroll
            for (int k = 0; k < 4; ++k) { w0[k] = *(const f32x4*)(cw + k * 2048 + c); w1[k] = *(const f32x4*)(cw + k * 2048 + c + 4); }
            u32x4 xr[11];
#pragma unroll
            for (int i = 0; i < 11; ++i) { if (t0 - 3 + i >= 0) xr[i] = *(const u32x4*)(XP + (size_t)(m0 - 3 + i) * 2048 + c); else xr[i] = (u32x4){0u, 0u, 0u, 0u}; }
#pragma unroll
            for (int r = 0; r < 8; ++r) {
                f32x4 a0 = b0, a1 = b1;
#pragma unroll
                for (int k = 0; k < 4; ++k) { const u32x4 v = xr[r + k];
                    a0[0] += w0[k][0] * bflo(v.x); a0[1] += w0[k][1] * bfhi(v.x); a0[2] += w0[k][2] * bflo(v.y); a0[3] += w0[k][3] * bfhi(v.y);
                    a1[0] += w1[k][0] * bflo(v.z); a1[1] += w1[k][1] * bfhi(v.z); a1[2] += w1[k][2] * bflo(v.w); a1[3] += w1[k][3] * bfhi(v.w); }
                u32x4 o; o.x = cvt_pk_bf16(silu_f(a0[0]), silu_f(a0[1])); o.y = cvt_pk_bf16(silu_f(a0[2]), silu_f(a0[3]));
                o.z = cvt_pk_bf16(silu_f(a1[0]), silu_f(a1[1])); o.w = cvt_pk_bf16(silu_f(a1[2]), silu_f(a1[3]));
                *(u32x4*)(XO + (size_t)(m0 + r) * 2048 + c) = o;
            }
        }
    }
    for (int m = gw; m < M; m += NGW) {
        const unsigned* sm = (const unsigned*)(SM + (size_t)m * 768);
        {
            unsigned w[3]; float ss = 0.f;
#pragma unroll
            for (int i = 0; i < 3; ++i) { w[i] = sm[lane + 64 * i]; const float a = bflo(w[i]), b = bfhi(w[i]); ss += a * a + b * b; }
            const float rs = rsqrtf(wave_sum(ss) * (1.f / 384.f) + EPS);
#pragma unroll
            for (int i = 0; i < 3; ++i) ((unsigned*)(CQN + (size_t)m * 384))[lane + 64 * i] = cvt_pk_bf16(bflo(w[i]) * rs, bfhi(w[i]) * rs);
        }
        {
            unsigned w[2]; float ss = 0.f;
#pragma unroll
            for (int i = 0; i < 2; ++i) { w[i] = sm[192 + lane + 64 * i]; const float a = bflo(w[i]), b = bfhi(w[i]); ss += a * a + b * b; }
            const float rs = rsqrtf(wave_sum(ss) * (1.f / 256.f) + EPS);
#pragma unroll
            for (int i = 0; i < 2; ++i) ((unsigned*)(CKVN + (size_t)m * 256))[lane + 64 * i] = cvt_pk_bf16(bflo(w[i]) * rs, bfhi(w[i]) * rs);
        }
        {
            const bf16_t* sr = SM + (size_t)m * 768;
            const float v = bf1(sr[640 + (lane & 31)]); const float pr = __shfl_xor(v, 16); const int i = lane & 15;
            const float c = COS[(size_t)m * 16 + i], s = SIN[(size_t)m * 16 + i];
            const float o = (lane & 16) ? (v * c + pr * s) : (v * c - pr * s);
            if (lane < 32) KPE[(size_t)m * 32 + lane] = tobf(o);
            const float d = bf1(sr[672 + (lane & 15)]) + p.dt_bias[L * 16 + (lane & 15)];
            const float sp = fmaxf(d, 0.f) + __logf(1.f + __expf(-fabsf(d)));
            if (lane < 16) DT[(size_t)m * 16 + lane] = sp;
        }
    }
}

__device__ __forceinline__ void pass_ycnorm(const P& p, int gw, int NGW, int lane_unused) {
    const int lane = fresh_tid() & 63;
    unsigned char* ws = p.ws; asm volatile("" : "+s"(ws));
    bf16_t* YC = (bf16_t*)(ws + WS_YC);
    for (int m0 = gw; m0 < M; m0 += 2 * NGW) {
        u32x4 v[2][4];
#pragma unroll
        for (int q = 0; q < 2; ++q) { const int m = m0 + q * NGW; if (m < M) {
#pragma unroll
            for (int j = 0; j < 4; ++j) v[q][j] = ((const u32x4*)(YC + (size_t)m * 2048))[lane + 64 * j]; } }
#pragma unroll
        for (int q = 0; q < 2; ++q) { const int m = m0 + q * NGW; if (m < M) {
            u32x4* row = (u32x4*)(YC + (size_t)m * 2048); float s[2] = {0.f, 0.f};
#pragma unroll
            for (int j = 0; j < 4; ++j) { const u32x4 w = v[q][j]; float a = 0.f;
                a += bflo(w.x) * bflo(w.x) + bfhi(w.x) * bfhi(w.x); a += bflo(w.y) * bflo(w.y) + bfhi(w.y) * bfhi(w.y);
                a += bflo(w.z) * bflo(w.z) + bfhi(w.z) * bfhi(w.z); a += bflo(w.w) * bflo(w.w) + bfhi(w.w) * bfhi(w.w);
                s[j >> 1] += a; }
            const float r0 = rsqrtf(wave_sum(s[0]) * (1.f / 1024.f) + EPS), r1 = rsqrtf(wave_sum(s[1]) * (1.f / 1024.f) + EPS);
#pragma unroll
            for (int j = 0; j < 4; ++j) { const float r = (j < 2) ? r0 : r1; const u32x4 w = v[q][j]; u32x4 o;
                o.x = cvt_pk_bf16(bflo(w.x) * r, bfhi(w.x) * r); o.y = cvt_pk_bf16(bflo(w.y) * r, bfhi(w.y) * r);
                o.z = cvt_pk_bf16(bflo(w.z) * r, bfhi(w.z) * r); o.w = cvt_pk_bf16(bflo(w.w) * r, bfhi(w.w) * r);
                row[lane + 64 * j] = o; } } }
    }
}

__device__ __forceinline__ void pass_ffnact(const P& p, int L, int half, int gw, int NGW, int lane_unused) {
    const int lane = fresh_tid() & 63;
    unsigned char* ws = p.ws; asm volatile("" : "+s"(ws));
    const bf16_t* U = (const bf16_t*)(ws + WS_U); bf16_t* ACT = (bf16_t*)(ws + WS_ACT) + (size_t)half * 8192 * DFF;
    const float* cw = p.ffn_conv_w + (size_t)L * 3 * 5632; const float* cb = p.ffn_conv_b + (size_t)L * 5632;
    for (int blk = gw; blk < 8192 / 4; blk += NGW) {
        const int m0 = blk * 4, t0 = m0 & (SEQ - 1);
        for (int ch = lane; ch < DFF / 8; ch += 64) {
            const int c = ch * 8;
            const f32x4 bg0 = *(const f32x4*)(cb + c), bg1 = *(const f32x4*)(cb + c + 4), bv0 = *(const f32x4*)(cb + DFF + c), bv1 = *(const f32x4*)(cb + DFF + c + 4);
            f32x4 wg0[3], wg1[3], wv0[3], wv1[3];
#pragma unroll
            for (int k = 0; k < 3; ++k) { const float* wk = cw + k * 5632; wg0[k] = *(const f32x4*)(wk + c); wg1[k] = *(const f32x4*)(wk + c + 4); wv0[k] = *(const f32x4*)(wk + DFF + c); wv1[k] = *(const f32x4*)(wk + DFF + c + 4); }
            u32x4 ug[6], uv[6];
#pragma unroll
            for (int i = 0; i < 6; ++i) { if (t0 - 2 + i >= 0) { const bf16_t* ur = U + (size_t)(m0 - 2 + i) * 5632; ug[i] = *(const u32x4*)(ur + c); uv[i] = *(const u32x4*)(ur + DFF + c); }
                else { ug[i] = (u32x4){0u, 0u, 0u, 0u}; uv[i] = (u32x4){0u, 0u, 0u, 0u}; } }
#pragma unroll
            for (int r = 0; r < 4; ++r) {
                f32x4 g0 = bg0, g1 = bg1, v0 = bv0, v1 = bv1;
#pragma unroll
                for (int k = 0; k < 3; ++k) { const u32x4 a = ug[r + k], b = uv[r + k];
                    g0[0] += wg0[k][0] * bflo(a.x); g0[1] += wg0[k][1] * bfhi(a.x); g0[2] += wg0[k][2] * bflo(a.y); g0[3] += wg0[k][3] * bfhi(a.y);
                    g1[0] += wg1[k][0] * bflo(a.z); g1[1] += wg1[k][1] * bfhi(a.z); g1[2] += wg1[k][2] * bflo(a.w); g1[3] += wg1[k][3] * bfhi(a.w);
                    v0[0] += wv0[k][0] * bflo(b.x); v0[1] += wv0[k][1] * bfhi(b.x); v0[2] += wv0[k][2] * bflo(b.y); v0[3] += wv0[k][3] * bfhi(b.y);
                    v1[0] += wv1[k][0] * bflo(b.z); v1[1] += wv1[k][1] * bfhi(b.z); v1[2] += wv1[k][2] * bflo(b.w); v1[3] += wv1[k][3] * bfhi(b.w); }
                u32x4 o; o.x = cvt_pk_bf16(silu_f(g0[0]) * v0[0], silu_f(g0[1]) * v0[1]); o.y = cvt_pk_bf16(silu_f(g0[2]) * v0[2], silu_f(g0[3]) * v0[3]);
                o.z = cvt_pk_bf16(silu_f(g1[0]) * v1[0], silu_f(g1[1]) * v1[1]); o.w = cvt_pk_bf16(silu_f(g1[2]) * v1[2], silu_f(g1[3]) * v1[3]);
                *(u32x4*)(ACT + (size_t)(m0 + r) * DFF + c) = o;
            }
        }
    }
}

__device__ __forceinline__ void pass_final(const P& p, int gw, int NGW, int lane_unused) {
    const int lane = fresh_tid() & 63;
    const float* rss = (const float*)(p.ws + WS_RSP);
    for (int m = gw; m < M; m += NGW) {
        const float rs = rsqrtf(rss16(rss, m) * (1.f / 1024.f) + EPS);
        f32x4* xr = (f32x4*)(p.out + (size_t)m * 1024) + lane; const f32x4* g = (const f32x4*)p.final_norm + lane;
#pragma unroll
        for (int j = 0; j < 4; ++j) { f32x4 v = xr[64 * j]; v = v * rs * g[64 * j]; xr[64 * j] = v; }
    }
}

typedef short v4i16_t __attribute__((ext_vector_type(4)));
__device__ __forceinline__ s16x4 vtr(const LAS unsigned char* p) { return __builtin_bit_cast(s16x4, __builtin_amdgcn_ds_read_tr16_b64_v4i16((LAS v4i16_t*)p)); }
__device__ __forceinline__ bf16x8 join8(s16x4 lo, s16x4 hi) { return (bf16x8){lo[0], lo[1], lo[2], lo[3], hi[0], hi[1], hi[2], hi[3]}; }
__device__ __forceinline__ bf16x8 pack8(const f32x16& s, int b) {
    u32x4 w; w.x = cvt_pk_bf16(s[b], s[b + 1]); w.y = cvt_pk_bf16(s[b + 2], s[b + 3]); w.z = cvt_pk_bf16(s[b + 4], s[b + 5]); w.w = cvt_pk_bf16(s[b + 6], s[b + 7]);
    return __builtin_bit_cast(bf16x8, w);
}

template <int DQK, int DV, bool CAUSAL, bool K2>
__device__ __forceinline__ void attn_unit(LAS unsigned char* lds, const bf16_t* Q, int qpitch, const bf16_t* Qp2, int q2pitch, const bf16_t* K, int kpitch, const bf16_t* Kp2, int k2pitch,
                                          const bf16_t* V, int vpitch, bf16_t* O, int opitch, int q0, int NT) {
    constexpr int KP = (DQK + 8) * 2, VP = (DV == 64) ? 192 : 320;
    constexpr int KBUF = 64 * KP, VBUF = 64 * VP, BUF = KBUF + VBUF;
    constexpr int KCH = DQK / 8, VCH = DV / 8, NKC = 64 * KCH, NVC = 64 * VCH;
    constexpr int NKR = (NKC + 511) / 512, NVR = NVC / 512;
    const int tid = fresh_tid(), lane = tid & 63, w = __builtin_amdgcn_readfirstlane(tid >> 6), ql = lane & 31, hi = lane >> 5;
    u32x4 kreg[NKR], vreg[NVR];
    auto gload = [&](int t) {
#pragma unroll
        for (int i = 0; i < NKR; ++i) { const int id = tid + 512 * i;
            if (id < NKC) { const int row = id / KCH, c = id % KCH; const size_t kv = (size_t)(64 * t + row);
                if (K2 && c >= (DQK - 32) / 8) kreg[i] = *(const u32x4*)(Kp2 + kv * k2pitch + (c - (DQK - 32) / 8) * 8);
                else kreg[i] = *(const u32x4*)(K + kv * kpitch + c * 8); } }
#pragma unroll
        for (int i = 0; i < NVR; ++i) { const int id = tid + 512 * i; const int row = id / VCH, c = id % VCH;
            vreg[i] = *(const u32x4*)(V + (size_t)(64 * t + row) * vpitch + c * 8); }
    };
    auto lstore = [&](int b) {
        LAS unsigned char* kb = lds + b * BUF; LAS unsigned char* vb = kb + KBUF;
#pragma unroll
        for (int i = 0; i < NKR; ++i) { const int id = tid + 512 * i; if (id < NKC) { const int row = id / KCH, c = id % KCH; *(LAS u32x4*)(kb + row * KP + c * 16) = kreg[i]; } }
#pragma unroll
        for (int i = 0; i < NVR; ++i) { const int id = tid + 512 * i; const int row = id / VCH, c = id % VCH; *(LAS u32x4*)(vb + row * VP + c * 16) = vreg[i]; }
    };
    gload(0);
    bf16x8 qf[DQK / 16];
#pragma unroll
    for (int d0 = 0; d0 < DQK / 16; ++d0) {
        if (K2 && d0 >= (DQK - 32) / 16) qf[d0] = *(const bf16x8*)(Qp2 + (size_t)(32 * w + ql) * q2pitch + 16 * (d0 - (DQK - 32) / 16) + 8 * hi);
        else qf[d0] = *(const bf16x8*)(Q + (size_t)(32 * w + ql) * qpitch + 16 * d0 + 8 * hi); }
    f32x16 oacc[DV / 32];
#pragma unroll
    for (int i = 0; i < DV / 32; ++i)
#pragma unroll
        for (int r = 0; r < 16; ++r) oacc[i][r] = 0.f;
    float m_run = -INFINITY, l_run = 0.f;
    const int q0w = q0 + 32 * w, qg = q0w + ql;
    lstore(0);
    __syncthreads();
    const int vtoff = (4 * hi + ((lane & 15) >> 2)) * VP + (16 * ((lane >> 4) & 1) + 4 * (lane & 3)) * 2;
    for (int t = 0; t < NT; ++t) {
        if (t + 1 < NT) gload(t + 1);
        const bool active = !CAUSAL || (64 * t <= q0w + 31);
        if (active) {
            const LAS unsigned char* kb = lds + (t & 1) * BUF; const LAS unsigned char* vb = kb + KBUF;
            f32x16 s0, s1;
#pragma unroll
            for (int r = 0; r < 16; ++r) { s0[r] = 0.f; s1[r] = 0.f; }
#pragma unroll
            for (int d0 = 0; d0 < DQK / 16; ++d0) {
                const bf16x8 a0 = *(const LAS bf16x8*)(kb + ql * KP + (16 * d0 + 8 * hi) * 2);
                const bf16x8 a1 = *(const LAS bf16x8*)(kb + (32 + ql) * KP + (16 * d0 + 8 * hi) * 2);
                s0 = __builtin_amdgcn_mfma_f32_32x32x16_bf16(a0, qf[d0], s0, 0, 0, 0);
                s1 = __builtin_amdgcn_mfma_f32_32x32x16_bf16(a1, qf[d0], s1, 0, 0, 0);
            }
            if (CAUSAL && (64 * t + 63 > q0w)) {
#pragma unroll
                for (int r = 0; r < 16; ++r) { const int kv = 64 * t + crow(r, hi); if (kv > qg) s0[r] = -INFINITY; if (kv + 32 > qg) s1[r] = -INFINITY; }
            }
            float mx = s0[0];
#pragma unroll
            for (int r = 1; r < 16; ++r) mx = fmaxf(mx, s0[r]);
#pragma unroll
            for (int r = 0; r < 16; ++r) mx = fmaxf(mx, s1[r]);
            mx = fmaxf(mx, __shfl_xor(mx, 32));
            const float m_new = fmaxf(m_run, mx);
            const float alpha = __builtin_amdgcn_exp2f(m_run - m_new);
            m_run = m_new;
            float ps = 0.f;
#pragma unroll
            for (int r = 0; r < 16; ++r) { s0[r] = __builtin_amdgcn_exp2f(s0[r] - m_new); s1[r] = __builtin_amdgcn_exp2f(s1[r] - m_new); ps += s0[r] + s1[r]; }
            l_run = l_run * alpha + ps;
            if (__any(alpha != 1.f)) {
#pragma unroll
                for (int i = 0; i < DV / 32; ++i)
#pragma unroll
                    for (int r = 0; r < 16; ++r) oacc[i][r] *= alpha;
            }
            const bf16x8 p00 = pack8(s0, 0), p01 = pack8(s0, 8), p10 = pack8(s1, 0), p11 = pack8(s1, 8);
#pragma unroll
            for (int i = 0; i < DV / 32; ++i) {
                const LAS unsigned char* vp = vb + vtoff + i * 64;
                { const bf16x8 a = join8(vtr(vp + (0) * VP), vtr(vp + (8) * VP)); oacc[i] = __builtin_amdgcn_mfma_f32_32x32x16_bf16(a, p00, oacc[i], 0, 0, 0); }
                { const bf16x8 a = join8(vtr(vp + (16) * VP), vtr(vp + (24) * VP)); oacc[i] = __builtin_amdgcn_mfma_f32_32x32x16_bf16(a, p01, oacc[i], 0, 0, 0); }
                { const bf16x8 a = join8(vtr(vp + (32) * VP), vtr(vp + (40) * VP)); oacc[i] = __builtin_amdgcn_mfma_f32_32x32x16_bf16(a, p10, oacc[i], 0, 0, 0); }
                { const bf16x8 a = join8(vtr(vp + (48) * VP), vtr(vp + (56) * VP)); oacc[i] = __builtin_amdgcn_mfma_f32_32x32x16_bf16(a, p11, oacc[i], 0, 0, 0); }
            }
        }
        if (t + 1 < NT) lstore((t + 1) & 1);
        __syncthreads();
    }
    const float lt = l_run + __shfl_xor(l_run, 32); const float inv = 1.f / lt;
    bf16_t* orow = O + (size_t)(32 * w + ql) * opitch;
#pragma unroll
    for (int i = 0; i < DV / 32; ++i)
#pragma unroll
        for (int rr = 0; rr < 4; ++rr) { u32x2 o; o.x = cvt_pk_bf16(oacc[i][4 * rr] * inv, oacc[i][4 * rr + 1] * inv); o.y = cvt_pk_bf16(oacc[i][4 * rr + 2] * inv, oacc[i][4 * rr + 3] * inv);
            *(u32x2*)(orow + 32 * i + 8 * rr + 4 * hi) = o; }
}

constexpr int SS_BP = 272, SS_XP = 144;
constexpr int SS_B = 0, SS_C = 34816, SS_XD = 69632  , SS_XDD = 88064  , SS_ZI = 106496  , SS_SB = 124928, SS_CS = 142336, SS_DT = 142848;
constexpr int SS_ECS = SS_DT + 512, SS_CSD = SS_DT + 1024;
static_assert(SS_CSD + 512 <= LDS_BYTES - 64, "SSD LDS map");
#define LDS_BARRIER() do { asm volatile("s_waitcnt lgkmcnt(0)" ::: "memory"); __builtin_amdgcn_s_barrier(); asm volatile("" ::: "memory"); } while (0)
__device__ __forceinline__ void ssd_unit(const P& p, int L, LAS unsigned char* lds, int b, int h) {
    unsigned char* ws = p.ws; asm volatile("" : "+s"(ws));
    const bf16_t* XBC = (const bf16_t*)(ws + WS_XBC); const bf16_t* Z = (const bf16_t*)(ws + WS_Z); const float* DT = (const float*)(ws + WS_DT); bf16_t* YC = (bf16_t*)(ws + WS_YC);
    const int tid = fresh_tid(), lane = tid & 63, w = __builtin_amdgcn_readfirstlane(tid >> 6), ql = lane & 31, hi = lane >> 5;
    const int g = h >> 2;
    const float Ah = -__expf(p.a_log[L * 16 + h]); const float dsk = p.d_skip[L * 16 + h];
    const int lb = (w < 4) ? w : (7 - w), pb = (w >> 1) & 1;
    LAS float* CS = (LAS float*)(lds + SS_CS); LAS float* DTS = (LAS float*)(lds + SS_DT);
    f32x16 sacc;
#pragma unroll
    for (int r = 0; r < 16; ++r) sacc[r] = 0.f;
    for (int i = tid; i < 64 * SS_BP / 4; i += 512) ((LAS unsigned*)(lds + SS_SB))[i] = 0u;
    u32x4 breg[4], creg[4], xreg[2], zreg[2]; float dreg[2] = {0.f, 0.f};
    auto gload = [&](int c) {
        const size_t m0 = (size_t)b * SEQ + (size_t)c * 128;
#pragma unroll
        for (int i = 0; i < 4; ++i) { const int id = tid + 512 * i, row = id >> 4, c16 = id & 15;
            breg[i] = *(const u32x4*)(XBC + (m0 + row) * 2048 + 1024 + g * 128 + 8 * c16);
            creg[i] = *(const u32x4*)(XBC + (m0 + row) * 2048 + 1536 + g * 128 + 8 * c16); }
#pragma unroll
        for (int i = 0; i < 2; ++i) { const int id = tid + 512 * i, row = id >> 3, c8 = id & 7; xreg[i] = *(const u32x4*)(XBC + (m0 + row) * 2048 + h * 64 + 8 * c8); zreg[i] = *(const u32x4*)(Z + (m0 + row) * 1024 + h * 64 + 8 * c8); }
        if (w == 0) { dreg[0] = DT[(m0 + 2 * lane) * 16 + h]; dreg[1] = DT[(m0 + 2 * lane + 1) * 16 + h]; }
    };
    gload(0);
    const int troff = (((lane & 15) >> 2)) ;
    const int tcol = 16 * ((lane >> 4) & 1) + 4 * (lane & 3);
    for (int c = 0; c < 16; ++c) {
        const size_t m0 = (size_t)b * SEQ + (size_t)c * 128;
        if (w == 0) {
            const float v0 = dreg[0] * Ah, v1 = dreg[1] * Ah; float s = v0 + v1;
#pragma unroll
            for (int o = 1; o < 64; o <<= 1) { const float t = __shfl_up(s, o); if (lane >= o) s += t; }
            CS[2 * lane] = s - v1; CS[2 * lane + 1] = s; DTS[2 * lane] = dreg[0]; DTS[2 * lane + 1] = dreg[1];
            { LAS float* ECS = (LAS float*)(lds + SS_ECS); LAS float* CSD = (LAS float*)(lds + SS_CSD);
              ECS[2 * lane] = __expf(s - v1); ECS[2 * lane + 1] = __expf(s); CSD[2 * lane] = (s - v1) - __logf(dreg[0]); CSD[2 * lane + 1] = s - __logf(dreg[1]); }
        }
#pragma unroll
        for (int i = 0; i < 4; ++i) { const int id = tid + 512 * i, row = id >> 4, c16 = id & 15;
            *(LAS u32x4*)(lds + SS_B + row * SS_BP + c16 * 16) = breg[i]; *(LAS u32x4*)(lds + SS_C + row * SS_BP + c16 * 16) = creg[i]; }
        LDS_BARRIER();
        { const float cend = CS[127];
#pragma unroll
          for (int i = 0; i < 2; ++i) { const int id = tid + 512 * i, row = id >> 3, c8 = id & 7; const float e = DTS[row] * __expf(cend - CS[row]);
              const u32x4 v = xreg[i]; u32x4 o2;
              o2.x = cvt_pk_bf16(bflo(v.x) * e, bfhi(v.x) * e); o2.y = cvt_pk_bf16(bflo(v.y) * e, bfhi(v.y) * e); o2.z = cvt_pk_bf16(bflo(v.z) * e, bfhi(v.z) * e); o2.w = cvt_pk_bf16(bflo(v.w) * e, bfhi(v.w) * e);
              *(LAS u32x4*)(lds + SS_XD + row * SS_XP + c8 * 16) = v; *(LAS u32x4*)(lds + SS_XDD + row * SS_XP + c8 * 16) = o2; *(LAS u32x4*)(lds + SS_ZI + row * SS_XP + c8 * 16) = zreg[i]; } }
        LDS_BARRIER();
        if (c + 1 < 16) gload(c + 1);
        f32x16 yacc, oac;
#pragma unroll
        for (int r = 0; r < 16; ++r) { yacc[r] = 0.f; oac[r] = 0.f; }
        const float cs_l = CS[32 * lb + ql];
        bf16x8 cfr[8];
#pragma unroll
        for (int ks = 0; ks < 8; ++ks) cfr[ks] = *(const LAS bf16x8*)(lds + SS_C + (32 * lb + ql) * SS_BP + (16 * ks + 8 * hi) * 2);
        for (int sb = 0; sb <= lb; ++sb) {
            f32x16 gt;
#pragma unroll
            for (int r = 0; r < 16; ++r) gt[r] = 0.f;
#pragma unroll
            for (int hf = 0; hf < 2; ++hf) {
                bf16x8 fa[4];
#pragma unroll
                for (int k = 0; k < 4; ++k) fa[k] = *(const LAS bf16x8*)(lds + SS_B + (32 * sb + ql) * SS_BP + (16 * (4 * hf + k) + 8 * hi) * 2);
                __builtin_amdgcn_sched_barrier(0);
#pragma unroll
                for (int k = 0; k < 4; ++k) gt = __builtin_amdgcn_mfma_f32_32x32x16_bf16(fa[k], cfr[4 * hf + k], gt, 0, 0, 0);
                __builtin_amdgcn_sched_barrier(0);
            }
            const int lg = 32 * lb + ql;
#pragma unroll
            for (int r = 0; r < 16; ++r) { const int s = 32 * sb + crow(r, hi); const float e = __expf(cs_l - ((const LAS float*)(lds + SS_CSD))[s]); gt[r] = (s <= lg) ? gt[r] * e : 0.f; }
            const bf16x8 w0 = pack8(gt, 0), w1 = pack8(gt, 8);
            const LAS unsigned char* xp = lds + SS_XD + (32 * sb + 4 * hi + troff) * SS_XP + (32 * pb + tcol) * 2;
            { const bf16x8 bx = join8(vtr(xp), vtr(xp + 8 * SS_XP)); yacc = __builtin_amdgcn_mfma_f32_32x32x16_bf16(w0, bx, yacc, 0, 0, 0); }
            { const bf16x8 bx = join8(vtr(xp + 16 * SS_XP), vtr(xp + 24 * SS_XP)); yacc = __builtin_amdgcn_mfma_f32_32x32x16_bf16(w1, bx, yacc, 0, 0, 0); }
        }
#pragma unroll
        for (int hf = 0; hf < 2; ++hf) {
            bf16x8 fs[4];
#pragma unroll
            for (int k = 0; k < 4; ++k) fs[k] = *(const LAS bf16x8*)(lds + SS_SB + (32 * pb + ql) * SS_BP + (16 * (4 * hf + k) + 8 * hi) * 2);
            __builtin_amdgcn_sched_barrier(0);
#pragma unroll
            for (int k = 0; k < 4; ++k) oac = __builtin_amdgcn_mfma_f32_32x32x16_bf16(cfr[4 * hf + k], fs[k], oac, 0, 0, 0);
            __builtin_amdgcn_sched_barrier(0);
        }
#pragma unroll
        for (int r = 0; r < 16; ++r) { const int l = 32 * lb + crow(r, hi); const size_t m = m0 + l; const int col = h * 64 + 32 * pb + ql;
            const float xv = bf1(*(const LAS bf16_t*)(lds + SS_XD + l * SS_XP + (32 * pb + ql) * 2)); const float zv = bf1(*(const LAS bf16_t*)(lds + SS_ZI + l * SS_XP + (32 * pb + ql) * 2));
            const float y = yacc[r] + oac[r] * ((const LAS float*)(lds + SS_ECS))[l] + xv * dsk;
            YC[m * 2048 + col] = tobf(y * silu_f(zv)); }
        { const float dec = __expf(CS[127]);
#pragma unroll
          for (int r = 0; r < 16; ++r) sacc[r] *= dec;
#pragma unroll
          for (int hf = 0; hf < 2; ++hf) {
              bf16x8 fa[4], fb[4];
#pragma unroll
              for (int k = 0; k < 4; ++k) { const int st = 4 * hf + k;
                  const LAS unsigned char* ap = lds + SS_XDD + (16 * st + 8 * hi + troff) * SS_XP + (32 * pb + tcol) * 2;
                  const LAS unsigned char* bp = lds + SS_B + (16 * st + 8 * hi + troff) * SS_BP + (32 * lb + tcol) * 2;
                  fa[k] = join8(vtr(ap), vtr(ap + 4 * SS_XP)); fb[k] = join8(vtr(bp), vtr(bp + 4 * SS_BP)); }
              __builtin_amdgcn_sched_barrier(0);
#pragma unroll
              for (int k = 0; k < 4; ++k) sacc = __builtin_amdgcn_mfma_f32_32x32x16_bf16(fa[k], fb[k], sacc, 0, 0, 0);
              __builtin_amdgcn_sched_barrier(0);
          } }
        LDS_BARRIER();
#pragma unroll
        for (int r = 0; r < 16; ++r) *(LAS bf16_t*)(lds + SS_SB + (32 * pb + crow(r, hi)) * SS_BP + (32 * lb + ql) * 2) = tobf(sacc[r]);
    }
    __syncthreads();
}

#define XB_TMO      128
#define XB_XCNT(j)  (256  + 64 * (j))
#define XB_XSUB(j)  (1280 + 64 * (j))
#define XB_XGEN(j)  (2304 + 64 * (j))
#define XB_TOP      3328
#define XB_TOPGEN   3392
#define XCD_BAR_WORDS 3456
#define XB_SPIN_CAP (1u << 18)

__device__ __forceinline__ unsigned xb_ld(unsigned* p)              { return __hip_atomic_load(p, __ATOMIC_RELAXED, __HIP_MEMORY_SCOPE_AGENT); }
__device__ __forceinline__ unsigned xb_add(unsigned* p, unsigned v) { return __hip_atomic_fetch_add(p, v, __ATOMIC_RELAXED, __HIP_MEMORY_SCOPE_AGENT); }
__device__ __forceinline__ unsigned xb_xcc_id() { return (unsigned)__builtin_amdgcn_s_getreg((3 << 11) | 20) & 0xFu; }
#define XB_SPIN(cond, bar) do { unsigned _sp = 0; while (cond) { __builtin_amdgcn_s_sleep(1); \
    if ((++_sp & 255u) == 0u) { if (xb_ld(&(bar)[XB_TMO])) break; if (_sp > XB_SPIN_CAP) { atomicAdd(&(bar)[XB_TMO], 1u); break; } } } } while (0)

struct XcdBarrier {
    unsigned* bar; unsigned x;
    volatile LAS unsigned* st;
};

__device__ __forceinline__ XcdBarrier xcd_barrier_post(unsigned* bar, volatile LAS unsigned* st) {
    XcdBarrier b; b.bar = bar; b.x = xb_xcc_id(); b.st = st;
    if (threadIdx.x == 0) (void)xb_add(&bar[XB_XCNT(b.x)], 1u);
    return b;
}
__device__ __forceinline__ void xcd_barrier_complete(unsigned* bar, unsigned x, unsigned& nloc, unsigned& nx) {
    const unsigned G = gridDim.x * gridDim.y * gridDim.z;
    unsigned sum, cnt, mine, sp = 0u;
    for (;;) {
        sum = 0u; cnt = 0u; mine = 0u;
#pragma unroll
        for (unsigned j = 0; j < 16; ++j) { const unsigned c = xb_ld(&bar[XB_XCNT(j)]); sum += c; cnt += (c > 0u) ? 1u : 0u; mine = (j == x) ? c : mine; }
        if (sum == G) break;
        __builtin_amdgcn_s_sleep(1);
        if ((++sp & 255u) == 0u) { if (xb_ld(&bar[XB_TMO])) break; if (sp > XB_SPIN_CAP) { atomicAdd(&bar[XB_TMO], 1u); break; } }
    }
    nloc = mine > 0u ? mine : 1u; nx = cnt > 0u ? cnt : 1u;
}

__device__ __forceinline__ void xcd_barrier(const XcdBarrier& b) {
    asm volatile("s_waitcnt vmcnt(0)" ::: "memory");
    __syncthreads();
    if (threadIdx.x == 0) {
        unsigned* bar = b.bar; unsigned bx_ = b.x; asm volatile("" : "+s"(bar), "+s"(bx_));
        __builtin_amdgcn_s_waitcnt(0);
        unsigned nloc = b.st[0], nx = b.st[1];
        if (nloc == 0u) { xcd_barrier_complete(bar, bx_, nloc, nx); b.st[0] = nloc; b.st[1] = nx; }
        const unsigned old = xb_add(&bar[XB_XSUB(bx_)], 1u);
        const unsigned gen = old / nloc;
        if (old + 1u == (gen + 1u) * nloc) {
            __builtin_amdgcn_fence(__ATOMIC_RELEASE, "agent");
            asm volatile("s_waitcnt vmcnt(0)" ::: "memory");
            const unsigned og = xb_add(&bar[XB_TOP], 1u);
            const unsigned tg = og / nx;
            if (og + 1u == (tg + 1u) * nx) xb_add(&bar[XB_TOPGEN], 1u);
            else XB_SPIN(xb_ld(&bar[XB_TOPGEN]) == tg, bar);
            __builtin_amdgcn_fence(__ATOMIC_ACQUIRE, "agent");
            xb_add(&bar[XB_XGEN(bx_)], 1u);
            asm volatile("s_waitcnt vmcnt(0)" ::: "memory");
        } else {
            XB_SPIN(xb_ld(&bar[XB_XGEN(bx_)]) == gen, bar);
            __builtin_amdgcn_fence(__ATOMIC_ACQUIRE, "agent");
            asm volatile("s_waitcnt vmcnt(0)" ::: "memory");
        }
    }
    __syncthreads();
}

__device__ __forceinline__ void my_grid_sync(unsigned* bar, unsigned& gen) {
    asm volatile("s_waitcnt vmcnt(0) lgkmcnt(0)" ::: "memory");
    __syncthreads();
    gen += 1u;
    if (threadIdx.x == 0) {
        __builtin_amdgcn_fence(__ATOMIC_RELEASE, "agent");
        asm volatile("s_waitcnt vmcnt(0)" ::: "memory");
        __hip_atomic_fetch_add(bar, 1u, __ATOMIC_RELAXED, __HIP_MEMORY_SCOPE_AGENT);
        const unsigned target = gen * gridDim.x;
        while (__hip_atomic_load(bar, __ATOMIC_RELAXED, __HIP_MEMORY_SCOPE_AGENT) < target) __builtin_amdgcn_s_sleep(1);
        __builtin_amdgcn_fence(__ATOMIC_ACQUIRE, "agent");
        asm volatile("s_waitcnt vmcnt(0)" ::: "memory");
    }
    __syncthreads();
    asm volatile("buffer_inv sc1\n\ts_waitcnt vmcnt(0)" ::: "memory");
}
#ifdef DUP_SYNC
#define SYNC2() xcd_barrier(xbar)
#else
#define SYNC2() do {} while (0)
#endif
#define GRID_SYNC() do { xcd_barrier(xbar); SYNC2(); ws = p.ws; asm volatile("" : "+s"(ws)); RSS = (float*)(ws + WS_RSP); XB = (bf16_t*)(ws + WS_XB); } while (0)
__global__ void __launch_bounds__(512, 2) trunk_fwd(P p) {
    extern __shared__ __attribute__((aligned(16))) unsigned char lds_raw[];
    cg::grid_group grid = cg::this_grid();
    LAS unsigned char* lds = (LAS unsigned char*)lds_raw;
    const int tid = threadIdx.x, lane = tid & 63, wave = __builtin_amdgcn_readfirstlane(tid >> 6);
    const int G = gridDim.x, gw = blockIdx.x * 8 + wave, NGW = G * 8;
    LAS float* scr = (LAS float*)(lds + wave * 16384);
    const int vcu = (G % 8 == 0) ? ((int)blockIdx.x % 8) * (G / 8) + (int)blockIdx.x / 8 : (int)blockIdx.x;
    unsigned char* ws = p.ws; asm volatile("" : "+s"(ws));
    float* RSS = (float*)(ws + WS_RSP);
    bf16_t* XB = (bf16_t*)(ws + WS_XB);

    volatile LAS unsigned* bst = (volatile LAS unsigned*)(lds + (LDS_BYTES - 64));
    if (tid < 2) bst[tid] = 0u;
    __syncthreads();
    grid.sync();
    XcdBarrier xbar = xcd_barrier_post((unsigned*)(p.ws + WS_RSS), bst);
#ifndef SKIP_PRO
    prologue(p, scr, gw, NGW, lane);
#endif
    GRID_SYNC();
    { EpiRoute E{(bf16_t*)(ws + WS_KMVM), nullptr, nullptr, 8192, 0, 0, 1 << 30, 1 << 30, nullptr, 0.f, 1.f};
      run_gemm(lds, (const bf16_t*)(ws + WS_MEMN), (const bf16_t*)(ws + WS_WMKV), 2048, 8192, 1024, E); }

    for (int L = 0; L < DEPTH; ++L) {
        { EpiRoute E{(bf16_t*)(ws + WS_Z), (bf16_t*)(ws + WS_XBCPRE), (bf16_t*)(ws + WS_SM), 1024, 2048, 768, 4, 12, RSS, 1.f / 1024.f, 1.f};
          run_gemm(lds, XB, (const bf16_t*)(ws + WS_WIN), M, NIN, 1024, E); }
#ifdef DUP_G1
        { EpiRoute E{(bf16_t*)(ws + WS_Z), (bf16_t*)(ws + WS_XBCPRE), (bf16_t*)(ws + WS_SM), 1024, 2048, 768, 4, 12, RSS, 1.f / 1024.f, 1.f};
          run_gemm(lds, XB, (const bf16_t*)(ws + WS_WIN), M, NIN, 1024, E); }
#endif
        GRID_SYNC();
#ifndef SKIP_L2
        pass_l2(p, L, gw, NGW, lane);
#ifdef DUP_PASS
        pass_l2(p, L, gw, NGW, lane);
#endif
#endif
        GRID_SYNC();
#if defined(DBG_STOP) && DBG_STOP == 1
        { for (size_t i = (size_t)blockIdx.x * 512 + threadIdx.x; i < (size_t)M * 1024; i += (size_t)G * 512) { const size_t mm = i >> 10; const int cc = (int)(i & 1023); p.out[i] = bf1(((const bf16_t*)(ws + WS_XBC))[mm * 2048 + cc]) + bf1(((const bf16_t*)(ws + WS_XBC))[mm * 2048 + 1024 + cc]) + bf1(((const bf16_t*)(ws + WS_CQN))[mm * 384 + cc % 384]) + bf1(((const bf16_t*)(ws + WS_CKVN))[mm * 256 + cc % 256]) + bf1(((const bf16_t*)(ws + WS_KPE))[mm * 32 + cc % 32]) + ((const float*)(ws + WS_DT))[mm * 16 + cc % 16] + bf1(((const bf16_t*)(ws + WS_Z))[mm * 1024 + cc]); } return; }
#endif

#ifndef SKIP_SSD
        if (G >= 256) {
            if (blockIdx.x < 128) { const int su = ((int)blockIdx.x & 7) * 16 + ((int)blockIdx.x >> 3); ssd_unit(p, L, lds, su >> 4, su & 15); }
            else {
                { EpiRope E{(bf16_t*)(ws + WS_YC), (bf16_t*)(ws + WS_SM), (const float*)(ws + WS_COS), (const float*)(ws + WS_SIN), 0.10206207261596575f * LOG2E};
                  run_gemm_on(lds, (const bf16_t*)(ws + WS_CQN), (const bf16_t*)(ws + WS_WUQ), M, 1536, 384, E, 128, (int)blockIdx.x - 128); }
                { EpiRoute E{(bf16_t*)(ws + WS_KN), (bf16_t*)(ws + WS_VB), nullptr, 1024, 1024, 0, 4, 1 << 30, nullptr, 0.f, 1.f};
                  run_gemm_on(lds, (const bf16_t*)(ws + WS_CKVN), (const bf16_t*)(ws + WS_WUKV), M, 2048, 256, E, 128, (int)blockIdx.x - 128); }
                convert_layer(p, -1, -1, -1, L, scr, gw - 1024, NGW - 1024, lane); } }
        else { for (int u = blockIdx.x; u < NB * 16; u += G) ssd_unit(p, L, lds, u >> 4, u & 15);
               { EpiRope E{(bf16_t*)(ws + WS_YC), (bf16_t*)(ws + WS_SM), (const float*)(ws + WS_COS), (const float*)(ws + WS_SIN), 0.10206207261596575f * LOG2E};
                 run_gemm(lds, (const bf16_t*)(ws + WS_CQN), (const bf16_t*)(ws + WS_WUQ), M, 1536, 384, E); }
               { EpiRoute E{(bf16_t*)(ws + WS_KN), (bf16_t*)(ws + WS_VB), nullptr, 1024, 1024, 0, 4, 1 << 30, nullptr, 0.f, 1.f};
                 run_gemm(lds, (const bf16_t*)(ws + WS_CKVN), (const bf16_t*)(ws + WS_WUKV), M, 2048, 256, E); }
               convert_layer(p, -1, -1, -1, L, scr, gw, NGW, lane); }
#ifdef DUP_SSD
        for (int u = blockIdx.x; u < NB * 16; u += G) ssd_unit(p, L, lds, u >> 4, u & 15);
#endif
#endif
        GRID_SYNC();
#if defined(DBG_STOP) && DBG_STOP == 2
        { for (size_t i = (size_t)blockIdx.x * 512 + threadIdx.x; i < (size_t)M * 1024; i += (size_t)G * 512) { const size_t mm = i >> 10; const int cc = (int)(i & 1023); p.out[i] = bf1(((const bf16_t*)(ws + WS_YC))[mm * 2048 + cc]); } return; }
#endif

#ifndef SKIP_MLA
#ifdef DUP_MLA
        for (int rep_ = 0; rep_ < 2; ++rep_)
#endif
        { const int v = vcu;
          for (int uu = v; uu < 256; uu += G) { const int bh = uu >> 1, half = uu & 1, b = bh >> 4, h = bh & 15;
            for (int i = 0; i < 4; ++i) { const int qb = half ? ((i == 0) ? 1 : (i == 1) ? 6 : (i == 2) ? 2 : 5) : ((i == 0) ? 0 : (i == 1) ? 7 : (i == 2) ? 3 : 4);
                const size_t r0 = (size_t)b * SEQ;
                attn_unit<96, 64, true, true>(lds, (const bf16_t*)(ws + WS_YC) + (r0 + 256 * qb) * 2048 + 1024 + 64 * h, 2048, (const bf16_t*)(ws + WS_SM) + (r0 + 256 * qb) * 512 + 32 * h, 512,
                                              (const bf16_t*)(ws + WS_KN) + r0 * 1024 + 64 * h, 1024,
                                              (const bf16_t*)(ws + WS_KPE) + r0 * 32, 32, (const bf16_t*)(ws + WS_VB) + r0 * 1024 + 64 * h, 1024,
                                              (bf16_t*)(ws + WS_YC) + (r0 + 256 * qb) * 2048 + 1024 + 64 * h, 2048, 256 * qb, 4 * (qb + 1)); } } }
#endif
        GRID_SYNC();
#if defined(DBG_STOP) && DBG_STOP == 3
        { for (size_t i = (size_t)blockIdx.x * 512 + threadIdx.x; i < (size_t)M * 1024; i += (size_t)G * 512) { const size_t mm = i >> 10; const int cc = (int)(i & 1023); p.out[i] = bf1(((const bf16_t*)(ws + WS_YC))[mm * 2048 + 1024 + cc]); } return; }
#endif

#ifndef SKIP_YCN
        pass_ycnorm(p, gw, NGW, lane);
#endif
        convert_layer(p, L + 1, L + 1, L, -1, scr, gw, NGW, lane);
        GRID_SYNC();
        { EpiRes E{L == 0 ? p.x : p.out, p.out, XB, RSS + (size_t)16 * M};
          run_gemm(lds, (const bf16_t*)(ws + WS_YC), (const bf16_t*)(ws + WS_WOUT), M, 1024, 2048, E); }
        GRID_SYNC();
#if defined(DBG_STOP) && DBG_STOP == 4
        return;
#endif

#if defined(DBG_STOP) && DBG_STOP == 9
        { for (size_t i = (size_t)blockIdx.x * 512 + threadIdx.x; i < (size_t)M * 1024; i += (size_t)G * 512) { const size_t mm = i >> 10; const int cc = (int)(i & 1023); p.out[i] = bf1(XB[mm * 1024 + cc]); } return; }
#endif

#if defined(DBG_STOP) && DBG_STOP == 10
        { for (size_t i = (size_t)blockIdx.x * 512 + threadIdx.x; i < (size_t)M * 1024; i += (size_t)G * 512) { const size_t mm = i >> 10; const int cc = (int)(i & 1023); p.out[i] = (RSS + (size_t)16 * M)[(size_t)(cc & 3) * M * 4 + mm * 4 + ((cc >> 2) & 3)]; } return; }
#endif

        { EpiRoute E{(bf16_t*)(ws + WS_QM), nullptr, nullptr, 1024, 0, 0, 1 << 30, 1 << 30, RSS + (size_t)16 * M, 1.f / 1024.f, 0.0625f * LOG2E};
          run_gemm(lds, XB, (const bf16_t*)(ws + WS_WMQ), M, 1024, 1024, E); }
#ifdef DUP_G6
        { EpiRoute E{(bf16_t*)(ws + WS_QM), nullptr, nullptr, 1024, 0, 0, 1 << 30, 1 << 30, RSS + (size_t)16 * M, 1.f / 1024.f, 0.0625f * LOG2E};
          run_gemm(lds, XB, (const bf16_t*)(ws + WS_WMQ), M, 1024, 1024, E); }
#endif
        GRID_SYNC();
#if defined(DBG_STOP) && DBG_STOP == 7
        { for (size_t i = (size_t)blockIdx.x * 512 + threadIdx.x; i < (size_t)M * 1024; i += (size_t)G * 512) { const size_t mm = i >> 10; const int cc = (int)(i & 1023); p.out[i] = bf1(((const bf16_t*)(ws + WS_QM))[mm * 1024 + cc]); } return; }
#endif

#ifndef SKIP_MEM
        for (int uu = vcu; uu < 512; uu += G) { const int dh = uu & 1, qb = (uu >> 1) & 7, mh = (uu >> 4) & 3, b = uu >> 6;
            const bf16_t* KM = (const bf16_t*)(ws + WS_KMVM) + (size_t)(b * 256) * 8192 + L * 2048 + 256 * mh;
            attn_unit<256, 128, false, false>(lds, (const bf16_t*)(ws + WS_QM) + ((size_t)b * SEQ + 256 * qb) * 1024 + 256 * mh, 1024, nullptr, 0, KM, 8192, nullptr, 0,
                                              KM + 1024 + 128 * dh, 8192, (bf16_t*)(ws + WS_OM) + ((size_t)b * SEQ + 256 * qb) * 1024 + 256 * mh + 128 * dh, 1024, 0, 4); }
#endif
        GRID_SYNC();
#if defined(DBG_STOP) && DBG_STOP == 8
        { for (size_t i = (size_t)blockIdx.x * 512 + threadIdx.x; i < (size_t)M * 1024; i += (size_t)G * 512) { const size_t mm = i >> 10; const int cc = (int)(i & 1023); p.out[i] = bf1(((const bf16_t*)(ws + WS_OM))[mm * 1024 + cc]); } return; }
#endif

        { EpiRes E{p.out, p.out, XB, RSS + (size_t)32 * M};
          run_gemm(lds, (const bf16_t*)(ws + WS_OM), (const bf16_t*)(ws + WS_WMO), M, 1024, 1024, E); }
        GRID_SYNC();
#if defined(DBG_STOP) && DBG_STOP == 5
        return;
#endif

        { EpiGlu E{(bf16_t*)(ws + WS_ACT), RSS + (size_t)32 * M, p.ffn_conv_w + (size_t)L * 3 * 5632, p.ffn_conv_b + (size_t)L * 5632, (float*)(ws + WS_HALO), (float*)(ws + WS_PART), (LAS float*)(lds + 131072)};
          run_gemm(lds, XB, (const bf16_t*)(ws + WS_WUP), M, 5632, 1024, E); }
#ifdef DUP_G8
        { EpiGlu E{(bf16_t*)(ws + WS_ACT), RSS + (size_t)32 * M, p.ffn_conv_w + (size_t)L * 3 * 5632, p.ffn_conv_b + (size_t)L * 5632, (float*)(ws + WS_HALO), (float*)(ws + WS_PART), (LAS float*)(lds + 131072)};
          run_gemm(lds, XB, (const bf16_t*)(ws + WS_WUP), M, 5632, 1024, E); }
#endif
        GRID_SYNC();
        {
          const int nM_ = M / 256, nN_ = 4, nwg_ = nM_ * nN_;
          for (int i_ = 0; (long)i_ * G + (int)blockIdx.x < nwg_; ++i_) { int wg_ = i_ * G + (int)blockIdx.x;
              { const int q_ = nwg_ / 8, r_ = nwg_ % 8, xcd_ = wg_ % 8, off_ = wg_ / 8; wg_ = (xcd_ < r_ ? xcd_ * (q_ + 1) : r_ * (q_ + 1) + (xcd_ - r_) * q_) + off_; }
              const int nig_ = 8 * nN_, gid_ = wg_ / nig_, fm_ = gid_ * 8, gsz_ = (nM_ - fm_) < 8 ? (nM_ - fm_) : 8;
              ffn_fixup(p, L, fm_ + ((wg_ % nig_) % gsz_)); }
          EpiRes E{p.out, p.out, XB, RSS};
          run_gemm(lds, (const bf16_t*)(ws + WS_ACT), (const bf16_t*)(ws + ((L & 1) ? WS_WDN1 : WS_WDN0)), M, 1024, 2816, E); }
        GRID_SYNC();
#if defined(DBG_STOP) && DBG_STOP == 6
        return;
#endif
    }
#ifndef SKIP_FIN
    pass_final(p, gw, NGW, lane);
#endif
}

extern "C" void kernel_launch(void* const* d_in, const int* in_sizes, int n_in, void* d_out, int out_size, void* d_ws, size_t ws_size, hipStream_t stream) {
    static int grid = 0;
    if (grid == 0) {
        if (n_in != 29 || out_size != M * DM || ws_size < WS_END) { fprintf(stderr, "kernel_launch: unexpected shapes (n_in %d out %d ws %zu need %zu)\n", n_in, out_size, ws_size, (size_t)WS_END); grid = -1; return; }
        int dev = 0, cus = 0, per_cu = 0;
        hipGetDevice(&dev);
        hipDeviceGetAttribute(&cus, hipDeviceAttributeMultiprocessorCount, dev);
        hipFuncSetAttribute((const void*)trunk_fwd, hipFuncAttributeMaxDynamicSharedMemorySize, LDS_BYTES);
        hipOccupancyMaxActiveBlocksPerMultiprocessor(&per_cu, (const void*)trunk_fwd, 512, LDS_BYTES);
        if (per_cu < 1) fprintf(stderr, "kernel_launch: occupancy query reports %d\n", per_cu);
        (void)hipGetLastError();
        grid = cus;
    }
    if (grid < 0) return;
    (void)hipMemsetAsync((char*)d_ws + WS_RSS, 0, 16384, stream);
    P a{};
    const void** pp = (const void**)&a;
    for (int i = 0; i < 29; ++i) pp[i] = d_in[i];
    a.out = (float*)d_out; a.ws = (unsigned char*)d_ws;
    void* args[] = {&a};
    hipError_t e = hipLaunchCooperativeKernel((const void*)trunk_fwd, dim3(grid), dim3(512), args, LDS_BYTES, stream);
    if (e != hipSuccess) fprintf(stderr, "cooperative launch failed: %s (grid %d)\n", hipGetErrorString(e), grid);
}
```

```cpp
#include <hip/hip_runtime.h>
#include <cstdio>
#include <cstdint>
namespace pg8 {
#define PG8_LAS __attribute__((address_space(3)))
typedef unsigned short bf16_t;
typedef short bf16x8 __attribute__((ext_vector_type(8)));
typedef float f32x4 __attribute__((ext_vector_type(4)));
typedef unsigned u32x4 __attribute__((ext_vector_type(4)));
constexpr int BM = 256, BK = 64, HALF = 128, HTB = HALF * BK * 2  , STAGE_BYTES = 8 * HTB, NXCD = 8, WGM = 8;

__host__ __device__ __forceinline__ int lds_byte(int r, int c) { const int st = (r >> 4) * 2 + (c >> 5), rr = r & 15, cc = c & 31, ob = rr * 64 + cc * 2; return st * 1024 + (ob ^ (((ob >> 9) & 1) << 5)); }
__host__ __device__ __forceinline__ void stage_rc(int b, int& R, int& C) { const int st = b / 1024, sb = b % 1024, swz = sb ^ (((sb >> 9) & 1) << 5); R = (st >> 1) * 16 + swz / 64; C = (st & 1) * 32 + (swz % 64) / 2; }
__host__ __device__ __forceinline__ int perm32(int rho) { const int n = rho >> 4, i = rho & 15; return 8 * (i >> 2) + 4 * n + (i & 3); }

struct Unit { int pm, pn; };
struct Gemm { const bf16_t* A; const bf16_t* Bt; int M, N, K; };

struct StaticOrder {
    int nM, nN, nwg, G, c;
    __host__ __device__ void init(int M, int N, int G_, int c_) { nM = M / BM; nN = N / BM; nwg = nM * nN; G = G_; c = c_; }
    __host__ __device__ bool next(int i, Unit& u) const {
        const long L = (long)i * G + c; if (L >= nwg) return false;
        int wgid = (int)L; { const int q = nwg / NXCD, r = nwg % NXCD, xcd = wgid % NXCD, off = wgid / NXCD; wgid = (xcd < r ? xcd * (q + 1) : r * (q + 1) + (xcd - r) * q) + off; }
        const int nig = WGM * nN, gid = wgid / nig, fm = gid * WGM, gsz = (nM - fm) < WGM ? (nM - fm) : WGM;
        u.pm = fm + ((wgid % nig) % gsz); u.pn = (wgid % nig) / gsz; return true;
    }
    __device__ __forceinline__ void a_ready(const Unit&) const {}
    __device__ __forceinline__ void done(const Unit&) const {}
};

__device__ __forceinline__ unsigned cvt_pk_bf16(float lo, float hi) { unsigned r; asm volatile("v_cvt_pk_bf16_f32 %0, %1, %2" : "=v"(r) : "v"(lo), "v"(hi)); return r; }
typedef float f32x2 __attribute__((ext_vector_type(2)));
__device__ __forceinline__ f32x2 gelu_pk(f32x2 v) {
    const f32x2 av = __builtin_elementwise_abs(v), d = av * 0.2316418882f + 1.0f;
    f32x2 t; t.x = __builtin_amdgcn_rcpf(d.x); t.y = __builtin_amdgcn_rcpf(d.y);
    f32x2 q = t * 0.5307027145f + (-0.7265760135f); q = q * t + 0.7107068705f; q = q * t + (-0.142248368f); q = q * t + 0.127414796f; q = q * t;
    const f32x2 s = (v * v) * (-0.72134752044f);
    f32x2 e; e.x = __builtin_amdgcn_exp2f(s.x); e.y = __builtin_amdgcn_exp2f(s.y);
    const f32x2 m = v * (q * e), r = v - m;
    f32x2 o; o.x = v.x < 0.f ? m.x : r.x; o.y = v.y < 0.f ? m.y : r.y; return o;
}

template <int ACT  > struct EpiBf16 {
    static constexpr bool PERM = true, AFTER_DRAIN = false; static_assert(ACT == 0 || ACT == 1, "EpiBf16: ACT is 0 (none) or 1 (gelu_pk)");
    bf16_t* O; int ldc; const float* bias; int split_cols; size_t split_stride; float scale0;
    __device__ __forceinline__ void operator()(const f32x4 (&acc)[2][2][4][2], const Unit& u, int wr, int wc, int fr, int fq) const {
        const int row0 = u.pm * BM + wr * 64 + fr; int colt = u.pn * BM; bf16_t* base = O;
        float sc = 1.f; if (split_cols) { const int t = colt / split_cols; base += (size_t)t * split_stride; colt -= t * split_cols; if (t == 0) sc = scale0; }
        const int col0 = colt + wc * 32 + 8 * fq, bcol0 = u.pn * BM + wc * 32 + 8 * fq;
        f32x4 bv[2][2];
#pragma unroll
        for (int bj = 0; bj < 2; ++bj)
#pragma unroll
            for (int n = 0; n < 2; ++n) bv[bj][n] = bias ? *(const f32x4*)(bias + bcol0 + bj * HALF + 4 * n) : (f32x4){0.f, 0.f, 0.f, 0.f};
#pragma unroll
        for (int ai = 0; ai < 2; ++ai)
#pragma unroll
            for (int m = 0; m < 4; ++m) { bf16_t* rowp = base + (size_t)(row0 + ai * HALF + m * 16) * ldc + col0;
#pragma unroll
                for (int bj = 0; bj < 2; ++bj) { f32x4 v0 = acc[ai][bj][m][0] + bv[bj][0], v1 = acc[ai][bj][m][1] + bv[bj][1];
                    if (ACT == 1) { f32x2 a = gelu_pk((f32x2){v0[0], v0[1]}), b = gelu_pk((f32x2){v0[2], v0[3]}), c = gelu_pk((f32x2){v1[0], v1[1]}), d = gelu_pk((f32x2){v1[2], v1[3]});
                        v0 = (f32x4){a.x, a.y, b.x, b.y}; v1 = (f32x4){c.x, c.y, d.x, d.y}; }
                    v0 = v0 * sc; v1 = v1 * sc; u32x4 w; w.x = cvt_pk_bf16(v0[0], v0[1]); w.y = cvt_pk_bf16(v0[2], v0[3]); w.z = cvt_pk_bf16(v1[0], v1[1]); w.w = cvt_pk_bf16(v1[2], v1[3]);
                    *(u32x4*)(rowp + bj * HALF) = w; } }
    }
};

struct PanelStats {
    unsigned* xbuf;
    unsigned* cnt;
    unsigned* tmo;
    int ntn; float eps;
    unsigned code;
    __device__ __forceinline__ bool run(const f32x4 (&v)[2][2][4][2], const Unit& u, int wr, int wc, int fr, int fq, PG8_LAS unsigned char* lds, int wid, int lane) const {
        typedef float f32x2v __attribute__((ext_vector_type(2)));
        PG8_LAS f32x2v* P = (PG8_LAS f32x2v*)lds;
        PG8_LAS f32x2v* S = (PG8_LAS f32x2v*)(lds + 8192);
        PG8_LAS unsigned* flag = (PG8_LAS unsigned*)(lds + 8192 + 2048);
#pragma unroll
        for (int ai = 0; ai < 2; ++ai)
#pragma unroll
            for (int m = 0; m < 4; ++m) {
                float s = 0.f;
#pragma unroll
                for (int bj = 0; bj < 2; ++bj)
#pragma unroll
                    for (int n = 0; n < 2; ++n) { const f32x4 x = v[ai][bj][m][n]; s += (x[0] + x[1]) + (x[2] + x[3]); }
                s += __shfl_xor(s, 16); s += __shfl_xor(s, 32);
                const float mw = s * (1.0f / 64.0f); float q = 0.f;
#pragma unroll
                for (int bj = 0; bj < 2; ++bj)
#pragma unroll
                    for (int n = 0; n < 2; ++n) { const f32x4 d = v[ai][bj][m][n] - mw; q += (d[0] * d[0] + d[1] * d[1]) + (d[2] * d[2] + d[3] * d[3]); }
                q += __shfl_xor(q, 16); q += __shfl_xor(q, 32);
                if (fq == 0) P[(ai * HALF + wr * 64 + m * 16 + fr) * 4 + wc] = (f32x2v){mw, q};
            }
        asm volatile("s_waitcnt lgkmcnt(0)" ::: "memory"); __builtin_amdgcn_s_barrier(); asm volatile("" ::: "memory");
#if defined(BROKEN_EXCHANGE_NO_WAIT)
#warning BROKEN CONTROL BUILD: the row-statistics exchange does not wait; results are wrong by design
        if (blockIdx.x >= 64) { const long long t0_ = clock64(); while (clock64() - t0_ < 60000) __builtin_amdgcn_s_sleep(8); }
#endif
        const int row = wid * 32 + (lane & 31);
        if (lane < 32) {
            const f32x2v a = P[row * 4 + 0], b = P[row * 4 + 1], c = P[row * 4 + 2], d = P[row * 4 + 3];
            const float mt = (a.x + b.x + c.x + d.x) * 0.25f;
            const float da = a.x - mt, db = b.x - mt, dc = c.x - mt, dd = d.x - mt;
            const float m2 = (a.y + b.y) + (c.y + d.y) + 64.0f * ((da * da + db * db) + (dc * dc + dd * dd));
            unsigned long long* slot = (unsigned long long*)xbuf + ((size_t)(u.pm * BM + row) * 4 + u.pn);
            __hip_atomic_store(slot, ((unsigned long long)__float_as_uint(m2) << 32) | __float_as_uint(mt), __ATOMIC_RELAXED, __HIP_MEMORY_SCOPE_AGENT);
        }
        asm volatile("s_waitcnt vmcnt(0)" ::: "memory");
        if (lane == 0) __hip_atomic_fetch_add(cnt + 64 * u.pm, 1u, __ATOMIC_RELAXED, __HIP_MEMORY_SCOPE_AGENT);
        if (wid == 0) {
            bool dead = false; const unsigned long long t0 = __builtin_amdgcn_s_memrealtime(); const unsigned want = 8u * (unsigned)ntn;
            for (;;) {
#if defined(BROKEN_EXCHANGE_NO_WAIT)
                break;
#endif
                if ((unsigned)__builtin_amdgcn_readfirstlane(__hip_atomic_load(cnt + 64 * u.pm, __ATOMIC_RELAXED, __HIP_MEMORY_SCOPE_AGENT)) >= want) break;
                if (__builtin_amdgcn_s_memrealtime() - t0 > 2000000ull) {
                    if (lane == 0) { unsigned expect = 0u; __hip_atomic_compare_exchange_strong(tmo + 1, &expect, code | (unsigned)(u.pm & 0xff), __ATOMIC_RELAXED, __ATOMIC_RELAXED, __HIP_MEMORY_SCOPE_AGENT);
                                     __hip_atomic_store(tmo, 1u, __ATOMIC_RELAXED, __HIP_MEMORY_SCOPE_AGENT); }
                    dead = true; break; }
                __builtin_amdgcn_s_sleep(2);
            }
            __builtin_amdgcn_fence(__ATOMIC_ACQUIRE, "agent");
            if (lane == 0) flag[0] = dead ? 1u : 0u;
        }
        asm volatile("s_waitcnt vmcnt(0) lgkmcnt(0)" ::: "memory"); __builtin_amdgcn_s_barrier(); asm volatile("" ::: "memory");
        const bool bad = flag[0] != 0u;
        if (lane < 32) {
            const unsigned long long* slot = (const unsigned long long*)xbuf + (size_t)(u.pm * BM + row) * 4; float mt[4], m2[4]; float ms = 0.f;
#pragma unroll
            for (int t = 0; t < 4; ++t) { if (t < ntn) { const unsigned long long w = __hip_atomic_load(slot + t, __ATOMIC_RELAXED, __HIP_MEMORY_SCOPE_AGENT); mt[t] = __uint_as_float((unsigned)w); m2[t] = __uint_as_float((unsigned)(w >> 32)); } else { mt[t] = 0.f; m2[t] = 0.f; } ms += mt[t]; }
            const float mean = ms / (float)ntn; float q = 0.f;
#pragma unroll
            for (int t = 0; t < 4; ++t) if (t < ntn) { const float dm = mt[t] - mean; q += m2[t] + 256.0f * dm * dm; }
            S[row] = (f32x2v){mean, 1.0f / sqrtf(q / (256.0f * (float)ntn) + eps)};
        }
        asm volatile("s_waitcnt lgkmcnt(0)" ::: "memory"); __builtin_amdgcn_s_barrier(); asm volatile("" ::: "memory");
        return bad;
    }
};
struct EpiLnRes {
    static constexpr bool PERM = false, AFTER_DRAIN = true;
    const float* base; float* out; int ldc; const float* bias; PanelStats st; unsigned poison;
    __device__ __forceinline__ void fused(f32x4 (&acc)[2][2][4][2], const Unit& u, int wr, int wc, int fr, int fq, PG8_LAS unsigned char* lds, int wid, int lane) const {
        typedef float f32x2v __attribute__((ext_vector_type(2)));
        const PG8_LAS f32x2v* S = (const PG8_LAS f32x2v*)(lds + 8192);
        const int col0 = u.pn * BM + wc * 32 + 4 * fq;
#pragma unroll
        for (int bj = 0; bj < 2; ++bj)
#pragma unroll
            for (int n = 0; n < 2; ++n) { const f32x4 bv = bias ? *(const f32x4*)(bias + col0 + bj * HALF + n * 16) : (f32x4){0.f, 0.f, 0.f, 0.f};
#pragma unroll
                for (int ai = 0; ai < 2; ++ai)
#pragma unroll
                    for (int m = 0; m < 4; ++m) acc[ai][bj][m][n] += bv; }
        f32x4 pre[4][2][2];
#pragma unroll
        for (int m = 0; m < 4; ++m) { const size_t off = (size_t)(u.pm * BM + wr * 64 + m * 16 + fr) * ldc + col0;
#pragma unroll
            for (int bj = 0; bj < 2; ++bj)
#pragma unroll
                for (int n = 0; n < 2; ++n) pre[m][bj][n] = *(const f32x4*)(base + off + bj * HALF + n * 16); }
        const bool bad = st.run(acc, u, wr, wc, fr, fq, lds, wid, lane) || poison != 0u;
        const float qnan = __builtin_nanf("");
#pragma unroll
        for (int ai = 0; ai < 2; ++ai)
#pragma unroll
            for (int m = 0; m < 4; ++m) { const int r = ai * HALF + wr * 64 + m * 16 + fr; const f32x2v sr = S[r]; const size_t off = (size_t)(u.pm * BM + r) * ldc + col0;
#pragma unroll
                for (int bj = 0; bj < 2; ++bj)
#pragma unroll
                    for (int n = 0; n < 2; ++n) { const f32x4 bs = ai == 0 ? pre[m][bj][n] : *(const f32x4*)(base + off + bj * HALF + n * 16); f32x4 o = bs + (acc[ai][bj][m][n] - sr.x) * sr.y;
                        if (bad) o = (f32x4){qnan, qnan, qnan, qnan}; *(f32x4*)(out + off + bj * HALF + n * 16) = o; }
                if (m & 1) asm volatile("" ::: "memory"); }
    }
};
struct EpiLnResLn {
    static constexpr bool PERM = false, AFTER_DRAIN = true;
    const float* base; float* out; bf16_t* xn; int ldc; const float* bias; PanelStats st1, st2; unsigned poison;
    __device__ __forceinline__ void fused(f32x4 (&acc)[2][2][4][2], const Unit& u, int wr, int wc, int fr, int fq, PG8_LAS unsigned char* lds, int wid, int lane) const {
        typedef float f32x2v __attribute__((ext_vector_type(2))); typedef unsigned u32x2v __attribute__((ext_vector_type(2)));
        const PG8_LAS f32x2v* S = (const PG8_LAS f32x2v*)(lds + 8192);
        const int col0 = u.pn * BM + wc * 32 + 4 * fq;
#pragma unroll
        for (int bj = 0; bj < 2; ++bj)
#pragma unroll
            for (int n = 0; n < 2; ++n) { const f32x4 bv = bias ? *(const f32x4*)(bias + col0 + bj * HALF + n * 16) : (f32x4){0.f, 0.f, 0.f, 0.f};
#pragma unroll
                for (int ai = 0; ai < 2; ++ai)
#pragma unroll
                    for (int m = 0; m < 4; ++m) acc[ai][bj][m][n] += bv; }
        bool bad = st1.run(acc, u, wr, wc, fr, fq, lds, wid, lane) || poison != 0u;
        const float qnan = __builtin_nanf("");
#pragma unroll
        for (int ai = 0; ai < 2; ++ai)
#pragma unroll
            for (int m = 0; m < 4; ++m) { const int r = ai * HALF + wr * 64 + m * 16 + fr; const f32x2v sr = S[r]; const size_t off = (size_t)(u.pm * BM + r) * ldc + col0;
#pragma unroll
                for (int bj = 0; bj < 2; ++bj)
#pragma unroll
                    for (int n = 0; n < 2; ++n) { const f32x4 bs = *(const f32x4*)(base + off + bj * HALF + n * 16); acc[ai][bj][m][n] = bs + (acc[ai][bj][m][n] - sr.x) * sr.y; }
                asm volatile("" : "+v"(acc[ai][0][m][0]), "+v"(acc[ai][0][m][1]), "+v"(acc[ai][1][m][0]), "+v"(acc[ai][1][m][1]));
                if (m & 1) asm volatile("" ::: "memory"); }
        const bool bad1 = bad;
        bad = st2.run(acc, u, wr, wc, fr, fq, lds, wid, lane) || bad;
#pragma unroll
        for (int ai = 0; ai < 2; ++ai)
#pragma unroll
            for (int m = 0; m < 4; ++m) { const int r = ai * HALF + wr * 64 + m * 16 + fr; const f32x2v sr = S[r]; const size_t off = (size_t)(u.pm * BM + r) * ldc + col0;
#pragma unroll
                for (int bj = 0; bj < 2; ++bj)
#pragma unroll
                    for (int n = 0; n < 2; ++n) { const f32x4 x1 = acc[ai][bj][m][n]; *(f32x4*)(out + off + bj * HALF + n * 16) = bad1 ? (f32x4){qnan, qnan, qnan, qnan} : x1;
                        const f32x4 o = (x1 - sr.x) * sr.y; u32x2v w; w.x = cvt_pk_bf16(o[0], o[1]); w.y = cvt_pk_bf16(o[2], o[3]);
                        if (bad) { w.x = 0x7fc07fc0u; w.y = 0x7fc07fc0u; } *(u32x2v*)(xn + off + bj * HALF + n * 16) = w; }
                asm volatile("" ::: "memory"); }
    }
};

template <class Epi, class Sched, bool ALIGN_EPI = false, bool SP2 = false>
__device__ __forceinline__ void gemm_phase(PG8_LAS unsigned char* lds, const Gemm g, const Sched& S, const Epi& E) {
    int tid_ = threadIdx.x; asm volatile("" : "+v"(tid_));
    const int tid = tid_, wid = __builtin_amdgcn_readfirstlane(tid >> 6), lane = tid & 63, wr = wid >> 2, wc = wid & 3, fr = lane & 15, fq = lane >> 4;
    const int K = g.K, nt = K / BK;
    unsigned voffA[2], voffB[2];
#pragma unroll
    for (int i = 0; i < 2; ++i) { int R, C; stage_rc(tid * 16 + i * 8192, R, C); const int Rb = Epi::PERM ? ((R & ~31) + perm32(R & 31)) : R;
        voffA[i] = (unsigned)(R * K + C) * 2u; voffB[i] = (unsigned)(Rb * K + C) * 2u; }
    const size_t kstep = (size_t)(BK * 2);
    const size_t hstep = (size_t)HALF * K * 2;
    const size_t tstep = 2 * hstep;
    const unsigned ldsw = (unsigned)wid * 1024u;
    const int aoff = lds_byte(wr * 64 + fr, fq * 8), boff = lds_byte(wc * 32 + fr, fq * 8);
#define PG8_SA(b, h) (((b) * 2 + (h)) * HTB)
#define PG8_SB(b, h) ((4 + (b) * 2 + (h)) * HTB)
#define PG8_STAGE(bufoff, gbase, voff) do { _Pragma("unroll") for (int _i = 0; _i < 2; ++_i) \
        __builtin_amdgcn_global_load_lds((const unsigned*)((const char*)(gbase) + (voff)[_i]), (PG8_LAS unsigned*)(lds + (bufoff) + ldsw + _i * 8192), 16, 0, 0); } while (0)
#define PG8_LDA(dst, b, h) do { _Pragma("unroll") for (int m = 0; m < 4; ++m) _Pragma("unroll") for (int k = 0; k < 2; ++k) dst[m][k] = *(const PG8_LAS bf16x8*)(lds + PG8_SA(b, h) + aoff + m * 2048 + k * 1024); } while (0)
#define PG8_LDB(dst, b, h) do { _Pragma("unroll") for (int n = 0; n < 2; ++n) _Pragma("unroll") for (int k = 0; k < 2; ++k) dst[n][k] = *(const PG8_LAS bf16x8*)(lds + PG8_SB(b, h) + boff + n * 2048 + k * 1024); } while (0)
#define PG8_MMA(ai, bj, At, Bt) do { __builtin_amdgcn_s_setprio(1); _Pragma("unroll") for (int m = 0; m < 4; ++m) _Pragma("unroll") for (int n = 0; n < 2; ++n) _Pragma("unroll") for (int k = 0; k < 2; ++k) \
        acc[ai][bj][m][n] = __builtin_amdgcn_mfma_f32_16x16x32_bf16(Bt[n][k], At[m][k], acc[ai][bj][m][n], 0, 0, 0); __builtin_amdgcn_s_setprio(0); } while (0)
#define PG8_WAIT_V(n) asm volatile("s_waitcnt vmcnt(" #n ")" ::: "memory")
#define PG8_WAIT_L(n) asm volatile("s_waitcnt lgkmcnt(" #n ")" ::: "memory")
#define PG8_BAR __builtin_amdgcn_s_barrier()
#define PG8_SCHED __builtin_amdgcn_sched_barrier(0)
    Unit cur, nxt; int ui = 0;
    if (!S.next(0, cur)) return;
    f32x4 acc[2][2][4][2];
#pragma unroll
    for (int a = 0; a < 2; ++a)
#pragma unroll
        for (int b = 0; b < 2; ++b)
#pragma unroll
            for (int m = 0; m < 4; ++m)
#pragma unroll
                for (int n = 0; n < 2; ++n) acc[a][b][m][n] = (f32x4){0.f, 0.f, 0.f, 0.f};
    bf16x8 At[4][2], B0[2][2], B1[2][2];
    const char* cA = (const char*)g.A + (size_t)cur.pm * tstep; const char* cB = (const char*)g.Bt + (size_t)cur.pn * tstep;
    S.a_ready(cur);
    if constexpr (SP2) {
        PG8_STAGE(PG8_SB(0, 0), cB, voffB); PG8_STAGE(PG8_SB(0, 1), cB + hstep, voffB); PG8_STAGE(PG8_SA(0, 0), cA, voffA); PG8_STAGE(PG8_SA(0, 1), cA + hstep, voffA);
        if (wr == 1) PG8_BAR;
        PG8_WAIT_V(2); PG8_BAR;
        PG8_STAGE(PG8_SB(1, 0), cB + kstep, voffB); PG8_STAGE(PG8_SA(1, 0), cA + kstep, voffA); PG8_STAGE(PG8_SB(1, 1), cB + hstep + kstep, voffB);
        PG8_WAIT_V(6); PG8_BAR;
    } else {
        PG8_STAGE(PG8_SB(0, 0), cB, voffB); PG8_STAGE(PG8_SA(0, 0), cA, voffA); PG8_STAGE(PG8_SB(0, 1), cB + hstep, voffB); PG8_STAGE(PG8_SA(0, 1), cA + hstep, voffA);
        if (wr == 1) PG8_BAR;
        PG8_WAIT_V(4); PG8_BAR;
        PG8_STAGE(PG8_SB(1, 0), cB + kstep, voffB); PG8_STAGE(PG8_SA(1, 0), cA + kstep, voffA); PG8_STAGE(PG8_SB(1, 1), cB + hstep + kstep, voffB);
        PG8_WAIT_V(6); PG8_BAR;
    }
    for (;;) {
        const bool has_next = S.next(ui + 1, nxt);
        const char* nA = has_next ? (const char*)g.A + (size_t)nxt.pm * tstep : cA; const char* nB = has_next ? (const char*)g.Bt + (size_t)nxt.pn * tstep : cB;
        for (int t = 0; t < nt; t += 2) {
            const bool last = (t == nt - 2);
            const char* a1 = cA + (size_t)(t + 1) * kstep;
            const char* a2 = last ? nA : cA + (size_t)(t + 2) * kstep; const char* b2 = last ? nB : cB + (size_t)(t + 2) * kstep;
            const char* a3 = a2 + kstep; const char* b3 = b2 + kstep;
            if (last && has_next) S.a_ready(nxt);
            if constexpr (SP2) {
            PG8_LDB(B0, 0, 0); PG8_LDB(B1, 0, 1); PG8_SCHED; PG8_LDA(At, 0, 0); PG8_STAGE(PG8_SA(1, 1), a1 + hstep, voffA);
            PG8_WAIT_V(8); PG8_WAIT_L(0); PG8_BAR; PG8_MMA(0, 0, At, B0); PG8_MMA(0, 1, At, B1); PG8_BAR; PG8_SCHED;
            PG8_LDA(At, 0, 1); PG8_STAGE(PG8_SB(0, 0), b2, voffB); PG8_STAGE(PG8_SB(0, 1), b2 + hstep, voffB); PG8_STAGE(PG8_SA(0, 0), a2, voffA);
            PG8_WAIT_V(8); PG8_WAIT_L(0); PG8_BAR; PG8_MMA(1, 0, At, B0); PG8_MMA(1, 1, At, B1); PG8_BAR; PG8_SCHED;
            PG8_LDB(B0, 1, 0); PG8_LDB(B1, 1, 1); PG8_SCHED; PG8_LDA(At, 1, 0); PG8_STAGE(PG8_SA(0, 1), a2 + hstep, voffA);
            PG8_WAIT_V(8); PG8_WAIT_L(0); PG8_BAR; PG8_MMA(0, 0, At, B0); PG8_MMA(0, 1, At, B1); PG8_BAR; PG8_SCHED;
            PG8_LDA(At, 1, 1); PG8_STAGE(PG8_SB(1, 0), b3, voffB); PG8_STAGE(PG8_SB(1, 1), b3 + hstep, voffB); PG8_STAGE(PG8_SA(1, 0), a3, voffA);
            PG8_WAIT_V(8); PG8_WAIT_L(0); PG8_BAR; PG8_MMA(1, 0, At, B0); PG8_MMA(1, 1, At, B1); PG8_BAR; PG8_SCHED;
            } else {
            PG8_LDB(B0, 0, 0); PG8_SCHED; PG8_LDA(At, 0, 0); PG8_STAGE(PG8_SA(1, 1), a1 + hstep, voffA);
            PG8_WAIT_L(8); PG8_BAR; PG8_WAIT_L(0); PG8_MMA(0, 0, At, B0); PG8_BAR; PG8_SCHED;
            PG8_LDB(B1, 0, 1); PG8_STAGE(PG8_SB(0, 0), b2, voffB);
            PG8_BAR; PG8_WAIT_L(0); PG8_MMA(0, 1, At, B1); PG8_BAR;
            PG8_LDA(At, 0, 1); PG8_STAGE(PG8_SA(0, 0), a2, voffA);
            PG8_BAR; PG8_WAIT_L(0); PG8_MMA(1, 0, At, B0); PG8_BAR; PG8_SCHED;
            PG8_STAGE(PG8_SB(0, 1), b2 + hstep, voffB);
            PG8_WAIT_V(6); PG8_BAR; PG8_MMA(1, 1, At, B1); PG8_BAR;
            PG8_LDB(B0, 1, 0); PG8_SCHED; PG8_LDA(At, 1, 0); PG8_STAGE(PG8_SA(0, 1), a2 + hstep, voffA);
            PG8_WAIT_L(8); PG8_BAR; PG8_WAIT_L(0); PG8_MMA(0, 0, At, B0); PG8_BAR; PG8_SCHED;
            PG8_LDB(B1, 1, 1); PG8_STAGE(PG8_SB(1, 0), b3, voffB);
            PG8_BAR; PG8_WAIT_L(0); PG8_MMA(0, 1, At, B1); PG8_BAR;
            PG8_LDA(At, 1, 1); PG8_STAGE(PG8_SA(1, 0), a3, voffA);
            PG8_BAR; PG8_WAIT_L(0); PG8_MMA(1, 0, At, B0); PG8_BAR; PG8_SCHED;
            PG8_STAGE(PG8_SB(1, 1), b3 + hstep, voffB);
            PG8_WAIT_V(6); PG8_BAR; PG8_MMA(1, 1, At, B1); PG8_BAR;
            }
        }
        if constexpr (ALIGN_EPI) { if (wr == 0) PG8_BAR; }
        if constexpr (!Epi::AFTER_DRAIN) { E(acc, cur, wr, wc, fr, fq); S.done(cur); }
        if (!has_next) break;
#pragma unroll
        for (int a = 0; a < 2; ++a)
#pragma unroll
            for (int b = 0; b < 2; ++b)
#pragma unroll
                for (int m = 0; m < 4; ++m)
#pragma unroll
                    for (int n = 0; n < 2; ++n) acc[a][b][m][n] = (f32x4){0.f, 0.f, 0.f, 0.f};
        cur = nxt; cA = nA; cB = nB; ++ui;
        if constexpr (ALIGN_EPI) { if (wr == 1) PG8_BAR; }
    }
    PG8_WAIT_V(0);
    if constexpr (!ALIGN_EPI) { if (wr == 0) PG8_BAR; }
    PG8_BAR;
    if constexpr (Epi::AFTER_DRAIN) { E.fused(acc, cur, wr, wc, fr, fq, lds, wid, lane); S.done(cur); }
#undef PG8_SA
#undef PG8_SB
#undef PG8_STAGE
#undef PG8_LDA
#undef PG8_LDB
#undef PG8_MMA
#undef PG8_WAIT_V
#undef PG8_WAIT_L
#undef PG8_BAR
#undef PG8_SCHED
}
}

#include <hip/hip_cooperative_groups.h>
namespace cg = cooperative_groups;
#define LAS __attribute__((address_space(3)))
typedef unsigned short bf16_t;
using pg8::f32x4; using pg8::bf16x8; using pg8::u32x4;
typedef float f32x2_t __attribute__((ext_vector_type(2))); typedef __bf16 bf16x2_t __attribute__((ext_vector_type(2)));
__device__ __forceinline__ unsigned cvt_pk_bf16(float lo, float hi) { f32x2_t v = {lo, hi}; bf16x2_t b = __builtin_convertvector(v, bf16x2_t); return __builtin_bit_cast(unsigned, b); }
typedef float f32x16 __attribute__((ext_vector_type(16)));
typedef short s16x4 __attribute__((ext_vector_type(4)));
typedef unsigned u32x2 __attribute__((ext_vector_type(2)));

constexpr int M = 16384, DM = 1024, SEQ = 2048, NB = 8, DEPTH = 4;
constexpr int NIN = 3840;
constexpr int DFF = 2816;
constexpr float EPS = 1e-6f;
constexpr float LOG2E = 1.4426950408889634f;
constexpr int LDS_BYTES = 147456;

struct P {
    const float *x, *mem; const int* pos;
    const float *norm_mix, *w_in, *ssm_conv_w, *ssm_conv_b, *dt_bias, *a_log, *d_skip, *ssm_norm, *q_norm, *w_uq, *kv_norm, *w_ukv, *attn_out_norm, *w_out,
                *norm_mem_q, *norm_mem_kv, *w_mq, *w_mk, *w_mv, *w_mo, *norm_ffn, *w_up, *ffn_conv_w, *ffn_conv_b, *w_down, *final_norm;
    float* out; unsigned char* ws;
};

constexpr size_t KiB = 1024, MiB = 1024 * 1024;
constexpr size_t WS_RSS = 0, WS_COS = 1 * MiB, WS_SIN = 2 * MiB, WS_DT = 3 * MiB, WS_KPE = 4 * MiB;
constexpr size_t WS_WIN = 6144 * KiB, WS_WUQ = 13824 * KiB, WS_WUKV = 14976 * KiB, WS_WOUT = 16000 * KiB, WS_WMQ = 20096 * KiB, WS_WMO = 22144 * KiB,
                 WS_WUP = 24192 * KiB, WS_WDN0 = 35456 * KiB, WS_WDN1 = 41088 * KiB;
constexpr size_t WS_WMKV = 46 * MiB, WS_KMVM = 62 * MiB, WS_MEMN = 94 * MiB, WS_XB = 98 * MiB, WS_VB = 98 * MiB;
constexpr size_t WS_Z = 130 * MiB, WS_QM = 130 * MiB, WS_U = 130 * MiB;
constexpr size_t WS_WUKV1 = 5 * MiB;
constexpr size_t WS_XBCPRE = 162 * MiB, WS_YC = 162 * MiB, WS_OM = 162 * MiB;
constexpr size_t WS_ACT = 218 * MiB;
constexpr size_t WS_SM = 226 * MiB, WS_XBC = 250 * MiB, WS_QB = 250 * MiB, WS_CQN = 314 * MiB, WS_CKVN = 326 * MiB, WS_RSP = 334 * MiB, WS_HALO = 337 * MiB, WS_PART = 340 * MiB, WS_KN = 343 * MiB, WS_END = 375 * MiB;

__device__ __forceinline__ float bflo(unsigned w) { return __uint_as_float(w << 16); }
__device__ __forceinline__ float bfhi(unsigned w) { return __uint_as_float(w & 0xffff0000u); }
__device__ __forceinline__ float bf1(bf16_t h) { return __uint_as_float((unsigned)h << 16); }
__device__ __forceinline__ bf16_t tobf(float f) { return (bf16_t)(cvt_pk_bf16(f, 0.f) & 0xffffu); }
__device__ __forceinline__ float wave_sum(float v) {
#pragma unroll
    for (int o = 1; o < 64; o <<= 1) v += __shfl_xor(v, o);
    return v;
}
__device__ __forceinline__ float silu_f(float v) { return v * __builtin_amdgcn_rcpf(1.f + __expf(-v)); }
__device__ __forceinline__ int crow(int r, int hi) { return (r & 3) + 8 * (r >> 2) + 4 * hi; }
#define LDS_WAIT() asm volatile("s_waitcnt lgkmcnt(0)" ::: "memory")
__device__ __forceinline__ int fresh_tid() { int t = threadIdx.x; asm volatile("" : "+v"(t)); return t; }
__device__ __forceinline__ float rss16(const float* rsp, int row) { const f32x4 a = *(const f32x4*)(rsp + (size_t)row * 4), b = *(const f32x4*)(rsp + (size_t)M * 4 + (size_t)row * 4), c = *(const f32x4*)(rsp + (size_t)M * 8 + (size_t)row * 4), d = *(const f32x4*)(rsp + (size_t)M * 12 + (size_t)row * 4);
    return (((a[0] + a[1]) + (a[2] + a[3])) + ((b[0] + b[1]) + (b[2] + b[3]))) + (((c[0] + c[1]) + (c[2] + c[3])) + ((d[0] + d[1]) + (d[2] + d[3]))); }

struct EpiRoute {
    static constexpr bool PERM = true, AFTER_DRAIN = false;
    bf16_t *b0, *b1, *b2; int ld0, ld1, ld2, t1, t2; const float* rss; float invk, mul;
    __device__ __forceinline__ void operator()(const f32x4 (&acc)[2][2][4][2], const pg8::Unit& u, int wr_, int wc_, int fr_, int fq_) const {
        const int t_ = fresh_tid(), wid_ = __builtin_amdgcn_readfirstlane(t_ >> 6), wr = wid_ >> 2, wc = wid_ & 3, fr = t_ & 15, fq = (t_ >> 4) & 3;
        bf16_t* base; int ld, colt;
        if (u.pn < t1) { base = b0; ld = ld0; colt = u.pn * 256; } else if (u.pn < t2) { base = b1; ld = ld1; colt = (u.pn - t1) * 256; } else { base = b2; ld = ld2; colt = (u.pn - t2) * 256; }
        const int col0 = colt + wc * 32 + 8 * fq;
#pragma unroll
        for (int ai = 0; ai < 2; ++ai)
#pragma unroll
            for (int m = 0; m < 4; ++m) {
                const int row = u.pm * 256 + ai * 128 + wr * 64 + m * 16 + fr;
                float s = mul; if (rss) s *= rsqrtf(rss16(rss, row) * invk + EPS);
                bf16_t* rowp = base + (size_t)row * ld + col0;
#pragma unroll
                for (int bj = 0; bj < 2; ++bj) { const f32x4 v0 = acc[ai][bj][m][0] * s, v1 = acc[ai][bj][m][1] * s;
                    u32x4 w; w.x = cvt_pk_bf16(v0[0], v0[1]); w.y = cvt_pk_bf16(v0[2], v0[3]); w.z = cvt_pk_bf16(v1[0], v1[1]); w.w = cvt_pk_bf16(v1[2], v1[3]);
                    *(u32x4*)(rowp + bj * 128) = w; }
                asm volatile("" ::: "memory");
            }
    }
};
struct EpiRope {
    static constexpr bool PERM = false, AFTER_DRAIN = false;
    bf16_t* YCq; bf16_t* QPE; const float* cs; const float* sn; float mul;
    __device__ __forceinline__ void operator()(const f32x4 (&acc)[2][2][4][2], const pg8::Unit& u, int wr_, int wc_, int fr_, int fq_) const {
        const int t_ = fresh_tid(), wid_ = __builtin_amdgcn_readfirstlane(t_ >> 6), wr = wid_ >> 2, wc = wid_ & 3, fr = t_ & 15, fq = (t_ >> 4) & 3;
#pragma unroll
        for (int ai = 0; ai < 2; ++ai)
#pragma unroll
            for (int m = 0; m < 4; ++m) {
                const int row = u.pm * 256 + ai * 128 + wr * 64 + m * 16 + fr;
                const f32x4 c = *(const f32x4*)(cs + (size_t)row * 16 + 4 * fq), s = *(const f32x4*)(sn + (size_t)row * 16 + 4 * fq);
#pragma unroll
                for (int bj = 0; bj < 2; ++bj) { const int gb = u.pn * 256 + bj * 128 + wc * 32; const int head = gb / 96, within = gb - head * 96; const bool rope = within == 64;
                    f32x4 a = acc[ai][bj][m][0], b = acc[ai][bj][m][1];
                    if (rope) { const f32x4 a2 = a * c - b * s, b2 = b * c + a * s; a = a2; b = b2; }
                    a = a * mul; b = b * mul;
                    bf16_t* dst = rope ? (QPE + (size_t)row * 512 + 32 * head + 4 * fq) : (YCq + (size_t)row * 2048 + 1024 + 64 * head + within + 4 * fq);
                    u32x2 w0, w1; w0.x = cvt_pk_bf16(a[0], a[1]); w0.y = cvt_pk_bf16(a[2], a[3]); w1.x = cvt_pk_bf16(b[0], b[1]); w1.y = cvt_pk_bf16(b[2], b[3]);
                    *(u32x2*)dst = w0; *(u32x2*)(dst + 16) = w1; }
                asm volatile("" ::: "memory");
            }
    }
};
struct EpiRes {
    static constexpr bool PERM = false, AFTER_DRAIN = false;
    const float* xin; float* xout; bf16_t* xb; float* rss;
    __device__ __forceinline__ void operator()(const f32x4 (&acc)[2][2][4][2], const pg8::Unit& u, int wr_, int wc_, int fr_, int fq_) const {
        const int t_ = fresh_tid(), wid_ = __builtin_amdgcn_readfirstlane(t_ >> 6), wr = wid_ >> 2, wc = wid_ & 3, fr = t_ & 15, fq = (t_ >> 4) & 3;
#pragma unroll
        for (int ai = 0; ai < 2; ++ai)
#pragma unroll
            for (int m = 0; m < 4; ++m) {
                const int row = u.pm * 256 + ai * 128 + wr * 64 + m * 16 + fr; float ss = 0.f;
#pragma unroll
                for (int bj = 0; bj < 2; ++bj)
#pragma unroll
                    for (int n = 0; n < 2; ++n) { const size_t off = (size_t)row * 1024 + u.pn * 256 + bj * 128 + wc * 32 + 16 * n + 4 * fq;
                        const f32x4 v = *(const f32x4*)(xin + off) + acc[ai][bj][m][n];
                        *(f32x4*)(xout + off) = v; u32x2 w; w.x = cvt_pk_bf16(v[0], v[1]); w.y = cvt_pk_bf16(v[2], v[3]); *(u32x2*)(xb + off) = w;
                        ss += (v[0] * v[0] + v[1] * v[1]) + (v[2] * v[2] + v[3] * v[3]); }
                ss += __shfl_xor(ss, 16); ss += __shfl_xor(ss, 32);
                if (fq == 0) rss[(size_t)u.pn * M * 4 + (size_t)row * 4 + wc] = ss;
                asm volatile("" ::: "memory");
            }
    }
};


template <int CTRL> __device__ __forceinline__ float dpp_mov(float old, float src) {
    return __builtin_bit_cast(float, __builtin_amdgcn_update_dpp(__builtin_bit_cast(int, old), __builtin_bit_cast(int, src), CTRL, 0xf, 0xf, false)); }
struct EpiGlu {
    static constexpr bool PERM = true, AFTER_DRAIN = false;
    bf16_t* ACT; const float* rss; const float* cw; const float* cb; float* HALO; float* PART; LAS float* H;
    __device__ __forceinline__ void operator()(const f32x4 (&acc)[2][2][4][2], const pg8::Unit& u, int wr_, int wc_, int fr_, int fq_) const {
        typedef float f32x2v __attribute__((ext_vector_type(2)));
        typedef __attribute__((address_space(1))) f32x4 gf4; typedef __attribute__((address_space(1))) f32x2v gf2; typedef __attribute__((address_space(1))) u32x2 gu2;
        const int t_ = fresh_tid(), wid_ = __builtin_amdgcn_readfirstlane(t_ >> 6), wr = wid_ >> 2, wc = wid_ & 3, fr = t_ & 15, fq = (t_ >> 4) & 3;
        const int pm = u.pm, pn = u.pn;
        LAS float* RS = H + 2048; LAS float* WT = H + 2304;
        if (t_ < 256) { RS[t_] = rsqrtf(rss16(rss, pm * 256 + t_) * (1.f / 1024.f) + EPS);
            const unsigned gcol = (unsigned)((t_ >> 7) * 2816 + 128 * pn + (t_ & 127));
            WT[t_] = cw[gcol]; WT[256 + t_] = cw[5632u + gcol]; WT[512 + t_] = cw[11264u + gcol]; WT[768 + t_] = cb[gcol]; }
        asm volatile("s_waitcnt lgkmcnt(0)" ::: "memory"); __builtin_amdgcn_s_barrier(); asm volatile("" ::: "memory");
        const LAS float* RSl = RS + wr * 64 + fr;
        const int lc = wc * 32 + 8 * fq;
        if (fr >= 14) {
#pragma unroll
            for (int ai = 0; ai < 2; ++ai)
#pragma unroll
                for (int bj = 0; bj < 2; ++bj)
#pragma unroll
                    for (int n = 0; n < 2; ++n) { const f32x4 v = acc[ai][bj][3][n] * RSl[ai * 128 + 48];
                        *(LAS f32x4*)(H + ((ai * 2 + wr) * 2 + (fr - 14)) * 256 + bj * 128 + lc + 4 * n) = v;
                        if (ai == 1 && wr == 1) *(gf4*)(HALO + (unsigned)((pm * 2 + (fr - 14)) * 5632 + bj * 2816 + 128 * pn + lc + 4 * n)) = v; }
        }
        asm volatile("s_waitcnt lgkmcnt(0)" ::: "memory"); __builtin_amdgcn_s_barrier(); asm volatile("" ::: "memory");
#pragma unroll
        for (int n = 0; n < 2; ++n)
#pragma unroll
            for (int ai = 0; ai < 2; ++ai) {
                const int src = ai * 2 + wr - 1;
                unsigned res0[4];
#pragma unroll
                for (int jp = 0; jp < 2; ++jp) {
                    const int lcc = lc + 4 * n + 2 * jp;
                    const f32x2v w0g = *(const LAS f32x2v*)(WT + lcc), w1g = *(const LAS f32x2v*)(WT + 256 + lcc), w2g = *(const LAS f32x2v*)(WT + 512 + lcc), bg = *(const LAS f32x2v*)(WT + 768 + lcc);
                    const f32x2v w0v = *(const LAS f32x2v*)(WT + 128 + lcc), w1v = *(const LAS f32x2v*)(WT + 384 + lcc), w2v = *(const LAS f32x2v*)(WT + 640 + lcc), bv = *(const LAS f32x2v*)(WT + 896 + lcc);
                    f32x2v pg = (f32x2v){0.f, 0.f}, pv = (f32x2v){0.f, 0.f};
                    if (src >= 0) { const LAS float* hp = H + (src * 2 + (fr & 1)) * 256 + lcc; pg = *(const LAS f32x2v*)hp; pv = *(const LAS f32x2v*)(hp + 128); }
                    const unsigned gc = (unsigned)(128 * pn + lcc);
#pragma unroll
                    for (int m = 0; m < 4; ++m) {
                        const float sm_ = RSl[ai * 128 + m * 16];
                        const f32x2v cg = (f32x2v){acc[ai][0][m][n][2 * jp] * sm_, acc[ai][0][m][n][2 * jp + 1] * sm_}, cv = (f32x2v){acc[ai][1][m][n][2 * jp] * sm_, acc[ai][1][m][n][2 * jp + 1] * sm_};
                        f32x2v og, ov;
#pragma unroll
                        for (int j = 0; j < 2; ++j) {
                            const float g1 = dpp_mov<0x111>(dpp_mov<0x121>(pg[j], pg[j]), cg[j]), g2 = dpp_mov<0x112>(dpp_mov<0x122>(pg[j], pg[j]), cg[j]);
                            const float v1 = dpp_mov<0x111>(dpp_mov<0x121>(pv[j], pv[j]), cv[j]), v2 = dpp_mov<0x112>(dpp_mov<0x122>(pv[j], pv[j]), cv[j]);
                            og[j] = bg[j] + w2g[j] * cg[j] + w1g[j] * g1 + w0g[j] * g2;
                            ov[j] = bv[j] + w2v[j] * cv[j] + w1v[j] * v1 + w0v[j] * v2; }
                        pg = cg; pv = cv;
                        const int row = pm * 256 + ai * 128 + wr * 64 + m * 16 + fr;
                        const bool partial = (ai == 0) && (m == 0) && (wr == 0) && (fr < 2) && ((pm & 7) != 0);
                        if (partial) { *(gf2*)(PART + ((unsigned)(((pm * 2 + fr) * 2 + 0) * 2816) + gc)) = og; *(gf2*)(PART + ((unsigned)(((pm * 2 + fr) * 2 + 1) * 2816) + gc)) = ov; }
                        const unsigned pk = cvt_pk_bf16(silu_f(og[0]) * ov[0], silu_f(og[1]) * ov[1]);
                        if (jp == 0) res0[m] = pk;
                        else if (!partial) { u32x2 o; o.x = res0[m]; o.y = pk; *(gu2*)(ACT + ((unsigned)(row * DFF) + gc - 2u)) = o; }
                    }
                    asm volatile("" ::: "memory");
                }
            }
    }
};
__device__ __forceinline__ void ffn_fixup(const P& p, int L, int pm) {
    if ((pm & 7) == 0) return;
    unsigned char* ws = p.ws; asm volatile("" : "+s"(ws));
    const float* HALO = (const float*)(ws + WS_HALO); const float* PART = (const float*)(ws + WS_PART); bf16_t* ACT = (bf16_t*)(ws + WS_ACT);
    const float* cw = p.ffn_conv_w + (size_t)L * 3 * 5632;
    const int tid = fresh_tid();
    for (int idx = tid; idx < 2 * DFF; idx += 512) { const int r = idx / DFF, c = idx - r * DFF;
        float g = PART[(((size_t)pm * 2 + r) * 2 + 0) * 2816 + c], v = PART[(((size_t)pm * 2 + r) * 2 + 1) * 2816 + c];
        const float hg0 = HALO[((size_t)(pm - 1) * 2 + 0) * 5632 + c], hg1 = HALO[((size_t)(pm - 1) * 2 + 1) * 5632 + c];
        const float hv0 = HALO[((size_t)(pm - 1) * 2 + 0) * 5632 + 2816 + c], hv1 = HALO[((size_t)(pm - 1) * 2 + 1) * 5632 + 2816 + c];
        if (r == 0) { g += cw[5632 + c] * hg1 + cw[c] * hg0; v += cw[5632 + 2816 + c] * hv1 + cw[2816 + c] * hv0; }
        else { g += cw[c] * hg1; v += cw[2816 + c] * hv1; }
        ACT[((size_t)pm * 256 + r) * DFF + c] = tobf(silu_f(g) * v); }
    asm volatile("s_waitcnt vmcnt(0)" ::: "memory");
    __syncthreads();
}

template <class Epi>
__device__ __forceinline__ void run_gemm_on(LAS unsigned char* lds, const bf16_t* A, const bf16_t* Bt, int m, int n, int k, const Epi& E, int G_, int c_) {
    pg8::Gemm g{A, Bt, m, n, k}; pg8::StaticOrder S; S.init(m, n, G_, c_);
    pg8::gemm_phase<Epi, pg8::StaticOrder, true, true>(lds, g, S, E);
}
template <class Epi>
__device__ __forceinline__ void run_gemm(LAS unsigned char* lds, const bf16_t* A, const bf16_t* Bt, int m, int n, int k, const Epi& E) {
    pg8::Gemm g{A, Bt, m, n, k}; pg8::StaticOrder S; S.init(m, n, (int)gridDim.x, (int)blockIdx.x);
    pg8::gemm_phase<Epi, pg8::StaticOrder, true, true>(lds, g, S, E);
}

template <class SrcCol, class Gain>
__device__ __forceinline__ void tr_item(const float* W, int K, int Nsrc, bf16_t* WT, int nblk, LAS float* scr, int item, int lane, SrcCol srccol, Gain gain) {
    const int kb = item / nblk, nb = item % nblk, k0 = 64 * kb, n0 = 32 * nb;
    const int sc = srccol(n0 + (lane & 31));
#pragma unroll
    for (int i = 0; i < 32; ++i) { const int kk = 2 * i + (lane >> 5);
        float v = 0.f; if (sc >= 0) v = W[(size_t)(k0 + kk) * Nsrc + sc] * gain(k0 + kk);
        scr[kk * 33 + (lane & 31)] = v; }
    LDS_WAIT(); asm volatile("" ::: "memory");
    const int c = lane & 7;
#pragma unroll
    for (int j = 0; j < 4; ++j) { const int n = (lane >> 3) + 8 * j; const LAS float* s = scr + (8 * c) * 33 + n;
        u32x4 o; o.x = cvt_pk_bf16(s[0 * 33], s[1 * 33]); o.y = cvt_pk_bf16(s[2 * 33], s[3 * 33]); o.z = cvt_pk_bf16(s[4 * 33], s[5 * 33]); o.w = cvt_pk_bf16(s[6 * 33], s[7 * 33]);
        *(u32x4*)(WT + (size_t)(n0 + n) * K + k0 + 8 * c) = o; }
    LDS_WAIT(); asm volatile("" ::: "memory");
}

__device__ __forceinline__ void convert_layer(const P& p, int Lw, int Lq, int Lu, int L, LAS float* scr, int gw, int NGW, int lane_unused) {
    const int lane = fresh_tid() & 63;
    unsigned char* ws = p.ws; asm volatile("" : "+s"(ws));
    constexpr int I_IN = 16 * 120, I_UQ = 6 * 48, I_UKV = 4 * 64, I_OUT = 32 * 32, I_MQ = 16 * 32, I_MO = 16 * 32, I_UP = 16 * 176, I_DN = 44 * 32;
    constexpr int NIT = I_IN + I_UQ + I_UKV + I_OUT + I_MQ + I_MO + I_UP + I_DN;
    for (int it = gw; it < NIT; it += NGW) {
        int r = it;
        if (r < I_IN) { if (Lw < 0 || Lw >= DEPTH) continue; const float* g = p.norm_mix + Lw * 1024;
            tr_item(p.w_in + (size_t)Lw * 1024 * 3760, 1024, 3760, (bf16_t*)(ws + WS_WIN), 120, scr, r, lane,
                    [](int n) { return n < 3072 ? n : (n < 3744 ? n + 16 : (n < 3760 ? n - 672 : -1)); }, [g](int k) { return g[k]; }); continue; } r -= I_IN;
        if (r < I_UQ) { if (Lq < 0 || Lq >= DEPTH) continue; const float* g = p.q_norm + Lq * 384;
            tr_item(p.w_uq + (size_t)Lq * 384 * 1536, 384, 1536, (bf16_t*)(ws + WS_WUQ), 48, scr, r, lane, [](int n) { return n; }, [g](int k) { return g[k]; }); continue; } r -= I_UQ;
        if (r < I_UKV) { if (Lq < 0 || Lq >= DEPTH) continue; const float* g = p.kv_norm + Lq * 256;
            tr_item(p.w_ukv + (size_t)Lq * 256 * 2048, 256, 2048, (bf16_t*)(ws + WS_WUKV), 64, scr, r, lane,
                    [](int n) { return n < 1024 ? 128 * (n >> 6) + (n & 63) : 128 * ((n - 1024) >> 6) + 64 + (n & 63); }, [g](int k) { return g[k]; }); continue; } r -= I_UKV;
        if (r < I_OUT) { if (L < 0) continue; const float* g1 = p.ssm_norm + L * 1024; const float* g2 = p.attn_out_norm + L * 1024;
            tr_item(p.w_out + (size_t)L * 2048 * 1024, 2048, 1024, (bf16_t*)(ws + WS_WOUT), 32, scr, r, lane, [](int n) { return n; }, [g1, g2](int k) { return k < 1024 ? g1[k] : g2[k - 1024]; }); continue; } r -= I_OUT;
        if (r < I_MQ) { if (L < 0) continue; const float* g = p.norm_mem_q + L * 1024;
            tr_item(p.w_mq + (size_t)L * 1024 * 1024, 1024, 1024, (bf16_t*)(ws + WS_WMQ), 32, scr, r, lane, [](int n) { return n; }, [g](int k) { return g[k]; }); continue; } r -= I_MQ;
        if (r < I_MO) { if (L < 0) continue;
            tr_item(p.w_mo + (size_t)L * 1024 * 1024, 1024, 1024, (bf16_t*)(ws + WS_WMO), 32, scr, r, lane, [](int n) { return n; }, [](int) { return 1.f; }); continue; } r -= I_MO;
        if (r < I_UP) { if (Lu < 0 || Lu >= DEPTH) continue; const float* g = p.norm_ffn + Lu * 1024;
            tr_item(p.w_up + (size_t)Lu * 1024 * 5632, 1024, 5632, (bf16_t*)(ws + WS_WUP), 176, scr, r, lane, [](int n) { return (n & 128) ? 2816 + 128 * (n >> 8) + (n & 127) : 128 * (n >> 8) + (n & 127); }, [g](int k) { return g[k]; }); continue; } r -= I_UP;
        if (L < 0) continue;
        tr_item(p.w_down + (size_t)L * 2816 * 1024, 2816, 1024, (bf16_t*)(ws + ((L & 1) ? WS_WDN1 : WS_WDN0)), 32, scr, r, lane, [](int n) { return n; }, [](int) { return 1.f; });
    }
}

__device__ __forceinline__ void prologue(const P& p, LAS float* scr, int gw, int NGW, int lane_unused) {
    const int lane = fresh_tid() & 63;
    unsigned char* ws = p.ws; asm volatile("" : "+s"(ws));
    float* rss = (float*)(ws + WS_RSP);
    bf16_t* XB = (bf16_t*)(ws + WS_XB);
    for (int m = gw; m < M; m += NGW) {
        const f32x4* xr = (const f32x4*)(p.x + (size_t)m * 1024) + lane; float ss = 0.f;
#pragma unroll
        for (int j = 0; j < 4; ++j) { const f32x4 v = xr[64 * j]; ss += (v[0] * v[0] + v[1] * v[1]) + (v[2] * v[2] + v[3] * v[3]);
            u32x2 w; w.x = cvt_pk_bf16(v[0], v[1]); w.y = cvt_pk_bf16(v[2], v[3]); *((u32x2*)(XB + (size_t)m * 1024) + lane + 64 * j) = w; }
        ss = wave_sum(ss); if (lane < 16) rss[(size_t)(lane >> 2) * M * 4 + (size_t)m * 4 + (lane & 3)] = (lane == 0) ? ss : 0.f;
    }
    bf16_t* MEMN = (bf16_t*)(ws + WS_MEMN);
    for (int m = gw; m < 2048; m += NGW) {
        const f32x4* xr = (const f32x4*)(p.mem + (size_t)m * 1024) + lane; f32x4 v[4]; float ss = 0.f;
#pragma unroll
        for (int j = 0; j < 4; ++j) { v[j] = xr[64 * j]; ss += (v[j][0] * v[j][0] + v[j][1] * v[j][1]) + (v[j][2] * v[j][2] + v[j][3] * v[j][3]); }
        const float rs = rsqrtf(wave_sum(ss) * (1.f / 1024.f) + EPS);
#pragma unroll
        for (int j = 0; j < 4; ++j) { u32x2 w; w.x = cvt_pk_bf16(v[j][0] * rs, v[j][1] * rs); w.y = cvt_pk_bf16(v[j][2] * rs, v[j][3] * rs); *((u32x2*)(MEMN + (size_t)m * 1024) + lane + 64 * j) = w; }
    }
    float* COS = (float*)(ws + WS_COS); float* SIN = (float*)(ws + WS_SIN);
    for (int i = gw * 64 + lane; i < M * 16; i += NGW * 64) { const int m = i >> 4, k = i & 15;
        const float inv = powf(10000.f, -(float)(2 * k) / 32.f); const float ang = (float)p.pos[m] * inv;
        COS[i] = cosf(ang); SIN[i] = sinf(ang); }
    for (int it = gw; it < 4 * 2 * 512; it += NGW) { const int L = it >> 10, kv = (it >> 9) & 1, r = it & 511; const float* g = p.norm_mem_kv + L * 1024;
        tr_item((kv ? p.w_mv : p.w_mk) + (size_t)L * 1024 * 1024, 1024, 1024, (bf16_t*)(ws + WS_WMKV) + (size_t)(L * 2048 + kv * 1024) * 1024, 32, scr, r, lane, [](int n) { return n; }, [g](int k) { return g[k]; }); }
    convert_layer(p, 0, 0, -1, -1, scr, gw, NGW, lane);
}

__device__ __forceinline__ void pass_l2(const P& p, int L, int gw, int NGW, int lane_unused) {
    const int lane = fresh_tid() & 63;
    unsigned char* ws = p.ws; asm volatile("" : "+s"(ws));
    const bf16_t* XP = (const bf16_t*)(ws + WS_XBCPRE); bf16_t* XO = (bf16_t*)(ws + WS_XBC); const bf16_t* SM = (const bf16_t*)(ws + WS_SM);
    bf16_t* CQN = (bf16_t*)(ws + WS_CQN); bf16_t* CKVN = (bf16_t*)(ws + WS_CKVN); bf16_t* KPE = (bf16_t*)(ws + WS_KPE); float* DT = (float*)(ws + WS_DT);
    const float* COS = (const float*)(ws + WS_COS); const float* SIN = (const float*)(ws + WS_SIN);
    const float* cw = p.ssm_conv_w + (size_t)L * 4 * 2048; const float* cb = p.ssm_conv_b + (size_t)L * 2048;
    for (int blk = gw; blk < M / 8; blk += NGW) {
        const int m0 = blk * 8, t0 = m0 & (SEQ - 1);
#pragma unroll 2
        for (int j = 0; j < 4; ++j) {
            const int c = lane * 8 + 512 * j;
            const f32x4 b0 = *(const f32x4*)(cb + c), b1 = *(const f32x4*)(cb + c + 4);
            f32x4 w0[4], w1[4];
#pragma unroll
            for (int k = 0; k < 4; ++k) { w0[k] = *(const f32x4*)(cw + k * 2048 + c); w1[k] = *(const f32x4*)(cw + k * 2048 + c + 4); }
            u32x4 xr[11];
#pragma unroll
            for (int i = 0; i < 11; ++i) { if (t0 - 3 + i >= 0) xr[i] = *(const u32x4*)(XP + (size_t)(m0 - 3 + i) * 2048 + c); else xr[i] = (u32x4){0u, 0u, 0u, 0u}; }
#pragma unroll
            for (int r = 0; r < 8; ++r) {
                f32x4 a0 = b0, a1 = b1;
#pragma unroll
                for (int k = 0; k < 4; ++k) { const u32x4 v = xr[r + k];
                    a0[0] += w0[k][0] * bflo(v.x); a0[1] += w0[k][1] * bfhi(v.x); a0[2] += w0[k][2] * bflo(v.y); a0[3] += w0[k][3] * bfhi(v.y);
                    a1[0] += w1[k][0] * bflo(v.z); a1[1] += w1[k][1] * bfhi(v.z); a1[2] += w1[k][2] * bflo(v.w); a1[3] += w1[k][3] * bfhi(v.w); }
                u32x4 o; o.x = cvt_pk_bf16(silu_f(a0[0]), silu_f(a0[1])); o.y = cvt_pk_bf16(silu_f(a0[2]), silu_f(a0[3]));
                o.z = cvt_pk_bf16(silu_f(a1[0]), silu_f(a1[1])); o.w = cvt_pk_bf16(silu_f(a1[2]), silu_f(a1[3]));
                *(u32x4*)(XO + (size_t)(m0 + r) * 2048 + c) = o;
            }
        }
    }
    for (int m = gw; m < M; m += NGW) {
        const unsigned* sm = (const unsigned*)(SM + (size_t)m * 768);
        {
            unsigned w[3]; float ss = 0.f;
#pragma unroll
            for (int i = 0; i < 3; ++i) { w[i] = sm[lane + 64 * i]; const float a = bflo(w[i]), b = bfhi(w[i]); ss += a * a + b * b; }
            const float rs = rsqrtf(wave_sum(ss) * (1.f / 384.f) + EPS);
#pragma unroll
            for (int i = 0; i < 3; ++i) ((unsigned*)(CQN + (size_t)m * 384))[lane + 64 * i] = cvt_pk_bf16(bflo(w[i]) * rs, bfhi(w[i]) * rs);
        }
        {
            unsigned w[2]; float ss = 0.f;
#pragma unroll
            for (int i = 0; i < 2; ++i) { w[i] = sm[192 + lane + 64 * i]; const float a = bflo(w[i]), b = bfhi(w[i]); ss += a * a + b * b; }
            const float rs = rsqrtf(wave_sum(ss) * (1.f / 256.f) + EPS);
#pragma unroll
            for (int i = 0; i < 2; ++i) ((unsigned*)(CKVN + (size_t)m * 256))[lane + 64 * i] = cvt_pk_bf16(bflo(w[i]) * rs, bfhi(w[i]) * rs);
        }
        {
            const bf16_t* sr = SM + (size_t)m * 768;
            const float v = bf1(sr[640 + (lane & 31)]); const float pr = __shfl_xor(v, 16); const int i = lane & 15;
            const float c = COS[(size_t)m * 16 + i], s = SIN[(size_t)m * 16 + i];
            const float o = (lane & 16) ? (v * c + pr * s) : (v * c - pr * s);
            if (lane < 32) KPE[(size_t)m * 32 + lane] = tobf(o);
            const float d = bf1(sr[672 + (lane & 15)]) + p.dt_bias[L * 16 + (lane & 15)];
            const float sp = fmaxf(d, 0.f) + __logf(1.f + __expf(-fabsf(d)));
            if (lane < 16) DT[(size_t)m * 16 + lane] = sp;
        }
    }
}

__device__ __forceinline__ void pass_ycnorm(const P& p, int gw, int NGW, int lane_unused) {
    const int lane = fresh_tid() & 63;
    unsigned char* ws = p.ws; asm volatile("" : "+s"(ws));
    bf16_t* YC = (bf16_t*)(ws + WS_YC);
    for (int m0 = gw; m0 < M; m0 += 2 * NGW) {
        u32x4 v[2][4];
#pragma unroll
        for (int q = 0; q < 2; ++q) { const int m = m0 + q * NGW; if (m < M) {
#pragma unroll
            for (int j = 0; j < 4; ++j) v[q][j] = ((const u32x4*)(YC + (size_t)m * 2048))[lane + 64 * j]; } }
#pragma unroll
        for (int q = 0; q < 2; ++q) { const int m = m0 + q * NGW; if (m < M) {
            u32x4* row = (u32x4*)(YC + (size_t)m * 2048); float s[2] = {0.f, 0.f};
#pragma unroll
            for (int j = 0; j < 4; ++j) { const u32x4 w = v[q][j]; float a = 0.f;
                a += bflo(w.x) * bflo(w.x) + bfhi(w.x) * bfhi(w.x); a += bflo(w.y) * bflo(w.y) + bfhi(w.y) * bfhi(w.y);
                a += bflo(w.z) * bflo(w.z) + bfhi(w.z) * bfhi(w.z); a += bflo(w.w) * bflo(w.w) + bfhi(w.w) * bfhi(w.w);
                s[j >> 1] += a; }
            const float r0 = rsqrtf(wave_sum(s[0]) * (1.f / 1024.f) + EPS), r1 = rsqrtf(wave_sum(s[1]) * (1.f / 1024.f) + EPS);
#pragma unroll
            for (int j = 0; j < 4; ++j) { const float r = (j < 2) ? r0 : r1; const u32x4 w = v[q][j]; u32x4 o;
                o.x = cvt_pk_bf16(bflo(w.x) * r, bfhi(w.x) * r); o.y = cvt_pk_bf16(bflo(w.y) * r, bfhi(w.y) * r);
                o.z = cvt_pk_bf16(bflo(w.z) * r, bfhi(w.z) * r); o.w = cvt_pk_bf16(bflo(w.w) * r, bfhi(w.w) * r);
                row[lane + 64 * j] = o; } } }
    }
}

__device__ __forceinline__ void pass_ffnact(const P& p, int L, int half, int gw, int NGW, int lane_unused) {
    const int lane = fresh_tid() & 63;
    unsigned char* ws = p.ws; asm volatile("" : "+s"(ws));
    const bf16_t* U = (const bf16_t*)(ws + WS_U); bf16_t* ACT = (bf16_t*)(ws + WS_ACT) + (size_t)half * 8192 * DFF;
    const float* cw = p.ffn_conv_w + (size_t)L * 3 * 5632; const float* cb = p.ffn_conv_b + (size_t)L * 5632;
    for (int blk = gw; blk < 8192 / 4; blk += NGW) {
        const int m0 = blk * 4, t0 = m0 & (SEQ - 1);
        for (int ch = lane; ch < DFF / 8; ch += 64) {
            const int c = ch * 8;
            const f32x4 bg0 = *(const f32x4*)(cb + c), bg1 = *(const f32x4*)(cb + c + 4), bv0 = *(const f32x4*)(cb + DFF + c), bv1 = *(const f32x4*)(cb + DFF + c + 4);
            f32x4 wg0[3], wg1[3], wv0[3], wv1[3];
#pragma unroll
            for (int k = 0; k < 3; ++k) { const float* wk = cw + k * 5632; wg0[k] = *(const f32x4*)(wk + c); wg1[k] = *(const f32x4*)(wk + c + 4); wv0[k] = *(const f32x4*)(wk + DFF + c); wv1[k] = *(const f32x4*)(wk + DFF + c + 4); }
            u32x4 ug[6], uv[6];
#pragma unroll
            for (int i = 0; i < 6; ++i) { if (t0 - 2 + i >= 0) { const bf16_t* ur = U + (size_t)(m0 - 2 + i) * 5632; ug[i] = *(const u32x4*)(ur + c); uv[i] = *(const u32x4*)(ur + DFF + c); }
                else { ug[i] = (u32x4){0u, 0u, 0u, 0u}; uv[i] = (u32x4){0u, 0u, 0u, 0u}; } }
#pragma unroll
            for (int r = 0; r < 4; ++r) {
                f32x4 g0 = bg0, g1 = bg1, v0 = bv0, v1 = bv1;
#pragma unroll
                for (int k = 0; k < 3; ++k) { const u32x4 a = ug[r + k], b = uv[r + k];
                    g0[0] += wg0[k][0] * bflo(a.x); g0[1] += wg0[k][1] * bfhi(a.x); g0[2] += wg0[k][2] * bflo(a.y); g0[3] += wg0[k][3] * bfhi(a.y);
                    g1[0] += wg1[k][0] * bflo(a.z); g1[1] += wg1[k][1] * bfhi(a.z); g1[2] += wg1[k][2] * bflo(a.w); g1[3] += wg1[k][3] * bfhi(a.w);
                    v0[0] += wv0[k][0] * bflo(b.x); v0[1] += wv0[k][1] * bfhi(b.x); v0[2] += wv0[k][2] * bflo(b.y); v0[3] += wv0[k][3] * bfhi(b.y);
                    v1[0] += wv1[k][0] * bflo(b.z); v1[1] += wv1[k][1] * bfhi(b.z); v1[2] += wv1[k][2] * bflo(b.w); v1[3] += wv1[k][3] * bfhi(b.w); }
                u32x4 o; o.x = cvt_pk_bf16(silu_f(g0[0]) * v0[0], silu_f(g0[1]) * v0[1]); o.y = cvt_pk_bf16(silu_f(g0[2]) * v0[2], silu_f(g0[3]) * v0[3]);
                o.z = cvt_pk_bf16(silu_f(g1[0]) * v1[0], silu_f(g1[1]) * v1[1]); o.w = cvt_pk_bf16(silu_f(g1[2]) * v1[2], silu_f(g1[3]) * v1[3]);
                *(u32x4*)(ACT + (size_t)(m0 + r) * DFF + c) = o;
            }
        }
    }
}

__device__ __forceinline__ void pass_final(const P& p, int gw, int NGW, int lane_unused) {
    const int lane = fresh_tid() & 63;
    const float* rss = (const float*)(p.ws + WS_RSP);
    for (int m = gw; m < M; m += NGW) {
        const float rs = rsqrtf(rss16(rss, m) * (1.f / 1024.f) + EPS);
        f32x4* xr = (f32x4*)(p.out + (size_t)m * 1024) + lane; const f32x4* g = (const f32x4*)p.final_norm + lane;
#pragma unroll
        for (int j = 0; j < 4; ++j) { f32x4 v = xr[64 * j]; v = v * rs * g[64 * j]; xr[64 * j] = v; }
    }
}

typedef short v4i16_t __attribute__((ext_vector_type(4)));
__device__ __forceinline__ s16x4 vtr(const LAS unsigned char* p) { return __builtin_bit_cast(s16x4, __builtin_amdgcn_ds_read_tr16_b64_v4i16((LAS v4i16_t*)p)); }
__device__ __forceinline__ bf16x8 join8(s16x4 lo, s16x4 hi) { return (bf16x8){lo[0], lo[1], lo[2], lo[3], hi[0], hi[1], hi[2], hi[3]}; }
__device__ __forceinline__ bf16x8 pack8(const f32x16& s, int b) {
    u32x4 w; w.x = cvt_pk_bf16(s[b], s[b + 1]); w.y = cvt_pk_bf16(s[b + 2], s[b + 3]); w.z = cvt_pk_bf16(s[b + 4], s[b + 5]); w.w = cvt_pk_bf16(s[b + 6], s[b + 7]);
    return __builtin_bit_cast(bf16x8, w);
}

template <int DQK, int DV, bool CAUSAL, bool K2>
__device__ __forceinline__ void attn_unit(LAS unsigned char* lds, const bf16_t* Q, int qpitch, const bf16_t* Qp2, int q2pitch, const bf16_t* K, int kpitch, const bf16_t* Kp2, int k2pitch,
                                          const bf16_t* V, int vpitch, bf16_t* O, int opitch, int q0, int NT) {
    constexpr int KP = (DQK + 8) * 2, VP = (DV == 64) ? 192 : 320;
    constexpr int KBUF = 64 * KP, VBUF = 64 * VP, BUF = KBUF + VBUF;
    constexpr int KCH = DQK / 8, VCH = DV / 8, NKC = 64 * KCH, NVC = 64 * VCH;
    constexpr int NKR = (NKC + 511) / 512, NVR = NVC / 512;
    const int tid = fresh_tid(), lane = tid & 63, w = __builtin_amdgcn_readfirstlane(tid >> 6), ql = lane & 31, hi = lane >> 5;
    u32x4 kreg[NKR], vreg[NVR];
    auto gload = [&](int t) {
#pragma unroll
        for (int i = 0; i < NKR; ++i) { const int id = tid + 512 * i;
            if (id < NKC) { const int row = id / KCH, c = id % KCH; const size_t kv = (size_t)(64 * t + row);
                if (K2 && c >= (DQK - 32) / 8) kreg[i] = *(const u32x4*)(Kp2 + kv * k2pitch + (c - (DQK - 32) / 8) * 8);
                else kreg[i] = *(const u32x4*)(K + kv * kpitch + c * 8); } }
#pragma unroll
        for (int i = 0; i < NVR; ++i) { const int id = tid + 512 * i; const int row = id / VCH, c = id % VCH;
            vreg[i] = *(const u32x4*)(V + (size_t)(64 * t + row) * vpitch + c * 8); }
    };
    auto lstore = [&](int b) {
        LAS unsigned char* kb = lds + b * BUF; LAS unsigned char* vb = kb + KBUF;
#pragma unroll
        for (int i = 0; i < NKR; ++i) { const int id = tid + 512 * i; if (id < NKC) { const int row = id / KCH, c = id % KCH; *(LAS u32x4*)(kb + row * KP + c * 16) = kreg[i]; } }
#pragma unroll
        for (int i = 0; i < NVR; ++i) { const int id = tid + 512 * i; const int row = id / VCH, c = id % VCH; *(LAS u32x4*)(vb + row * VP + c * 16) = vreg[i]; }
    };
    gload(0);
    bf16x8 qf[DQK / 16];
#pragma unroll
    for (int d0 = 0; d0 < DQK / 16; ++d0) {
        if (K2 && d0 >= (DQK - 32) / 16) qf[d0] = *(const bf16x8*)(Qp2 + (size_t)(32 * w + ql) * q2pitch + 16 * (d0 - (DQK - 32) / 16) + 8 * hi);
        else qf[d0] = *(const bf16x8*)(Q + (size_t)(32 * w + ql) * qpitch + 16 * d0 + 8 * hi); }
    f32x16 oacc[DV / 32];
#pragma unroll
    for (int i = 0; i < DV / 32; ++i)
#pragma unroll
        for (int r = 0; r < 16; ++r) oacc[i][r] = 0.f;
    float m_run = -INFINITY, l_run = 0.f;
    const int q0w = q0 + 32 * w, qg = q0w + ql;
    lstore(0);
    __syncthreads();
    const int vtoff = (4 * hi + ((lane & 15) >> 2)) * VP + (16 * ((lane >> 4) & 1) + 4 * (lane & 3)) * 2;
    for (int t = 0; t < NT; ++t) {
        if (t + 1 < NT) gload(t + 1);
        const bool active = !CAUSAL || (64 * t <= q0w + 31);
        if (active) {
            const LAS unsigned char* kb = lds + (t & 1) * BUF; const LAS unsigned char* vb = kb + KBUF;
            f32x16 s0, s1;
#pragma unroll
            for (int r = 0; r < 16; ++r) { s0[r] = 0.f; s1[r] = 0.f; }
            if constexpr (DQK <= 128)
            {
                constexpr int ND0 = DQK / 16, GB = (ND0 <= 6) ? ND0 : 2;
#pragma unroll
                for (int g0 = 0; g0 < ND0; g0 += GB) {
                    bf16x8 ka[GB], kc[GB];
#pragma unroll
                    for (int k = 0; k < GB; ++k) { ka[k] = *(const LAS bf16x8*)(kb + ql * KP + (16 * (g0 + k) + 8 * hi) * 2); kc[k] = *(const LAS bf16x8*)(kb + (32 + ql) * KP + (16 * (g0 + k) + 8 * hi) * 2); }
                    __builtin_amdgcn_sched_barrier(0);
#pragma unroll
                    for (int k = 0; k < GB; ++k) { s0 = __builtin_amdgcn_mfma_f32_32x32x16_bf16(ka[k], qf[g0 + k], s0, 0, 0, 0); s1 = __builtin_amdgcn_mfma_f32_32x32x16_bf16(kc[k], qf[g0 + k], s1, 0, 0, 0); }
                    __builtin_amdgcn_sched_barrier(0);
                }
            }
            else {
#pragma unroll
                for (int d0 = 0; d0 < DQK / 16; ++d0) {
                    const bf16x8 a0 = *(const LAS bf16x8*)(kb + ql * KP + (16 * d0 + 8 * hi) * 2);
                    const bf16x8 a1 = *(const LAS bf16x8*)(kb + (32 + ql) * KP + (16 * d0 + 8 * hi) * 2);
                    s0 = __builtin_amdgcn_mfma_f32_32x32x16_bf16(a0, qf[d0], s0, 0, 0, 0);
                    s1 = __builtin_amdgcn_mfma_f32_32x32x16_bf16(a1, qf[d0], s1, 0, 0, 0);
                }
            }
            if (CAUSAL && (64 * t + 63 > q0w)) {
#pragma unroll
                for (int r = 0; r < 16; ++r) { const int kv = 64 * t + crow(r, hi); if (kv > qg) s0[r] = -INFINITY; if (kv + 32 > qg) s1[r] = -INFINITY; }
            }
            float mx = s0[0];
#pragma unroll
            for (int r = 1; r < 16; ++r) mx = fmaxf(mx, s0[r]);
#pragma unroll
            for (int r = 0; r < 16; ++r) mx = fmaxf(mx, s1[r]);
            mx = fmaxf(mx, __shfl_xor(mx, 32));
            const float m_new = fmaxf(m_run, mx);
            const float alpha = __builtin_amdgcn_exp2f(m_run - m_new);
            m_run = m_new;
            float ps = 0.f;
#pragma unroll
            for (int r = 0; r < 16; ++r) { s0[r] = __builtin_amdgcn_exp2f(s0[r] - m_new); s1[r] = __builtin_amdgcn_exp2f(s1[r] - m_new); ps += s0[r] + s1[r]; }
            l_run = l_run * alpha + ps;
            if (__any(alpha != 1.f)) {
#pragma unroll
                for (int i = 0; i < DV / 32; ++i)
#pragma unroll
                    for (int r = 0; r < 16; ++r) oacc[i][r] *= alpha;
            }
            const bf16x8 p00 = pack8(s0, 0), p01 = pack8(s0, 8), p10 = pack8(s1, 0), p11 = pack8(s1, 8);
            if constexpr (DQK <= 128) {
#pragma unroll
            for (int i = 0; i < DV / 32; ++i) {
                const LAS unsigned char* vp = vb + vtoff + i * 64;
                bf16x8 va[4];
#pragma unroll
                for (int k = 0; k < 4; ++k) va[k] = join8(vtr(vp + (16 * k) * VP), vtr(vp + (16 * k + 8) * VP));
                __builtin_amdgcn_sched_barrier(0);
                oacc[i] = __builtin_amdgcn_mfma_f32_32x32x16_bf16(va[0], p00, oacc[i], 0, 0, 0);
                oacc[i] = __builtin_amdgcn_mfma_f32_32x32x16_bf16(va[1], p01, oacc[i], 0, 0, 0);
                oacc[i] = __builtin_amdgcn_mfma_f32_32x32x16_bf16(va[2], p10, oacc[i], 0, 0, 0);
                oacc[i] = __builtin_amdgcn_mfma_f32_32x32x16_bf16(va[3], p11, oacc[i], 0, 0, 0);
                __builtin_amdgcn_sched_barrier(0);
            }
            } else {
#pragma unroll
                for (int i = 0; i < DV / 32; ++i) {
                    const LAS unsigned char* vp = vb + vtoff + i * 64;
                    { const bf16x8 a = join8(vtr(vp + (0) * VP), vtr(vp + (8) * VP)); oacc[i] = __builtin_amdgcn_mfma_f32_32x32x16_bf16(a, p00, oacc[i], 0, 0, 0); }
                    { const bf16x8 a = join8(vtr(vp + (16) * VP), vtr(vp + (24) * VP)); oacc[i] = __builtin_amdgcn_mfma_f32_32x32x16_bf16(a, p01, oacc[i], 0, 0, 0); }
                    { const bf16x8 a = join8(vtr(vp + (32) * VP), vtr(vp + (40) * VP)); oacc[i] = __builtin_amdgcn_mfma_f32_32x32x16_bf16(a, p10, oacc[i], 0, 0, 0); }
                    { const bf16x8 a = join8(vtr(vp + (48) * VP), vtr(vp + (56) * VP)); oacc[i] = __builtin_amdgcn_mfma_f32_32x32x16_bf16(a, p11, oacc[i], 0, 0, 0); }
                }
            }
        }
        if (t + 1 < NT) lstore((t + 1) & 1);
        __syncthreads();
    }
    const float lt = l_run + __shfl_xor(l_run, 32); const float inv = 1.f / lt;
    bf16_t* orow = O + (size_t)(32 * w + ql) * opitch;
#pragma unroll
    for (int i = 0; i < DV / 32; ++i)
#pragma unroll
        for (int rr = 0; rr < 4; ++rr) { u32x2 o; o.x = cvt_pk_bf16(oacc[i][4 * rr] * inv, oacc[i][4 * rr + 1] * inv); o.y = cvt_pk_bf16(oacc[i][4 * rr + 2] * inv, oacc[i][4 * rr + 3] * inv);
            *(u32x2*)(orow + 32 * i + 8 * rr + 4 * hi) = o; }
}

constexpr int SS_BP = 272, SS_XP = 144;
constexpr int SS_B = 0, SS_C = 34816, SS_XD = 69632  , SS_XDD = 88064  , SS_ZI = 106496  , SS_SB = 124928, SS_CS = 142336, SS_DT = 142848;
constexpr int SS_ECS = SS_DT + 512, SS_CSD = SS_DT + 1024;
static_assert(SS_CSD + 512 <= LDS_BYTES - 64, "SSD LDS map");
#define LDS_BARRIER() do { asm volatile("s_waitcnt lgkmcnt(0)" ::: "memory"); __builtin_amdgcn_s_barrier(); asm volatile("" ::: "memory"); } while (0)
__device__ __forceinline__ void ssd_unit(const P& p, int L, LAS unsigned char* lds, int b, int h) {
    unsigned char* ws = p.ws; asm volatile("" : "+s"(ws));
    const bf16_t* XBC = (const bf16_t*)(ws + WS_XBC); const bf16_t* Z = (const bf16_t*)(ws + WS_Z); const float* DT = (const float*)(ws + WS_DT); bf16_t* YC = (bf16_t*)(ws + WS_YC);
    const int tid = fresh_tid(), lane = tid & 63, w = __builtin_amdgcn_readfirstlane(tid >> 6), ql = lane & 31, hi = lane >> 5;
    const int g = h >> 2;
    const float Ah = -__expf(p.a_log[L * 16 + h]); const float dsk = p.d_skip[L * 16 + h];
    const int lb = (w < 4) ? w : (7 - w), pb = (w >> 1) & 1;
    LAS float* CS = (LAS float*)(lds + SS_CS); LAS float* DTS = (LAS float*)(lds + SS_DT);
    f32x16 sacc;
#pragma unroll
    for (int r = 0; r < 16; ++r) sacc[r] = 0.f;
    for (int i = tid; i < 64 * SS_BP / 4; i += 512) ((LAS unsigned*)(lds + SS_SB))[i] = 0u;
    u32x4 breg[4], creg[4], xreg[2], zreg[2]; float dreg[2] = {0.f, 0.f};
    auto gload = [&](int c) {
        const size_t m0 = (size_t)b * SEQ + (size_t)c * 128;
#pragma unroll
        for (int i = 0; i < 4; ++i) { const int id = tid + 512 * i, row = id >> 4, c16 = id & 15;
            breg[i] = *(const u32x4*)(XBC + (m0 + row) * 2048 + 1024 + g * 128 + 8 * c16);
            creg[i] = *(const u32x4*)(XBC + (m0 + row) * 2048 + 1536 + g * 128 + 8 * c16); }
#pragma unroll
        for (int i = 0; i < 2; ++i) { const int id = tid + 512 * i, row = id >> 3, c8 = id & 7; xreg[i] = *(const u32x4*)(XBC + (m0 + row) * 2048 + h * 64 + 8 * c8); zreg[i] = *(const u32x4*)(Z + (m0 + row) * 1024 + h * 64 + 8 * c8); }
        if (w == 0) { dreg[0] = DT[(m0 + 2 * lane) * 16 + h]; dreg[1] = DT[(m0 + 2 * lane + 1) * 16 + h]; }
    };
    gload(0);
    const int troff = (((lane & 15) >> 2)) ;
    const int tcol = 16 * ((lane >> 4) & 1) + 4 * (lane & 3);
    for (int c = 0; c < 16; ++c) {
        const size_t m0 = (size_t)b * SEQ + (size_t)c * 128;
        if (w == 0) {
            const float v0 = dreg[0] * Ah, v1 = dreg[1] * Ah; float s = v0 + v1;
#pragma unroll
            for (int o = 1; o < 64; o <<= 1) { const float t = __shfl_up(s, o); if (lane >= o) s += t; }
            CS[2 * lane] = s - v1; CS[2 * lane + 1] = s; DTS[2 * lane] = dreg[0]; DTS[2 * lane + 1] = dreg[1];
            { LAS float* ECS = (LAS float*)(lds + SS_ECS); LAS float* CSD = (LAS float*)(lds + SS_CSD);
              ECS[2 * lane] = __expf(s - v1); ECS[2 * lane + 1] = __expf(s); CSD[2 * lane] = (s - v1) - __logf(dreg[0]); CSD[2 * lane + 1] = s - __logf(dreg[1]); }
        }
#pragma unroll
        for (int i = 0; i < 4; ++i) { const int id = tid + 512 * i, row = id >> 4, c16 = id & 15;
            *(LAS u32x4*)(lds + SS_B + row * SS_BP + c16 * 16) = breg[i]; *(LAS u32x4*)(lds + SS_C + row * SS_BP + c16 * 16) = creg[i]; }
        LDS_BARRIER();
        { const float cend = CS[127];
#pragma unroll
          for (int i = 0; i < 2; ++i) { const int id = tid + 512 * i, row = id >> 3, c8 = id & 7; const float e = DTS[row] * __expf(cend - CS[row]);
              const u32x4 v = xreg[i]; u32x4 o2;
              o2.x = cvt_pk_bf16(bflo(v.x) * e, bfhi(v.x) * e); o2.y = cvt_pk_bf16(bflo(v.y) * e, bfhi(v.y) * e); o2.z = cvt_pk_bf16(bflo(v.z) * e, bfhi(v.z) * e); o2.w = cvt_pk_bf16(bflo(v.w) * e, bfhi(v.w) * e);
              *(LAS u32x4*)(lds + SS_XD + row * SS_XP + c8 * 16) = v; *(LAS u32x4*)(lds + SS_XDD + row * SS_XP + c8 * 16) = o2; *(LAS u32x4*)(lds + SS_ZI + row * SS_XP + c8 * 16) = zreg[i]; } }
        LDS_BARRIER();
        if (c + 1 < 16) gload(c + 1);
        f32x16 yacc, oac;
#pragma unroll
        for (int r = 0; r < 16; ++r) { yacc[r] = 0.f; oac[r] = 0.f; }
        const float cs_l = CS[32 * lb + ql];
        bf16x8 cfr[8];
#pragma unroll
        for (int ks = 0; ks < 8; ++ks) cfr[ks] = *(const LAS bf16x8*)(lds + SS_C + (32 * lb + ql) * SS_BP + (16 * ks + 8 * hi) * 2);
        for (int sb = 0; sb <= lb; ++sb) {
            f32x16 gt;
#pragma unroll
            for (int r = 0; r < 16; ++r) gt[r] = 0.f;
#pragma unroll
            for (int hf = 0; hf < 2; ++hf) {
                bf16x8 fa[4];
#pragma unroll
                for (int k = 0; k < 4; ++k) fa[k] = *(const LAS bf16x8*)(lds + SS_B + (32 * sb + ql) * SS_BP + (16 * (4 * hf + k) + 8 * hi) * 2);
                __builtin_amdgcn_sched_barrier(0);
#pragma unroll
                for (int k = 0; k < 4; ++k) gt = __builtin_amdgcn_mfma_f32_32x32x16_bf16(fa[k], cfr[4 * hf + k], gt, 0, 0, 0);
                __builtin_amdgcn_sched_barrier(0);
            }
            const int lg = 32 * lb + ql;
#pragma unroll
            for (int r = 0; r < 16; ++r) { const int s = 32 * sb + crow(r, hi); const float e = __expf(cs_l - ((const LAS float*)(lds + SS_CSD))[s]); gt[r] = (s <= lg) ? gt[r] * e : 0.f; }
            const bf16x8 w0 = pack8(gt, 0), w1 = pack8(gt, 8);
            const LAS unsigned char* xp = lds + SS_XD + (32 * sb + 4 * hi + troff) * SS_XP + (32 * pb + tcol) * 2;
            { const bf16x8 bx = join8(vtr(xp), vtr(xp + 8 * SS_XP)); yacc = __builtin_amdgcn_mfma_f32_32x32x16_bf16(w0, bx, yacc, 0, 0, 0); }
            { const bf16x8 bx = join8(vtr(xp + 16 * SS_XP), vtr(xp + 24 * SS_XP)); yacc = __builtin_amdgcn_mfma_f32_32x32x16_bf16(w1, bx, yacc, 0, 0, 0); }
        }
#pragma unroll
        for (int hf = 0; hf < 2; ++hf) {
            bf16x8 fs[4];
#pragma unroll
            for (int k = 0; k < 4; ++k) fs[k] = *(const LAS bf16x8*)(lds + SS_SB + (32 * pb + ql) * SS_BP + (16 * (4 * hf + k) + 8 * hi) * 2);
            __builtin_amdgcn_sched_barrier(0);
#pragma unroll
            for (int k = 0; k < 4; ++k) oac = __builtin_amdgcn_mfma_f32_32x32x16_bf16(cfr[4 * hf + k], fs[k], oac, 0, 0, 0);
            __builtin_amdgcn_sched_barrier(0);
        }
#pragma unroll
        for (int r = 0; r < 16; ++r) { const int l = 32 * lb + crow(r, hi); const size_t m = m0 + l; const int col = h * 64 + 32 * pb + ql;
            const float xv = bf1(*(const LAS bf16_t*)(lds + SS_XD + l * SS_XP + (32 * pb + ql) * 2)); const float zv = bf1(*(const LAS bf16_t*)(lds + SS_ZI + l * SS_XP + (32 * pb + ql) * 2));
            const float y = yacc[r] + oac[r] * ((const LAS float*)(lds + SS_ECS))[l] + xv * dsk;
            YC[m * 2048 + col] = tobf(y * silu_f(zv)); }
        { const float dec = __expf(CS[127]);
#pragma unroll
          for (int r = 0; r < 16; ++r) sacc[r] *= dec;
#pragma unroll
          for (int hf = 0; hf < 2; ++hf) {
              bf16x8 fa[4], fb[4];
#pragma unroll
              for (int k = 0; k < 4; ++k) { const int st = 4 * hf + k;
                  const LAS unsigned char* ap = lds + SS_XDD + (16 * st + 8 * hi + troff) * SS_XP + (32 * pb + tcol) * 2;
                  const LAS unsigned char* bp = lds + SS_B + (16 * st + 8 * hi + troff) * SS_BP + (32 * lb + tcol) * 2;
                  fa[k] = join8(vtr(ap), vtr(ap + 4 * SS_XP)); fb[k] = join8(vtr(bp), vtr(bp + 4 * SS_BP)); }
              __builtin_amdgcn_sched_barrier(0);
#pragma unroll
              for (int k = 0; k < 4; ++k) sacc = __builtin_amdgcn_mfma_f32_32x32x16_bf16(fa[k], fb[k], sacc, 0, 0, 0);
              __builtin_amdgcn_sched_barrier(0);
          } }
        LDS_BARRIER();
#pragma unroll
        for (int r = 0; r < 16; ++r) *(LAS bf16_t*)(lds + SS_SB + (32 * pb + crow(r, hi)) * SS_BP + (32 * lb + ql) * 2) = tobf(sacc[r]);
    }
    __syncthreads();
}

#define XB_TMO      128
#define XB_XCNT(j)  (256  + 64 * (j))
#define XB_XSUB(j)  (1280 + 64 * (j))
#define XB_XGEN(j)  (2304 + 64 * (j))
#define XB_TOP      3328
#define XB_TOPGEN   3392
#define XCD_BAR_WORDS 3456
#define XB_SPIN_CAP (1u << 18)

__device__ __forceinline__ unsigned xb_ld(unsigned* p)              { return __hip_atomic_load(p, __ATOMIC_RELAXED, __HIP_MEMORY_SCOPE_AGENT); }
__device__ __forceinline__ unsigned xb_add(unsigned* p, unsigned v) { return __hip_atomic_fetch_add(p, v, __ATOMIC_RELAXED, __HIP_MEMORY_SCOPE_AGENT); }
__device__ __forceinline__ unsigned xb_xcc_id() { return (unsigned)__builtin_amdgcn_s_getreg((3 << 11) | 20) & 0xFu; }
#define XB_SPIN(cond, bar) do { unsigned _sp = 0; while (cond) { __builtin_amdgcn_s_sleep(1); \
    if ((++_sp & 255u) == 0u) { if (xb_ld(&(bar)[XB_TMO])) break; if (_sp > XB_SPIN_CAP) { atomicAdd(&(bar)[XB_TMO], 1u); break; } } } } while (0)

struct XcdBarrier {
    unsigned* bar; unsigned x;
    volatile LAS unsigned* st;
};

__device__ __forceinline__ XcdBarrier xcd_barrier_post(unsigned* bar, volatile LAS unsigned* st) {
    XcdBarrier b; b.bar = bar; b.x = xb_xcc_id(); b.st = st;
    if (threadIdx.x == 0) (void)xb_add(&bar[XB_XCNT(b.x)], 1u);
    return b;
}
__device__ __forceinline__ void xcd_barrier_complete(unsigned* bar, unsigned x, unsigned& nloc, unsigned& nx) {
    const unsigned G = gridDim.x * gridDim.y * gridDim.z;
    unsigned sum, cnt, mine, sp = 0u;
    for (;;) {
        sum = 0u; cnt = 0u; mine = 0u;
#pragma unroll
        for (unsigned j = 0; j < 16; ++j) { const unsigned c = xb_ld(&bar[XB_XCNT(j)]); sum += c; cnt += (c > 0u) ? 1u : 0u; mine = (j == x) ? c : mine; }
        if (sum == G) break;
        __builtin_amdgcn_s_sleep(1);
        if ((++sp & 255u) == 0u) { if (xb_ld(&bar[XB_TMO])) break; if (sp > XB_SPIN_CAP) { atomicAdd(&bar[XB_TMO], 1u); break; } }
    }
    nloc = mine > 0u ? mine : 1u; nx = cnt > 0u ? cnt : 1u;
}

__device__ __forceinline__ void xcd_barrier(const XcdBarrier& b) {
    asm volatile("s_waitcnt vmcnt(0)" ::: "memory");
    __syncthreads();
    if (threadIdx.x == 0) {
        unsigned* bar = b.bar; unsigned bx_ = b.x; asm volatile("" : "+s"(bar), "+s"(bx_));
        __builtin_amdgcn_s_waitcnt(0);
        unsigned nloc = b.st[0], nx = b.st[1];
        if (nloc == 0u) { xcd_barrier_complete(bar, bx_, nloc, nx); b.st[0] = nloc; b.st[1] = nx; }
        const unsigned old = xb_add(&bar[XB_XSUB(bx_)], 1u);
        const unsigned gen = old / nloc;
        if (old + 1u == (gen + 1u) * nloc) {
            __builtin_amdgcn_fence(__ATOMIC_RELEASE, "agent");
            asm volatile("s_waitcnt vmcnt(0)" ::: "memory");
            const unsigned og = xb_add(&bar[XB_TOP], 1u);
            const unsigned tg = og / nx;
            if (og + 1u == (tg + 1u) * nx) xb_add(&bar[XB_TOPGEN], 1u);
            else XB_SPIN(xb_ld(&bar[XB_TOPGEN]) == tg, bar);
            __builtin_amdgcn_fence(__ATOMIC_ACQUIRE, "agent");
            xb_add(&bar[XB_XGEN(bx_)], 1u);
            asm volatile("s_waitcnt vmcnt(0)" ::: "memory");
        } else {
            XB_SPIN(xb_ld(&bar[XB_XGEN(bx_)]) == gen, bar);
            __builtin_amdgcn_fence(__ATOMIC_ACQUIRE, "agent");
            asm volatile("s_waitcnt vmcnt(0)" ::: "memory");
        }
    }
    __syncthreads();
}

__device__ __forceinline__ void my_grid_sync(unsigned* bar, unsigned& gen) {
    asm volatile("s_waitcnt vmcnt(0) lgkmcnt(0)" ::: "memory");
    __syncthreads();
    gen += 1u;
    if (threadIdx.x == 0) {
        __builtin_amdgcn_fence(__ATOMIC_RELEASE, "agent");
        asm volatile("s_waitcnt vmcnt(0)" ::: "memory");
        __hip_atomic_fetch_add(bar, 1u, __ATOMIC_RELAXED, __HIP_MEMORY_SCOPE_AGENT);
        const unsigned target = gen * gridDim.x;
        while (__hip_atomic_load(bar, __ATOMIC_RELAXED, __HIP_MEMORY_SCOPE_AGENT) < target) __builtin_amdgcn_s_sleep(1);
        __builtin_amdgcn_fence(__ATOMIC_ACQUIRE, "agent");
        asm volatile("s_waitcnt vmcnt(0)" ::: "memory");
    }
    __syncthreads();
    asm volatile("buffer_inv sc1\n\ts_waitcnt vmcnt(0)" ::: "memory");
}
#ifdef DUP_SYNC
#define SYNC2() xcd_barrier(xbar)
#else
#define SYNC2() do {} while (0)
#endif
#define GRID_SYNC() do { xcd_barrier(xbar); SYNC2(); ws = p.ws; asm volatile("" : "+s"(ws)); RSS = (float*)(ws + WS_RSP); XB = (bf16_t*)(ws + WS_XB); } while (0)
__global__ void __launch_bounds__(512, 2) trunk_fwd(P p) {
    extern __shared__ __attribute__((aligned(16))) unsigned char lds_raw[];
    cg::grid_group grid = cg::this_grid();
    LAS unsigned char* lds = (LAS unsigned char*)lds_raw;
    const int tid = threadIdx.x, lane = tid & 63, wave = __builtin_amdgcn_readfirstlane(tid >> 6);
    const int G = gridDim.x, gw = blockIdx.x * 8 + wave, NGW = G * 8;
    LAS float* scr = (LAS float*)(lds + wave * 16384);
    const int vcu = (G % 8 == 0) ? ((int)blockIdx.x % 8) * (G / 8) + (int)blockIdx.x / 8 : (int)blockIdx.x;
    unsigned char* ws = p.ws; asm volatile("" : "+s"(ws));
    float* RSS = (float*)(ws + WS_RSP);
    bf16_t* XB = (bf16_t*)(ws + WS_XB);

    volatile LAS unsigned* bst = (volatile LAS unsigned*)(lds + (LDS_BYTES - 64));
    if (tid < 2) bst[tid] = 0u;
    __syncthreads();
    grid.sync();
    XcdBarrier xbar = xcd_barrier_post((unsigned*)(p.ws + WS_RSS), bst);
#ifndef SKIP_PRO
    prologue(p, scr, gw, NGW, lane);
#endif
    GRID_SYNC();
    { EpiRoute E{(bf16_t*)(ws + WS_KMVM), nullptr, nullptr, 8192, 0, 0, 1 << 30, 1 << 30, nullptr, 0.f, 1.f};
      run_gemm(lds, (const bf16_t*)(ws + WS_MEMN), (const bf16_t*)(ws + WS_WMKV), 2048, 8192, 1024, E); }

    for (int L = 0; L < DEPTH; ++L) {
        { EpiRoute E{(bf16_t*)(ws + WS_Z), (bf16_t*)(ws + WS_XBCPRE), (bf16_t*)(ws + WS_SM), 1024, 2048, 768, 4, 12, RSS, 1.f / 1024.f, 1.f};
          run_gemm(lds, XB, (const bf16_t*)(ws + WS_WIN), M, NIN, 1024, E); }
#ifdef DUP_G1
        { EpiRoute E{(bf16_t*)(ws + WS_Z), (bf16_t*)(ws + WS_XBCPRE), (bf16_t*)(ws + WS_SM), 1024, 2048, 768, 4, 12, RSS, 1.f / 1024.f, 1.f};
          run_gemm(lds, XB, (const bf16_t*)(ws + WS_WIN), M, NIN, 1024, E); }
#endif
        GRID_SYNC();
#ifndef SKIP_L2
        pass_l2(p, L, gw, NGW, lane);
#ifdef DUP_PASS
        pass_l2(p, L, gw, NGW, lane);
#endif
#endif
        GRID_SYNC();
#if defined(DBG_STOP) && DBG_STOP == 1
        { for (size_t i = (size_t)blockIdx.x * 512 + threadIdx.x; i < (size_t)M * 1024; i += (size_t)G * 512) { const size_t mm = i >> 10; const int cc = (int)(i & 1023); p.out[i] = bf1(((const bf16_t*)(ws + WS_XBC))[mm * 2048 + cc]) + bf1(((const bf16_t*)(ws + WS_XBC))[mm * 2048 + 1024 + cc]) + bf1(((const bf16_t*)(ws + WS_CQN))[mm * 384 + cc % 384]) + bf1(((const bf16_t*)(ws + WS_CKVN))[mm * 256 + cc % 256]) + bf1(((const bf16_t*)(ws + WS_KPE))[mm * 32 + cc % 32]) + ((const float*)(ws + WS_DT))[mm * 16 + cc % 16] + bf1(((const bf16_t*)(ws + WS_Z))[mm * 1024 + cc]); } return; }
#endif

#ifndef SKIP_SSD
        if (G >= 256) {
            if (blockIdx.x < 128) { const int su = ((int)blockIdx.x & 7) * 16 + ((int)blockIdx.x >> 3); ssd_unit(p, L, lds, su >> 4, su & 15); }
            else {
                { EpiRope E{(bf16_t*)(ws + WS_YC), (bf16_t*)(ws + WS_SM), (const float*)(ws + WS_COS), (const float*)(ws + WS_SIN), 0.10206207261596575f * LOG2E};
                  run_gemm_on(lds, (const bf16_t*)(ws + WS_CQN), (const bf16_t*)(ws + WS_WUQ), M, 1536, 384, E, 128, (int)blockIdx.x - 128); }
                { EpiRoute E{(bf16_t*)(ws + WS_KN), (bf16_t*)(ws + WS_VB), nullptr, 1024, 1024, 0, 4, 1 << 30, nullptr, 0.f, 1.f};
                  run_gemm_on(lds, (const bf16_t*)(ws + WS_CKVN), (const bf16_t*)(ws + WS_WUKV), M, 2048, 256, E, 128, (int)blockIdx.x - 128); }
                convert_layer(p, -1, -1, -1, L, scr, gw - 1024, NGW - 1024, lane); } }
        else { for (int u = blockIdx.x; u < NB * 16; u += G) ssd_unit(p, L, lds, u >> 4, u & 15);
               { EpiRope E{(bf16_t*)(ws + WS_YC), (bf16_t*)(ws + WS_SM), (const float*)(ws + WS_COS), (const float*)(ws + WS_SIN), 0.10206207261596575f * LOG2E};
                 run_gemm(lds, (const bf16_t*)(ws + WS_CQN), (const bf16_t*)(ws + WS_WUQ), M, 1536, 384, E); }
               { EpiRoute E{(bf16_t*)(ws + WS_KN), (bf16_t*)(ws + WS_VB), nullptr, 1024, 1024, 0, 4, 1 << 30, nullptr, 0.f, 1.f};
                 run_gemm(lds, (const bf16_t*)(ws + WS_CKVN), (const bf16_t*)(ws + WS_WUKV), M, 2048, 256, E); }
               convert_layer(p, -1, -1, -1, L, scr, gw, NGW, lane); }
#ifdef DUP_SSD
        for (int u = blockIdx.x; u < NB * 16; u += G) ssd_unit(p, L, lds, u >> 4, u & 15);
#endif
#endif
        GRID_SYNC();
#if defined(DBG_STOP) && DBG_STOP == 2
        { for (size_t i = (size_t)blockIdx.x * 512 + threadIdx.x; i < (size_t)M * 1024; i += (size_t)G * 512) { const size_t mm = i >> 10; const int cc = (int)(i & 1023); p.out[i] = bf1(((const bf16_t*)(ws + WS_YC))[mm * 2048 + cc]); } return; }
#endif

#ifndef SKIP_MLA
#ifdef DUP_MLA
        for (int rep_ = 0; rep_ < 2; ++rep_)
#endif
        { const int v = vcu;
          for (int uu = v; uu < 256; uu += G) { const int bh = uu >> 1, half = uu & 1, b = bh >> 4, h = bh & 15;
            for (int i = 0; i < 4; ++i) { const int qb = half ? ((i == 0) ? 1 : (i == 1) ? 6 : (i == 2) ? 2 : 5) : ((i == 0) ? 0 : (i == 1) ? 7 : (i == 2) ? 3 : 4);
                const size_t r0 = (size_t)b * SEQ;
                attn_unit<96, 64, true, true>(lds, (const bf16_t*)(ws + WS_YC) + (r0 + 256 * qb) * 2048 + 1024 + 64 * h, 2048, (const bf16_t*)(ws + WS_SM) + (r0 + 256 * qb) * 512 + 32 * h, 512,
                                              (const bf16_t*)(ws + WS_KN) + r0 * 1024 + 64 * h, 1024,
                                              (const bf16_t*)(ws + WS_KPE) + r0 * 32, 32, (const bf16_t*)(ws + WS_VB) + r0 * 1024 + 64 * h, 1024,
                                              (bf16_t*)(ws + WS_YC) + (r0 + 256 * qb) * 2048 + 1024 + 64 * h, 2048, 256 * qb, 4 * (qb + 1)); } } }
#endif
        GRID_SYNC();
#if defined(DBG_STOP) && DBG_STOP == 3
        { for (size_t i = (size_t)blockIdx.x * 512 + threadIdx.x; i < (size_t)M * 1024; i += (size_t)G * 512) { const size_t mm = i >> 10; const int cc = (int)(i & 1023); p.out[i] = bf1(((const bf16_t*)(ws + WS_YC))[mm * 2048 + 1024 + cc]); } return; }
#endif

#ifndef SKIP_YCN
        pass_ycnorm(p, gw, NGW, lane);
#endif
        convert_layer(p, L + 1, L + 1, L, -1, scr, gw, NGW, lane);
        GRID_SYNC();
        { EpiRes E{L == 0 ? p.x : p.out, p.out, XB, RSS + (size_t)16 * M};
          run_gemm(lds, (const bf16_t*)(ws + WS_YC), (const bf16_t*)(ws + WS_WOUT), M, 1024, 2048, E); }
        GRID_SYNC();
#if defined(DBG_STOP) && DBG_STOP == 4
        return;
#endif

#if defined(DBG_STOP) && DBG_STOP == 9
        { for (size_t i = (size_t)blockIdx.x * 512 + threadIdx.x; i < (size_t)M * 1024; i += (size_t)G * 512) { const size_t mm = i >> 10; const int cc = (int)(i & 1023); p.out[i] = bf1(XB[mm * 1024 + cc]); } return; }
#endif

#if defined(DBG_STOP) && DBG_STOP == 10
        { for (size_t i = (size_t)blockIdx.x * 512 + threadIdx.x; i < (size_t)M * 1024; i += (size_t)G * 512) { const size_t mm = i >> 10; const int cc = (int)(i & 1023); p.out[i] = (RSS + (size_t)16 * M)[(size_t)(cc & 3) * M * 4 + mm * 4 + ((cc >> 2) & 3)]; } return; }
#endif

        { EpiRoute E{(bf16_t*)(ws + WS_QM), nullptr, nullptr, 1024, 0, 0, 1 << 30, 1 << 30, RSS + (size_t)16 * M, 1.f / 1024.f, 0.0625f * LOG2E};
          run_gemm(lds, XB, (const bf16_t*)(ws + WS_WMQ), M, 1024, 1024, E); }
#ifdef DUP_G6
        { EpiRoute E{(bf16_t*)(ws + WS_QM), nullptr, nullptr, 1024, 0, 0, 1 << 30, 1 << 30, RSS + (size_t)16 * M, 1.f / 1024.f, 0.0625f * LOG2E};
          run_gemm(lds, XB, (const bf16_t*)(ws + WS_WMQ), M, 1024, 1024, E); }
#endif
        GRID_SYNC();
#if defined(DBG_STOP) && DBG_STOP == 7
        { for (size_t i = (size_t)blockIdx.x * 512 + threadIdx.x; i < (size_t)M * 1024; i += (size_t)G * 512) { const size_t mm = i >> 10; const int cc = (int)(i & 1023); p.out[i] = bf1(((const bf16_t*)(ws + WS_QM))[mm * 1024 + cc]); } return; }
#endif

#ifndef SKIP_MEM
        for (int uu = vcu; uu < 512; uu += G) { const int dh = uu & 1, qb = (uu >> 1) & 7, mh = (uu >> 4) & 3, b = uu >> 6;
            const bf16_t* KM = (const bf16_t*)(ws + WS_KMVM) + (size_t)(b * 256) * 8192 + L * 2048 + 256 * mh;
            attn_unit<256, 128, false, false>(lds, (const bf16_t*)(ws + WS_QM) + ((size_t)b * SEQ + 256 * qb) * 1024 + 256 * mh, 1024, nullptr, 0, KM, 8192, nullptr, 0,
                                              KM + 1024 + 128 * dh, 8192, (bf16_t*)(ws + WS_OM) + ((size_t)b * SEQ + 256 * qb) * 1024 + 256 * mh + 128 * dh, 1024, 0, 4); }
#endif
        GRID_SYNC();
#if defined(DBG_STOP) && DBG_STOP == 8
        { for (size_t i = (size_t)blockIdx.x * 512 + threadIdx.x; i < (size_t)M * 1024; i += (size_t)G * 512) { const size_t mm = i >> 10; const int cc = (int)(i & 1023); p.out[i] = bf1(((const bf16_t*)(ws + WS_OM))[mm * 1024 + cc]); } return; }
#endif

        { EpiRes E{p.out, p.out, XB, RSS + (size_t)32 * M};
          run_gemm(lds, (const bf16_t*)(ws + WS_OM), (const bf16_t*)(ws + WS_WMO), M, 1024, 1024, E); }
        GRID_SYNC();
#if defined(DBG_STOP) && DBG_STOP == 5
        return;
#endif

        { EpiGlu E{(bf16_t*)(ws + WS_ACT), RSS + (size_t)32 * M, p.ffn_conv_w + (size_t)L * 3 * 5632, p.ffn_conv_b + (size_t)L * 5632, (float*)(ws + WS_HALO), (float*)(ws + WS_PART), (LAS float*)(lds + 131072)};
          run_gemm(lds, XB, (const bf16_t*)(ws + WS_WUP), M, 5632, 1024, E); }
#ifdef DUP_G8
        { EpiGlu E{(bf16_t*)(ws + WS_ACT), RSS + (size_t)32 * M, p.ffn_conv_w + (size_t)L * 3 * 5632, p.ffn_conv_b + (size_t)L * 5632, (float*)(ws + WS_HALO), (float*)(ws + WS_PART), (LAS float*)(lds + 131072)};
          run_gemm(lds, XB, (const bf16_t*)(ws + WS_WUP), M, 5632, 1024, E); }
#endif
        GRID_SYNC();
        {
          const int nM_ = M / 256, nN_ = 4, nwg_ = nM_ * nN_;
          for (int i_ = 0; (long)i_ * G + (int)blockIdx.x < nwg_; ++i_) { int wg_ = i_ * G + (int)blockIdx.x;
              { const int q_ = nwg_ / 8, r_ = nwg_ % 8, xcd_ = wg_ % 8, off_ = wg_ / 8; wg_ = (xcd_ < r_ ? xcd_ * (q_ + 1) : r_ * (q_ + 1) + (xcd_ - r_) * q_) + off_; }
              const int nig_ = 8 * nN_, gid_ = wg_ / nig_, fm_ = gid_ * 8, gsz_ = (nM_ - fm_) < 8 ? (nM_ - fm_) : 8;
              ffn_fixup(p, L, fm_ + ((wg_ % nig_) % gsz_)); }
          EpiRes E{p.out, p.out, XB, RSS};
          run_gemm(lds, (const bf16_t*)(ws + WS_ACT), (const bf16_t*)(ws + ((L & 1) ? WS_WDN1 : WS_WDN0)), M, 1024, 2816, E); }
        GRID_SYNC();
#if defined(DBG_STOP) && DBG_STOP == 6
        return;
#endif
    }
#ifndef SKIP_FIN
    pass_final(p, gw, NGW, lane);
#endif
}

extern "C" void kernel_launch(void* const* d_in, const int* in_sizes, int n_in, void* d_out, int out_size, void* d_ws, size_t ws_size, hipStream_t stream) {
    static int grid = 0;
    if (grid == 0) {
        if (n_in != 29 || out_size != M * DM || ws_size < WS_END) { fprintf(stderr, "kernel_launch: unexpected shapes (n_in %d out %d ws %zu need %zu)\n", n_in, out_size, ws_size, (size_t)WS_END); grid = -1; return; }
        int dev = 0, cus = 0, per_cu = 0;
        hipGetDevice(&dev);
        hipDeviceGetAttribute(&cus, hipDeviceAttributeMultiprocessorCount, dev);
        hipFuncSetAttribute((const void*)trunk_fwd, hipFuncAttributeMaxDynamicSharedMemorySize, LDS_BYTES);
        hipOccupancyMaxActiveBlocksPerMultiprocessor(&per_cu, (const void*)trunk_fwd, 512, LDS_BYTES);
        if (per_cu < 1) fprintf(stderr, "kernel_launch: occupancy query reports %d\n", per_cu);
        (void)hipGetLastError();
        grid = cus;
    }
    if (grid < 0) return;
    (void)hipMemsetAsync((char*)d_ws + WS_RSS, 0, 16384, stream);
    P a{};
    const void** pp = (const void**)&a;
    for (int i = 0; i < 29; ++i) pp[i] = d_in[i];
    a.out = (float*)d_out; a.ws = (unsigned char*)d_ws;
    void* args[] = {&a};
    hipError_t e = hipLaunchCooperativeKernel((const void*)trunk_fwd, dim3(grid), dim3(512), args, LDS_BYTES, stream);
    if (e != hipSuccess) fprintf(stderr, "cooperative launch failed: %s (grid %d)\n", hipGetErrorString(e), grid);
}
```

```cpp
#include <hip/hip_runtime.h>
#include <cstdio>
#include <cstdint>
namespace pg8 {
#define PG8_LAS __attribute__((address_space(3)))
typedef unsigned short bf16_t;
typedef short bf16x8 __attribute__((ext_vector_type(8)));
typedef float f32x4 __attribute__((ext_vector_type(4)));
typedef unsigned u32x4 __attribute__((ext_vector_type(4)));
constexpr int BM = 256, BK = 64, HALF = 128, HTB = HALF * BK * 2  , STAGE_BYTES = 8 * HTB, NXCD = 8, WGM = 8;

__host__ __device__ __forceinline__ int lds_byte(int r, int c) { const int st = (r >> 4) * 2 + (c >> 5), rr = r & 15, cc = c & 31, ob = rr * 64 + cc * 2; return st * 1024 + (ob ^ (((ob >> 9) & 1) << 5)); }
__host__ __device__ __forceinline__ void stage_rc(int b, int& R, int& C) { const int st = b / 1024, sb = b % 1024, swz = sb ^ (((sb >> 9) & 1) << 5); R = (st >> 1) * 16 + swz / 64; C = (st & 1) * 32 + (swz % 64) / 2; }
__host__ __device__ __forceinline__ int perm32(int rho) { const int n = rho >> 4, i = rho & 15; return 8 * (i >> 2) + 4 * n + (i & 3); }

struct Unit { int pm, pn; };
struct Gemm { const bf16_t* A; const bf16_t* Bt; int M, N, K; };

struct StaticOrder {
    int nM, nN, nwg, G, c;
    __host__ __device__ void init(int M, int N, int G_, int c_) { nM = M / BM; nN = N / BM; nwg = nM * nN; G = G_; c = c_; }
    __host__ __device__ bool next(int i, Unit& u) const {
        const long L = (long)i * G + c; if (L >= nwg) return false;
        int wgid = (int)L; { const int q = nwg / NXCD, r = nwg % NXCD, xcd = wgid % NXCD, off = wgid / NXCD; wgid = (xcd < r ? xcd * (q + 1) : r * (q + 1) + (xcd - r) * q) + off; }
        const int nig = WGM * nN, gid = wgid / nig, fm = gid * WGM, gsz = (nM - fm) < WGM ? (nM - fm) : WGM;
        u.pm = fm + ((wgid % nig) % gsz); u.pn = (wgid % nig) / gsz; return true;
    }
    __device__ __forceinline__ void a_ready(const Unit&) const {}
    __device__ __forceinline__ void done(const Unit&) const {}
};

__device__ __forceinline__ unsigned cvt_pk_bf16(float lo, float hi) { unsigned r; asm volatile("v_cvt_pk_bf16_f32 %0, %1, %2" : "=v"(r) : "v"(lo), "v"(hi)); return r; }
typedef float f32x2 __attribute__((ext_vector_type(2)));
__device__ __forceinline__ f32x2 gelu_pk(f32x2 v) {
    const f32x2 av = __builtin_elementwise_abs(v), d = av * 0.2316418882f + 1.0f;
    f32x2 t; t.x = __builtin_amdgcn_rcpf(d.x); t.y = __builtin_amdgcn_rcpf(d.y);
    f32x2 q = t * 0.5307027145f + (-0.7265760135f); q = q * t + 0.7107068705f; q = q * t + (-0.142248368f); q = q * t + 0.127414796f; q = q * t;
    const f32x2 s = (v * v) * (-0.72134752044f);
    f32x2 e; e.x = __builtin_amdgcn_exp2f(s.x); e.y = __builtin_amdgcn_exp2f(s.y);
    const f32x2 m = v * (q * e), r = v - m;
    f32x2 o; o.x = v.x < 0.f ? m.x : r.x; o.y = v.y < 0.f ? m.y : r.y; return o;
}

template <int ACT  > struct EpiBf16 {
    static constexpr bool PERM = true, AFTER_DRAIN = false; static_assert(ACT == 0 || ACT == 1, "EpiBf16: ACT is 0 (none) or 1 (gelu_pk)");
    bf16_t* O; int ldc; const float* bias; int split_cols; size_t split_stride; float scale0;
    __device__ __forceinline__ void operator()(const f32x4 (&acc)[2][2][4][2], const Unit& u, int wr, int wc, int fr, int fq) const {
        const int row0 = u.pm * BM + wr * 64 + fr; int colt = u.pn * BM; bf16_t* base = O;
        float sc = 1.f; if (split_cols) { const int t = colt / split_cols; base += (size_t)t * split_stride; colt -= t * split_cols; if (t == 0) sc = scale0; }
        const int col0 = colt + wc * 32 + 8 * fq, bcol0 = u.pn * BM + wc * 32 + 8 * fq;
        f32x4 bv[2][2];
#pragma unroll
        for (int bj = 0; bj < 2; ++bj)
#pragma unroll
            for (int n = 0; n < 2; ++n) bv[bj][n] = bias ? *(const f32x4*)(bias + bcol0 + bj * HALF + 4 * n) : (f32x4){0.f, 0.f, 0.f, 0.f};
#pragma unroll
        for (int ai = 0; ai < 2; ++ai)
#pragma unroll
            for (int m = 0; m < 4; ++m) { bf16_t* rowp = base + (size_t)(row0 + ai * HALF + m * 16) * ldc + col0;
#pragma unroll
                for (int bj = 0; bj < 2; ++bj) { f32x4 v0 = acc[ai][bj][m][0] + bv[bj][0], v1 = acc[ai][bj][m][1] + bv[bj][1];
                    if (ACT == 1) { f32x2 a = gelu_pk((f32x2){v0[0], v0[1]}), b = gelu_pk((f32x2){v0[2], v0[3]}), c = gelu_pk((f32x2){v1[0], v1[1]}), d = gelu_pk((f32x2){v1[2], v1[3]});
                        v0 = (f32x4){a.x, a.y, b.x, b.y}; v1 = (f32x4){c.x, c.y, d.x, d.y}; }
                    v0 = v0 * sc; v1 = v1 * sc; u32x4 w; w.x = cvt_pk_bf16(v0[0], v0[1]); w.y = cvt_pk_bf16(v0[2], v0[3]); w.z = cvt_pk_bf16(v1[0], v1[1]); w.w = cvt_pk_bf16(v1[2], v1[3]);
                    *(u32x4*)(rowp + bj * HALF) = w; } }
    }
};

struct PanelStats {
    unsigned* xbuf;
    unsigned* cnt;
    unsigned* tmo;
    int ntn; float eps;
    unsigned code;
    __device__ __forceinline__ bool run(const f32x4 (&v)[2][2][4][2], const Unit& u, int wr, int wc, int fr, int fq, PG8_LAS unsigned char* lds, int wid, int lane) const {
        typedef float f32x2v __attribute__((ext_vector_type(2)));
        PG8_LAS f32x2v* P = (PG8_LAS f32x2v*)lds;
        PG8_LAS f32x2v* S = (PG8_LAS f32x2v*)(lds + 8192);
        PG8_LAS unsigned* flag = (PG8_LAS unsigned*)(lds + 8192 + 2048);
#pragma unroll
        for (int ai = 0; ai < 2; ++ai)
#pragma unroll
            for (int m = 0; m < 4; ++m) {
                float s = 0.f;
#pragma unroll
                for (int bj = 0; bj < 2; ++bj)
#pragma unroll
                    for (int n = 0; n < 2; ++n) { const f32x4 x = v[ai][bj][m][n]; s += (x[0] + x[1]) + (x[2] + x[3]); }
                s += __shfl_xor(s, 16); s += __shfl_xor(s, 32);
                const float mw = s * (1.0f / 64.0f); float q = 0.f;
#pragma unroll
                for (int bj = 0; bj < 2; ++bj)
#pragma unroll
                    for (int n = 0; n < 2; ++n) { const f32x4 d = v[ai][bj][m][n] - mw; q += (d[0] * d[0] + d[1] * d[1]) + (d[2] * d[2] + d[3] * d[3]); }
                q += __shfl_xor(q, 16); q += __shfl_xor(q, 32);
                if (fq == 0) P[(ai * HALF + wr * 64 + m * 16 + fr) * 4 + wc] = (f32x2v){mw, q};
            }
        asm volatile("s_waitcnt lgkmcnt(0)" ::: "memory"); __builtin_amdgcn_s_barrier(); asm volatile("" ::: "memory");
#if defined(BROKEN_EXCHANGE_NO_WAIT)
#warning BROKEN CONTROL BUILD: the row-statistics exchange does not wait; results are wrong by design
        if (blockIdx.x >= 64) { const long long t0_ = clock64(); while (clock64() - t0_ < 60000) __builtin_amdgcn_s_sleep(8); }
#endif
        const int row = wid * 32 + (lane & 31);
        if (lane < 32) {
            const f32x2v a = P[row * 4 + 0], b = P[row * 4 + 1], c = P[row * 4 + 2], d = P[row * 4 + 3];
            const float mt = (a.x + b.x + c.x + d.x) * 0.25f;
            const float da = a.x - mt, db = b.x - mt, dc = c.x - mt, dd = d.x - mt;
            const float m2 = (a.y + b.y) + (c.y + d.y) + 64.0f * ((da * da + db * db) + (dc * dc + dd * dd));
            unsigned long long* slot = (unsigned long long*)xbuf + ((size_t)(u.pm * BM + row) * 4 + u.pn);
            __hip_atomic_store(slot, ((unsigned long long)__float_as_uint(m2) << 32) | __float_as_uint(mt), __ATOMIC_RELAXED, __HIP_MEMORY_SCOPE_AGENT);
        }
        asm volatile("s_waitcnt vmcnt(0)" ::: "memory");
        if (lane == 0) __hip_atomic_fetch_add(cnt + 64 * u.pm, 1u, __ATOMIC_RELAXED, __HIP_MEMORY_SCOPE_AGENT);
        if (wid == 0) {
            bool dead = false; const unsigned long long t0 = __builtin_amdgcn_s_memrealtime(); const unsigned want = 8u * (unsigned)ntn;
            for (;;) {
#if defined(BROKEN_EXCHANGE_NO_WAIT)
                break;
#endif
                if ((unsigned)__builtin_amdgcn_readfirstlane(__hip_atomic_load(cnt + 64 * u.pm, __ATOMIC_RELAXED, __HIP_MEMORY_SCOPE_AGENT)) >= want) break;
                if (__builtin_amdgcn_s_memrealtime() - t0 > 2000000ull) {
                    if (lane == 0) { unsigned expect = 0u; __hip_atomic_compare_exchange_strong(tmo + 1, &expect, code | (unsigned)(u.pm & 0xff), __ATOMIC_RELAXED, __ATOMIC_RELAXED, __HIP_MEMORY_SCOPE_AGENT);
                                     __hip_atomic_store(tmo, 1u, __ATOMIC_RELAXED, __HIP_MEMORY_SCOPE_AGENT); }
                    dead = true; break; }
                __builtin_amdgcn_s_sleep(2);
            }
            __builtin_amdgcn_fence(__ATOMIC_ACQUIRE, "agent");
            if (lane == 0) flag[0] = dead ? 1u : 0u;
        }
        asm volatile("s_waitcnt vmcnt(0) lgkmcnt(0)" ::: "memory"); __builtin_amdgcn_s_barrier(); asm volatile("" ::: "memory");
        const bool bad = flag[0] != 0u;
        if (lane < 32) {
            const unsigned long long* slot = (const unsigned long long*)xbuf + (size_t)(u.pm * BM + row) * 4; float mt[4], m2[4]; float ms = 0.f;
#pragma unroll
            for (int t = 0; t < 4; ++t) { if (t < ntn) { const unsigned long long w = __hip_atomic_load(slot + t, __ATOMIC_RELAXED, __HIP_MEMORY_SCOPE_AGENT); mt[t] = __uint_as_float((unsigned)w); m2[t] = __uint_as_float((unsigned)(w >> 32)); } else { mt[t] = 0.f; m2[t] = 0.f; } ms += mt[t]; }
            const float mean = ms / (float)ntn; float q = 0.f;
#pragma unroll
            for (int t = 0; t < 4; ++t) if (t < ntn) { const float dm = mt[t] - mean; q += m2[t] + 256.0f * dm * dm; }
            S[row] = (f32x2v){mean, 1.0f / sqrtf(q / (256.0f * (float)ntn) + eps)};
        }
        asm volatile("s_waitcnt lgkmcnt(0)" ::: "memory"); __builtin_amdgcn_s_barrier(); asm volatile("" ::: "memory");
        return bad;
    }
};
struct EpiLnRes {
    static constexpr bool PERM = false, AFTER_DRAIN = true;
    const float* base; float* out; int ldc; const float* bias; PanelStats st; unsigned poison;
    __device__ __forceinline__ void fused(f32x4 (&acc)[2][2][4][2], const Unit& u, int wr, int wc, int fr, int fq, PG8_LAS unsigned char* lds, int wid, int lane) const {
        typedef float f32x2v __attribute__((ext_vector_type(2)));
        const PG8_LAS f32x2v* S = (const PG8_LAS f32x2v*)(lds + 8192);
        const int col0 = u.pn * BM + wc * 32 + 4 * fq;
#pragma unroll
        for (int bj = 0; bj < 2; ++bj)
#pragma unroll
            for (int n = 0; n < 2; ++n) { const f32x4 bv = bias ? *(const f32x4*)(bias + col0 + bj * HALF + n * 16) : (f32x4){0.f, 0.f, 0.f, 0.f};
#pragma unroll
                for (int ai = 0; ai < 2; ++ai)
#pragma unroll
                    for (int m = 0; m < 4; ++m) acc[ai][bj][m][n] += bv; }
        f32x4 pre[4][2][2];
#pragma unroll
        for (int m = 0; m < 4; ++m) { const size_t off = (size_t)(u.pm * BM + wr * 64 + m * 16 + fr) * ldc + col0;
#pragma unroll
            for (int bj = 0; bj < 2; ++bj)
#pragma unroll
                for (int n = 0; n < 2; ++n) pre[m][bj][n] = *(const f32x4*)(base + off + bj * HALF + n * 16); }
        const bool bad = st.run(acc, u, wr, wc, fr, fq, lds, wid, lane) || poison != 0u;
        const float qnan = __builtin_nanf("");
#pragma unroll
        for (int ai = 0; ai < 2; ++ai)
#pragma unroll
            for (int m = 0; m < 4; ++m) { const int r = ai * HALF + wr * 64 + m * 16 + fr; const f32x2v sr = S[r]; const size_t off = (size_t)(u.pm * BM + r) * ldc + col0;
#pragma unroll
                for (int bj = 0; bj < 2; ++bj)
#pragma unroll
                    for (int n = 0; n < 2; ++n) { const f32x4 bs = ai == 0 ? pre[m][bj][n] : *(const f32x4*)(base + off + bj * HALF + n * 16); f32x4 o = bs + (acc[ai][bj][m][n] - sr.x) * sr.y;
                        if (bad) o = (f32x4){qnan, qnan, qnan, qnan}; *(f32x4*)(out + off + bj * HALF + n * 16) = o; }
                if (m & 1) asm volatile("" ::: "memory"); }
    }
};
struct EpiLnResLn {
    static constexpr bool PERM = false, AFTER_DRAIN = true;
    const float* base; float* out; bf16_t* xn; int ldc; const float* bias; PanelStats st1, st2; unsigned poison;
    __device__ __forceinline__ void fused(f32x4 (&acc)[2][2][4][2], const Unit& u, int wr, int wc, int fr, int fq, PG8_LAS unsigned char* lds, int wid, int lane) const {
        typedef float f32x2v __attribute__((ext_vector_type(2))); typedef unsigned u32x2v __attribute__((ext_vector_type(2)));
        const PG8_LAS f32x2v* S = (const PG8_LAS f32x2v*)(lds + 8192);
        const int col0 = u.pn * BM + wc * 32 + 4 * fq;
#pragma unroll
        for (int bj = 0; bj < 2; ++bj)
#pragma unroll
            for (int n = 0; n < 2; ++n) { const f32x4 bv = bias ? *(const f32x4*)(bias + col0 + bj * HALF + n * 16) : (f32x4){0.f, 0.f, 0.f, 0.f};
#pragma unroll
                for (int ai = 0; ai < 2; ++ai)
#pragma unroll
                    for (int m = 0; m < 4; ++m) acc[ai][bj][m][n] += bv; }
        bool bad = st1.run(acc, u, wr, wc, fr, fq, lds, wid, lane) || poison != 0u;
        const float qnan = __builtin_nanf("");
#pragma unroll
        for (int ai = 0; ai < 2; ++ai)
#pragma unroll
            for (int m = 0; m < 4; ++m) { const int r = ai * HALF + wr * 64 + m * 16 + fr; const f32x2v sr = S[r]; const size_t off = (size_t)(u.pm * BM + r) * ldc + col0;
#pragma unroll
                for (int bj = 0; bj < 2; ++bj)
#pragma unroll
                    for (int n = 0; n < 2; ++n) { const f32x4 bs = *(const f32x4*)(base + off + bj * HALF + n * 16); acc[ai][bj][m][n] = bs + (acc[ai][bj][m][n] - sr.x) * sr.y; }
                asm volatile("" : "+v"(acc[ai][0][m][0]), "+v"(acc[ai][0][m][1]), "+v"(acc[ai][1][m][0]), "+v"(acc[ai][1][m][1]));
                if (m & 1) asm volatile("" ::: "memory"); }
        const bool bad1 = bad;
        bad = st2.run(acc, u, wr, wc, fr, fq, lds, wid, lane) || bad;
#pragma unroll
        for (int ai = 0; ai < 2; ++ai)
#pragma unroll
            for (int m = 0; m < 4; ++m) { const int r = ai * HALF + wr * 64 + m * 16 + fr; const f32x2v sr = S[r]; const size_t off = (size_t)(u.pm * BM + r) * ldc + col0;
#pragma unroll
                for (int bj = 0; bj < 2; ++bj)
#pragma unroll
                    for (int n = 0; n < 2; ++n) { const f32x4 x1 = acc[ai][bj][m][n]; *(f32x4*)(out + off + bj * HALF + n * 16) = bad1 ? (f32x4){qnan, qnan, qnan, qnan} : x1;
                        const f32x4 o = (x1 - sr.x) * sr.y; u32x2v w; w.x = cvt_pk_bf16(o[0], o[1]); w.y = cvt_pk_bf16(o[2], o[3]);
                        if (bad) { w.x = 0x7fc07fc0u; w.y = 0x7fc07fc0u; } *(u32x2v*)(xn + off + bj * HALF + n * 16) = w; }
                asm volatile("" ::: "memory"); }
    }
};

template <class Epi, class Sched, bool ALIGN_EPI = false, bool SP2 = false>
__device__ __forceinline__ void gemm_phase(PG8_LAS unsigned char* lds, const Gemm g, const Sched& S, const Epi& E) {
    int tid_ = threadIdx.x; asm volatile("" : "+v"(tid_));
    const int tid = tid_, wid = __builtin_amdgcn_readfirstlane(tid >> 6), lane = tid & 63, wr = wid >> 2, wc = wid & 3, fr = lane & 15, fq = lane >> 4;
    const int K = g.K, nt = K / BK;
    unsigned voffA[2], voffB[2];
#pragma unroll
    for (int i = 0; i < 2; ++i) { int R, C; stage_rc(tid * 16 + i * 8192, R, C); const int Rb = Epi::PERM ? ((R & ~31) + perm32(R & 31)) : R;
        voffA[i] = (unsigned)(R * K + C) * 2u; voffB[i] = (unsigned)(Rb * K + C) * 2u; }
    const size_t kstep = (size_t)(BK * 2);
    const size_t hstep = (size_t)HALF * K * 2;
    const size_t tstep = 2 * hstep;
    const unsigned ldsw = (unsigned)wid * 1024u;
    const int aoff = lds_byte(wr * 64 + fr, fq * 8), boff = lds_byte(wc * 32 + fr, fq * 8);
#define PG8_SA(b, h) (((b) * 2 + (h)) * HTB)
#define PG8_SB(b, h) ((4 + (b) * 2 + (h)) * HTB)
#define PG8_STAGE(bufoff, gbase, voff) do { _Pragma("unroll") for (int _i = 0; _i < 2; ++_i) \
        __builtin_amdgcn_global_load_lds((const unsigned*)((const char*)(gbase) + (voff)[_i]), (PG8_LAS unsigned*)(lds + (bufoff) + ldsw + _i * 8192), 16, 0, 0); } while (0)
#define PG8_LDA(dst, b, h) do { _Pragma("unroll") for (int m = 0; m < 4; ++m) _Pragma("unroll") for (int k = 0; k < 2; ++k) dst[m][k] = *(const PG8_LAS bf16x8*)(lds + PG8_SA(b, h) + aoff + m * 2048 + k * 1024); } while (0)
#define PG8_LDB(dst, b, h) do { _Pragma("unroll") for (int n = 0; n < 2; ++n) _Pragma("unroll") for (int k = 0; k < 2; ++k) dst[n][k] = *(const PG8_LAS bf16x8*)(lds + PG8_SB(b, h) + boff + n * 2048 + k * 1024); } while (0)
#define PG8_MMA(ai, bj, At, Bt) do { __builtin_amdgcn_s_setprio(1); _Pragma("unroll") for (int m = 0; m < 4; ++m) _Pragma("unroll") for (int n = 0; n < 2; ++n) _Pragma("unroll") for (int k = 0; k < 2; ++k) \
        acc[ai][bj][m][n] = __builtin_amdgcn_mfma_f32_16x16x32_bf16(Bt[n][k], At[m][k], acc[ai][bj][m][n], 0, 0, 0); __builtin_amdgcn_s_setprio(0); } while (0)
#define PG8_WAIT_V(n) asm volatile("s_waitcnt vmcnt(" #n ")" ::: "memory")
#define PG8_WAIT_L(n) asm volatile("s_waitcnt lgkmcnt(" #n ")" ::: "memory")
#define PG8_BAR __builtin_amdgcn_s_barrier()
#define PG8_SCHED __builtin_amdgcn_sched_barrier(0)
    Unit cur, nxt; int ui = 0;
    if (!S.next(0, cur)) return;
    f32x4 acc[2][2][4][2];
#pragma unroll
    for (int a = 0; a < 2; ++a)
#pragma unroll
        for (int b = 0; b < 2; ++b)
#pragma unroll
            for (int m = 0; m < 4; ++m)
#pragma unroll
                for (int n = 0; n < 2; ++n) acc[a][b][m][n] = (f32x4){0.f, 0.f, 0.f, 0.f};
    bf16x8 At[4][2], B0[2][2], B1[2][2];
    const char* cA = (const char*)g.A + (size_t)cur.pm * tstep; const char* cB = (const char*)g.Bt + (size_t)cur.pn * tstep;
    S.a_ready(cur);
    if constexpr (SP2) {
        PG8_STAGE(PG8_SB(0, 0), cB, voffB); PG8_STAGE(PG8_SB(0, 1), cB + hstep, voffB); PG8_STAGE(PG8_SA(0, 0), cA, voffA); PG8_STAGE(PG8_SA(0, 1), cA + hstep, voffA);
        if (wr == 1) PG8_BAR;
        PG8_WAIT_V(2); PG8_BAR;
        PG8_STAGE(PG8_SB(1, 0), cB + kstep, voffB); PG8_STAGE(PG8_SA(1, 0), cA + kstep, voffA); PG8_STAGE(PG8_SB(1, 1), cB + hstep + kstep, voffB);
        PG8_WAIT_V(6); PG8_BAR;
    } else {
        PG8_STAGE(PG8_SB(0, 0), cB, voffB); PG8_STAGE(PG8_SA(0, 0), cA, voffA); PG8_STAGE(PG8_SB(0, 1), cB + hstep, voffB); PG8_STAGE(PG8_SA(0, 1), cA + hstep, voffA);
        if (wr == 1) PG8_BAR;
        PG8_WAIT_V(4); PG8_BAR;
        PG8_STAGE(PG8_SB(1, 0), cB + kstep, voffB); PG8_STAGE(PG8_SA(1, 0), cA + kstep, voffA); PG8_STAGE(PG8_SB(1, 1), cB + hstep + kstep, voffB);
        PG8_WAIT_V(6); PG8_BAR;
    }
    for (;;) {
        const bool has_next = S.next(ui + 1, nxt);
        const char* nA = has_next ? (const char*)g.A + (size_t)nxt.pm * tstep : cA; const char* nB = has_next ? (const char*)g.Bt + (size_t)nxt.pn * tstep : cB;
        for (int t = 0; t < nt; t += 2) {
            const bool last = (t == nt - 2);
            const char* a1 = cA + (size_t)(t + 1) * kstep;
            const char* a2 = last ? nA : cA + (size_t)(t + 2) * kstep; const char* b2 = last ? nB : cB + (size_t)(t + 2) * kstep;
            const char* a3 = a2 + kstep; const char* b3 = b2 + kstep;
            if (last && has_next) S.a_ready(nxt);
            if constexpr (SP2) {
            PG8_LDB(B0, 0, 0); PG8_LDB(B1, 0, 1); PG8_SCHED; PG8_LDA(At, 0, 0); PG8_STAGE(PG8_SA(1, 1), a1 + hstep, voffA);
            PG8_WAIT_V(8); PG8_WAIT_L(0); PG8_BAR; PG8_MMA(0, 0, At, B0); PG8_MMA(0, 1, At, B1); PG8_BAR; PG8_SCHED;
            PG8_LDA(At, 0, 1); PG8_STAGE(PG8_SB(0, 0), b2, voffB); PG8_STAGE(PG8_SB(0, 1), b2 + hstep, voffB); PG8_STAGE(PG8_SA(0, 0), a2, voffA);
            PG8_WAIT_V(8); PG8_WAIT_L(0); PG8_BAR; PG8_MMA(1, 0, At, B0); PG8_MMA(1, 1, At, B1); PG8_BAR; PG8_SCHED;
            PG8_LDB(B0, 1, 0); PG8_LDB(B1, 1, 1); PG8_SCHED; PG8_LDA(At, 1, 0); PG8_STAGE(PG8_SA(0, 1), a2 + hstep, voffA);
            PG8_WAIT_V(8); PG8_WAIT_L(0); PG8_BAR; PG8_MMA(0, 0, At, B0); PG8_MMA(0, 1, At, B1); PG8_BAR; PG8_SCHED;
            PG8_LDA(At, 1, 1); PG8_STAGE(PG8_SB(1, 0), b3, voffB); PG8_STAGE(PG8_SB(1, 1), b3 + hstep, voffB); PG8_STAGE(PG8_SA(1, 0), a3, voffA);
            PG8_WAIT_V(8); PG8_WAIT_L(0); PG8_BAR; PG8_MMA(1, 0, At, B0); PG8_MMA(1, 1, At, B1); PG8_BAR; PG8_SCHED;
            } else {
            PG8_LDB(B0, 0, 0); PG8_SCHED; PG8_LDA(At, 0, 0); PG8_STAGE(PG8_SA(1, 1), a1 + hstep, voffA);
            PG8_WAIT_L(8); PG8_BAR; PG8_WAIT_L(0); PG8_MMA(0, 0, At, B0); PG8_BAR; PG8_SCHED;
            PG8_LDB(B1, 0, 1); PG8_STAGE(PG8_SB(0, 0), b2, voffB);
            PG8_BAR; PG8_WAIT_L(0); PG8_MMA(0, 1, At, B1); PG8_BAR;
            PG8_LDA(At, 0, 1); PG8_STAGE(PG8_SA(0, 0), a2, voffA);
            PG8_BAR; PG8_WAIT_L(0); PG8_MMA(1, 0, At, B0); PG8_BAR; PG8_SCHED;
            PG8_STAGE(PG8_SB(0, 1), b2 + hstep, voffB);
            PG8_WAIT_V(6); PG8_BAR; PG8_MMA(1, 1, At, B1); PG8_BAR;
            PG8_LDB(B0, 1, 0); PG8_SCHED; PG8_LDA(At, 1, 0); PG8_STAGE(PG8_SA(0, 1), a2 + hstep, voffA);
            PG8_WAIT_L(8); PG8_BAR; PG8_WAIT_L(0); PG8_MMA(0, 0, At, B0); PG8_BAR; PG8_SCHED;
            PG8_LDB(B1, 1, 1); PG8_STAGE(PG8_SB(1, 0), b3, voffB);
            PG8_BAR; PG8_WAIT_L(0); PG8_MMA(0, 1, At, B1); PG8_BAR;
            PG8_LDA(At, 1, 1); PG8_STAGE(PG8_SA(1, 0), a3, voffA);
            PG8_BAR; PG8_WAIT_L(0); PG8_MMA(1, 0, At, B0); PG8_BAR; PG8_SCHED;
            PG8_STAGE(PG8_SB(1, 1), b3 + hstep, voffB);
            PG8_WAIT_V(6); PG8_BAR; PG8_MMA(1, 1, At, B1); PG8_BAR;
            }
        }
        if constexpr (ALIGN_EPI) { if (wr == 0) PG8_BAR; }
        if constexpr (!Epi::AFTER_DRAIN) { E(acc, cur, wr, wc, fr, fq); S.done(cur); }
        if (!has_next) break;
#pragma unroll
        for (int a = 0; a < 2; ++a)
#pragma unroll
            for (int b = 0; b < 2; ++b)
#pragma unroll
                for (int m = 0; m < 4; ++m)
#pragma unroll
                    for (int n = 0; n < 2; ++n) acc[a][b][m][n] = (f32x4){0.f, 0.f, 0.f, 0.f};
        cur = nxt; cA = nA; cB = nB; ++ui;
        if constexpr (ALIGN_EPI) { if (wr == 1) PG8_BAR; }
    }
    PG8_WAIT_V(0);
    if constexpr (!ALIGN_EPI) { if (wr == 0) PG8_BAR; }
    PG8_BAR;
    if constexpr (Epi::AFTER_DRAIN) { E.fused(acc, cur, wr, wc, fr, fq, lds, wid, lane); S.done(cur); }
#undef PG8_SA
#undef PG8_SB
#undef PG8_STAGE
#undef PG8_LDA
#undef PG8_LDB
#undef PG8_MMA
#undef PG8_WAIT_V
#undef PG8_WAIT_L
#undef PG8_BAR
#undef PG8_SCHED
}
}

#include <hip/hip_cooperative_groups.h>
namespace cg = cooperative_groups;
#define LAS __attribute__((address_space(3)))
typedef unsigned short bf16_t;
using pg8::f32x4; using pg8::bf16x8; using pg8::u32x4;
typedef float f32x2_t __attribute__((ext_vector_type(2))); typedef __bf16 bf16x2_t __attribute__((ext_vector_type(2)));
__device__ __forceinline__ unsigned cvt_pk_bf16(float lo, float hi) { f32x2_t v = {lo, hi}; bf16x2_t b = __builtin_convertvector(v, bf16x2_t); return __builtin_bit_cast(unsigned, b); }
typedef float f32x16 __attribute__((ext_vector_type(16)));
typedef short s16x4 __attribute__((ext_vector_type(4)));
typedef unsigned u32x2 __attribute__((ext_vector_type(2)));

constexpr int M = 16384, DM = 1024, SEQ = 2048, NB = 8, DEPTH = 4;
constexpr int NIN = 3840;
constexpr int DFF = 2816;
constexpr float EPS = 1e-6f;
constexpr float LOG2E = 1.4426950408889634f;
constexpr int LDS_BYTES = 147456;

struct P {
    const float *x, *mem; const int* pos;
    const float *norm_mix, *w_in, *ssm_conv_w, *ssm_conv_b, *dt_bias, *a_log, *d_skip, *ssm_norm, *q_norm, *w_uq, *kv_norm, *w_ukv, *attn_out_norm, *w_out,
                *norm_mem_q, *norm_mem_kv, *w_mq, *w_mk, *w_mv, *w_mo, *norm_ffn, *w_up, *ffn_conv_w, *ffn_conv_b, *w_down, *final_norm;
    float* out; unsigned char* ws;
};

constexpr size_t KiB = 1024, MiB = 1024 * 1024;
constexpr size_t WS_RSS = 0, WS_COS = 1 * MiB, WS_SIN = 2 * MiB, WS_DT = 3 * MiB, WS_KPE = 4 * MiB;
constexpr size_t WS_WIN = 6144 * KiB, WS_WUQ = 13824 * KiB, WS_WUKV = 14976 * KiB, WS_WOUT = 16000 * KiB, WS_WMQ = 20096 * KiB, WS_WMO = 22144 * KiB,
                 WS_WUP = 24192 * KiB, WS_WDN0 = 35456 * KiB, WS_WDN1 = 41088 * KiB;
constexpr size_t WS_WMKV = 46 * MiB, WS_KMVM = 62 * MiB, WS_MEMN = 94 * MiB, WS_XB = 98 * MiB, WS_VB = 98 * MiB;
constexpr size_t WS_Z = 130 * MiB, WS_QM = 130 * MiB, WS_U = 130 * MiB;
constexpr size_t WS_WUKV1 = 5 * MiB;
constexpr size_t WS_XBCPRE = 162 * MiB, WS_YC = 162 * MiB, WS_OM = 162 * MiB;
constexpr size_t WS_ACT = 218 * MiB;
constexpr size_t WS_SM = 226 * MiB, WS_XBC = 250 * MiB, WS_QB = 250 * MiB, WS_CQN = 314 * MiB, WS_CKVN = 326 * MiB, WS_RSP = 334 * MiB, WS_HALO = 337 * MiB, WS_PART = 340 * MiB, WS_KN = 343 * MiB, WS_END = 375 * MiB;

__device__ __forceinline__ float bflo(unsigned w) { return __uint_as_float(w << 16); }
__device__ __forceinline__ float bfhi(unsigned w) { return __uint_as_float(w & 0xffff0000u); }
__device__ __forceinline__ float bf1(bf16_t h) { return __uint_as_float((unsigned)h << 16); }
__device__ __forceinline__ bf16_t tobf(float f) { return (bf16_t)(cvt_pk_bf16(f, 0.f) & 0xffffu); }
__device__ __forceinline__ float wave_sum(float v) {
#pragma unroll
    for (int o = 1; o < 64; o <<= 1) v += __shfl_xor(v, o);
    return v;
}
__device__ __forceinline__ float silu_f(float v) { return v * __builtin_amdgcn_rcpf(1.f + __expf(-v)); }
__device__ __forceinline__ int crow(int r, int hi) { return (r & 3) + 8 * (r >> 2) + 4 * hi; }
#define LDS_WAIT() asm volatile("s_waitcnt lgkmcnt(0)" ::: "memory")
__device__ __forceinline__ int fresh_tid() { int t = threadIdx.x; asm volatile("" : "+v"(t)); return t; }
__device__ __forceinline__ float rss16(const float* rsp, int row) { const f32x4 a = *(const f32x4*)(rsp + (size_t)row * 4), b = *(const f32x4*)(rsp + (size_t)M * 4 + (size_t)row * 4), c = *(const f32x4*)(rsp + (size_t)M * 8 + (size_t)row * 4), d = *(const f32x4*)(rsp + (size_t)M * 12 + (size_t)row * 4);
    return (((a[0] + a[1]) + (a[2] + a[3])) + ((b[0] + b[1]) + (b[2] + b[3]))) + (((c[0] + c[1]) + (c[2] + c[3])) + ((d[0] + d[1]) + (d[2] + d[3]))); }

struct EpiRoute {
    static constexpr bool PERM = true, AFTER_DRAIN = false;
    bf16_t *b0, *b1, *b2; int ld0, ld1, ld2, t1, t2; const float* rss; float invk, mul;
    __device__ __forceinline__ void operator()(const f32x4 (&acc)[2][2][4][2], const pg8::Unit& u, int wr_, int wc_, int fr_, int fq_) const {
        const int t_ = fresh_tid(), wid_ = __builtin_amdgcn_readfirstlane(t_ >> 6), wr = wid_ >> 2, wc = wid_ & 3, fr = t_ & 15, fq = (t_ >> 4) & 3;
        bf16_t* base; int ld, colt;
        if (u.pn < t1) { base = b0; ld = ld0; colt = u.pn * 256; } else if (u.pn < t2) { base = b1; ld = ld1; colt = (u.pn - t1) * 256; } else { base = b2; ld = ld2; colt = (u.pn - t2) * 256; }
        const int col0 = colt + wc * 32 + 8 * fq;
#pragma unroll
        for (int ai = 0; ai < 2; ++ai)
#pragma unroll
            for (int m = 0; m < 4; ++m) {
                const int row = u.pm * 256 + ai * 128 + wr * 64 + m * 16 + fr;
                float s = mul; if (rss) s *= rsqrtf(rss16(rss, row) * invk + EPS);
                bf16_t* rowp = base + (size_t)row * ld + col0;
#pragma unroll
                for (int bj = 0; bj < 2; ++bj) { const f32x4 v0 = acc[ai][bj][m][0] * s, v1 = acc[ai][bj][m][1] * s;
                    u32x4 w; w.x = cvt_pk_bf16(v0[0], v0[1]); w.y = cvt_pk_bf16(v0[2], v0[3]); w.z = cvt_pk_bf16(v1[0], v1[1]); w.w = cvt_pk_bf16(v1[2], v1[3]);
                    *(u32x4*)(rowp + bj * 128) = w; }
                asm volatile("" ::: "memory");
            }
    }
};
struct EpiRope {
    static constexpr bool PERM = false, AFTER_DRAIN = false;
    bf16_t* YCq; bf16_t* QPE; const float* cs; const float* sn; float mul;
    __device__ __forceinline__ void operator()(const f32x4 (&acc)[2][2][4][2], const pg8::Unit& u, int wr_, int wc_, int fr_, int fq_) const {
        const int t_ = fresh_tid(), wid_ = __builtin_amdgcn_readfirstlane(t_ >> 6), wr = wid_ >> 2, wc = wid_ & 3, fr = t_ & 15, fq = (t_ >> 4) & 3;
#pragma unroll
        for (int ai = 0; ai < 2; ++ai)
#pragma unroll
            for (int m = 0; m < 4; ++m) {
                const int row = u.pm * 256 + ai * 128 + wr * 64 + m * 16 + fr;
                const f32x4 c = *(const f32x4*)(cs + (size_t)row * 16 + 4 * fq), s = *(const f32x4*)(sn + (size_t)row * 16 + 4 * fq);
#pragma unroll
                for (int bj = 0; bj < 2; ++bj) { const int gb = u.pn * 256 + bj * 128 + wc * 32; const int head = gb / 96, within = gb - head * 96; const bool rope = within == 64;
                    f32x4 a = acc[ai][bj][m][0], b = acc[ai][bj][m][1];
                    if (rope) { const f32x4 a2 = a * c - b * s, b2 = b * c + a * s; a = a2; b = b2; }
                    a = a * mul; b = b * mul;
                    bf16_t* dst = rope ? (QPE + (size_t)row * 512 + 32 * head + 4 * fq) : (YCq + (size_t)row * 2048 + 1024 + 64 * head + within + 4 * fq);
                    u32x2 w0, w1; w0.x = cvt_pk_bf16(a[0], a[1]); w0.y = cvt_pk_bf16(a[2], a[3]); w1.x = cvt_pk_bf16(b[0], b[1]); w1.y = cvt_pk_bf16(b[2], b[3]);
                    *(u32x2*)dst = w0; *(u32x2*)(dst + 16) = w1; }
                asm volatile("" ::: "memory");
            }
    }
};
struct EpiRes {
    static constexpr bool PERM = false, AFTER_DRAIN = false;
    const float* xin; float* xout; bf16_t* xb; float* rss;
    __device__ __forceinline__ void operator()(const f32x4 (&acc)[2][2][4][2], const pg8::Unit& u, int wr_, int wc_, int fr_, int fq_) const {
        const int t_ = fresh_tid(), wid_ = __builtin_amdgcn_readfirstlane(t_ >> 6), wr = wid_ >> 2, wc = wid_ & 3, fr = t_ & 15, fq = (t_ >> 4) & 3;
#pragma unroll
        for (int ai = 0; ai < 2; ++ai)
#pragma unroll
            for (int m = 0; m < 4; ++m) {
                const int row = u.pm * 256 + ai * 128 + wr * 64 + m * 16 + fr; float ss = 0.f;
#pragma unroll
                for (int bj = 0; bj < 2; ++bj)
#pragma unroll
                    for (int n = 0; n < 2; ++n) { const size_t off = (size_t)row * 1024 + u.pn * 256 + bj * 128 + wc * 32 + 16 * n + 4 * fq;
                        const f32x4 v = *(const f32x4*)(xin + off) + acc[ai][bj][m][n];
                        *(f32x4*)(xout + off) = v; u32x2 w; w.x = cvt_pk_bf16(v[0], v[1]); w.y = cvt_pk_bf16(v[2], v[3]); *(u32x2*)(xb + off) = w;
                        ss += (v[0] * v[0] + v[1] * v[1]) + (v[2] * v[2] + v[3] * v[3]); }
                ss += __shfl_xor(ss, 16); ss += __shfl_xor(ss, 32);
                if (fq == 0) rss[(size_t)u.pn * M * 4 + (size_t)row * 4 + wc] = ss;
                asm volatile("" ::: "memory");
            }
    }
};


template <int CTRL> __device__ __forceinline__ float dpp_mov(float old, float src) {
    return __builtin_bit_cast(float, __builtin_amdgcn_update_dpp(__builtin_bit_cast(int, old), __builtin_bit_cast(int, src), CTRL, 0xf, 0xf, false)); }
struct EpiGlu {
    static constexpr bool PERM = true, AFTER_DRAIN = false;
    bf16_t* ACT; const float* rss; const float* cw; const float* cb; float* HALO; float* PART; LAS float* H;
    __device__ __forceinline__ void operator()(const f32x4 (&acc)[2][2][4][2], const pg8::Unit& u, int wr_, int wc_, int fr_, int fq_) const {
        typedef float f32x2v __attribute__((ext_vector_type(2)));
        typedef __attribute__((address_space(1))) f32x4 gf4; typedef __attribute__((address_space(1))) f32x2v gf2; typedef __attribute__((address_space(1))) u32x2 gu2;
        const int t_ = fresh_tid(), wid_ = __builtin_amdgcn_readfirstlane(t_ >> 6), wr = wid_ >> 2, wc = wid_ & 3, fr = t_ & 15, fq = (t_ >> 4) & 3;
        const int pm = u.pm, pn = u.pn;
        LAS float* RS = H + 2048; LAS float* WT = H + 2304;
        if (t_ < 256) { RS[t_] = rsqrtf(rss16(rss, pm * 256 + t_) * (1.f / 1024.f) + EPS);
            const unsigned gcol = (unsigned)((t_ >> 7) * 2816 + 128 * pn + (t_ & 127));
            WT[t_] = cw[gcol]; WT[256 + t_] = cw[5632u + gcol]; WT[512 + t_] = cw[11264u + gcol]; WT[768 + t_] = cb[gcol]; }
        asm volatile("s_waitcnt lgkmcnt(0)" ::: "memory"); __builtin_amdgcn_s_barrier(); asm volatile("" ::: "memory");
        const LAS float* RSl = RS + wr * 64 + fr;
        const int lc = wc * 32 + 8 * fq;
        if (fr >= 14) {
#pragma unroll
            for (int ai = 0; ai < 2; ++ai)
#pragma unroll
                for (int bj = 0; bj < 2; ++bj)
#pragma unroll
                    for (int n = 0; n < 2; ++n) { const f32x4 v = acc[ai][bj][3][n] * RSl[ai * 128 + 48];
                        *(LAS f32x4*)(H + ((ai * 2 + wr) * 2 + (fr - 14)) * 256 + bj * 128 + lc + 4 * n) = v;
                        if (ai == 1 && wr == 1) *(gf4*)(HALO + (unsigned)((pm * 2 + (fr - 14)) * 5632 + bj * 2816 + 128 * pn + lc + 4 * n)) = v; }
        }
        asm volatile("s_waitcnt lgkmcnt(0)" ::: "memory"); __builtin_amdgcn_s_barrier(); asm volatile("" ::: "memory");
#pragma unroll
        for (int n = 0; n < 2; ++n)
#pragma unroll
            for (int ai = 0; ai < 2; ++ai) {
                const int src = ai * 2 + wr - 1;
                unsigned res0[4];
#pragma unroll
                for (int jp = 0; jp < 2; ++jp) {
                    const int lcc = lc + 4 * n + 2 * jp;
                    const f32x2v w0g = *(const LAS f32x2v*)(WT + lcc), w1g = *(const LAS f32x2v*)(WT + 256 + lcc), w2g = *(const LAS f32x2v*)(WT + 512 + lcc), bg = *(const LAS f32x2v*)(WT + 768 + lcc);
                    const f32x2v w0v = *(const LAS f32x2v*)(WT + 128 + lcc), w1v = *(const LAS f32x2v*)(WT + 384 + lcc), w2v = *(const LAS f32x2v*)(WT + 640 + lcc), bv = *(const LAS f32x2v*)(WT + 896 + lcc);
                    f32x2v pg = (f32x2v){0.f, 0.f}, pv = (f32x2v){0.f, 0.f};
                    if (src >= 0) { const LAS float* hp = H + (src * 2 + (fr & 1)) * 256 + lcc; pg = *(const LAS f32x2v*)hp; pv = *(const LAS f32x2v*)(hp + 128); }
                    const unsigned gc = (unsigned)(128 * pn + lcc);
#pragma unroll
                    for (int m = 0; m < 4; ++m) {
                        const float sm_ = RSl[ai * 128 + m * 16];
                        const f32x2v cg = (f32x2v){acc[ai][0][m][n][2 * jp] * sm_, acc[ai][0][m][n][2 * jp + 1] * sm_}, cv = (f32x2v){acc[ai][1][m][n][2 * jp] * sm_, acc[ai][1][m][n][2 * jp + 1] * sm_};
                        f32x2v og, ov;
#pragma unroll
                        for (int j = 0; j < 2; ++j) {
                            const float g1 = dpp_mov<0x111>(dpp_mov<0x121>(pg[j], pg[j]), cg[j]), g2 = dpp_mov<0x112>(dpp_mov<0x122>(pg[j], pg[j]), cg[j]);
                            const float v1 = dpp_mov<0x111>(dpp_mov<0x121>(pv[j], pv[j]), cv[j]), v2 = dpp_mov<0x112>(dpp_mov<0x122>(pv[j], pv[j]), cv[j]);
                            og[j] = bg[j] + w2g[j] * cg[j] + w1g[j] * g1 + w0g[j] * g2;
                            ov[j] = bv[j] + w2v[j] * cv[j] + w1v[j] * v1 + w0v[j] * v2; }
                        pg = cg; pv = cv;
                        const int row = pm * 256 + ai * 128 + wr * 64 + m * 16 + fr;
                        const bool partial = (ai == 0) && (m == 0) && (wr == 0) && (fr < 2) && ((pm & 7) != 0);
                        if (partial) { *(gf2*)(PART + ((unsigned)(((pm * 2 + fr) * 2 + 0) * 2816) + gc)) = og; *(gf2*)(PART + ((unsigned)(((pm * 2 + fr) * 2 + 1) * 2816) + gc)) = ov; }
                        const unsigned pk = cvt_pk_bf16(silu_f(og[0]) * ov[0], silu_f(og[1]) * ov[1]);
                        if (jp == 0) res0[m] = pk;
                        else if (!partial) { u32x2 o; o.x = res0[m]; o.y = pk; *(gu2*)(ACT + ((unsigned)(row * DFF) + gc - 2u)) = o; }
                    }
                    asm volatile("" ::: "memory");
                }
            }
    }
};
__device__ __forceinline__ void ffn_fixup(const P& p, int L, int pm) {
    if ((pm & 7) == 0) return;
    unsigned char* ws = p.ws; asm volatile("" : "+s"(ws));
    const float* HALO = (const float*)(ws + WS_HALO); const float* PART = (const float*)(ws + WS_PART); bf16_t* ACT = (bf16_t*)(ws + WS_ACT);
    const float* cw = p.ffn_conv_w + (size_t)L * 3 * 5632;
    const int tid = fresh_tid();
    for (int idx = tid; idx < 2 * DFF; idx += 512) { const int r = idx / DFF, c = idx - r * DFF;
        float g = PART[(((size_t)pm * 2 + r) * 2 + 0) * 2816 + c], v = PART[(((size_t)pm * 2 + r) * 2 + 1) * 2816 + c];
        const float hg0 = HALO[((size_t)(pm - 1) * 2 + 0) * 5632 + c], hg1 = HALO[((size_t)(pm - 1) * 2 + 1) * 5632 + c];
        const float hv0 = HALO[((size_t)(pm - 1) * 2 + 0) * 5632 + 2816 + c], hv1 = HALO[((size_t)(pm - 1) * 2 + 1) * 5632 + 2816 + c];
        if (r == 0) { g += cw[5632 + c] * hg1 + cw[c] * hg0; v += cw[5632 + 2816 + c] * hv1 + cw[2816 + c] * hv0; }
        else { g += cw[c] * hg1; v += cw[2816 + c] * hv1; }
        ACT[((size_t)pm * 256 + r) * DFF + c] = tobf(silu_f(g) * v); }
    asm volatile("s_waitcnt vmcnt(0)" ::: "memory");
    __syncthreads();
}

template <class Epi>
__device__ __forceinline__ void run_gemm_on(LAS unsigned char* lds, const bf16_t* A, const bf16_t* Bt, int m, int n, int k, const Epi& E, int G_, int c_) {
    pg8::Gemm g{A, Bt, m, n, k}; pg8::StaticOrder S; S.init(m, n, G_, c_);
    pg8::gemm_phase<Epi, pg8::StaticOrder, true, true>(lds, g, S, E);
}
template <class Epi>
__device__ __forceinline__ void run_gemm(LAS unsigned char* lds, const bf16_t* A, const bf16_t* Bt, int m, int n, int k, const Epi& E) {
    pg8::Gemm g{A, Bt, m, n, k}; pg8::StaticOrder S; S.init(m, n, (int)gridDim.x, (int)blockIdx.x);
    pg8::gemm_phase<Epi, pg8::StaticOrder, true, true>(lds, g, S, E);
}

template <class SrcCol, class Gain>
__device__ __forceinline__ void tr_item(const float* W, int K, int Nsrc, bf16_t* WT, int nblk, LAS float* scr, int item, int lane, SrcCol srccol, Gain gain) {
    const int kb = item / nblk, nb = item % nblk, k0 = 64 * kb, n0 = 32 * nb;
    const int sc = srccol(n0 + (lane & 31));
#pragma unroll
    for (int i = 0; i < 32; ++i) { const int kk = 2 * i + (lane >> 5);
        float v = 0.f; if (sc >= 0) v = W[(size_t)(k0 + kk) * Nsrc + sc] * gain(k0 + kk);
        scr[kk * 33 + (lane & 31)] = v; }
    LDS_WAIT(); asm volatile("" ::: "memory");
    const int c = lane & 7;
#pragma unroll
    for (int j = 0; j < 4; ++j) { const int n = (lane >> 3) + 8 * j; const LAS float* s = scr + (8 * c) * 33 + n;
        u32x4 o; o.x = cvt_pk_bf16(s[0 * 33], s[1 * 33]); o.y = cvt_pk_bf16(s[2 * 33], s[3 * 33]); o.z = cvt_pk_bf16(s[4 * 33], s[5 * 33]); o.w = cvt_pk_bf16(s[6 * 33], s[7 * 33]);
        *(u32x4*)(WT + (size_t)(n0 + n) * K + k0 + 8 * c) = o; }
    LDS_WAIT(); asm volatile("" ::: "memory");
}

__device__ __forceinline__ void convert_layer(const P& p, int Lw, int Lq, int Lu, int L, LAS float* scr, int gw, int NGW, int lane_unused) {
    const int lane = fresh_tid() & 63;
    unsigned char* ws = p.ws; asm volatile("" : "+s"(ws));
    constexpr int I_IN = 16 * 120, I_UQ = 6 * 48, I_UKV = 4 * 64, I_OUT = 32 * 32, I_MQ = 16 * 32, I_MO = 16 * 32, I_UP = 16 * 176, I_DN = 44 * 32;
    constexpr int NIT = I_IN + I_UQ + I_UKV + I_OUT + I_MQ + I_MO + I_UP + I_DN;
    for (int it = gw; it < NIT; it += NGW) {
        int r = it;
        if (r < I_IN) { if (Lw < 0 || Lw >= DEPTH) continue; const float* g = p.norm_mix + Lw * 1024;
            tr_item(p.w_in + (size_t)Lw * 1024 * 3760, 1024, 3760, (bf16_t*)(ws + WS_WIN), 120, scr, r, lane,
                    [](int n) { return n < 3072 ? n : (n < 3744 ? n + 16 : (n < 3760 ? n - 672 : -1)); }, [g](int k) { return g[k]; }); continue; } r -= I_IN;
        if (r < I_UQ) { if (Lq < 0 || Lq >= DEPTH) continue; const float* g = p.q_norm + Lq * 384;
            tr_item(p.w_uq + (size_t)Lq * 384 * 1536, 384, 1536, (bf16_t*)(ws + WS_WUQ), 48, scr, r, lane, [](int n) { return n; }, [g](int k) { return g[k]; }); continue; } r -= I_UQ;
        if (r < I_UKV) { if (Lq < 0 || Lq >= DEPTH) continue; const float* g = p.kv_norm + Lq * 256;
            tr_item(p.w_ukv + (size_t)Lq * 256 * 2048, 256, 2048, (bf16_t*)(ws + WS_WUKV), 64, scr, r, lane,
                    [](int n) { return n < 1024 ? 128 * (n >> 6) + (n & 63) : 128 * ((n - 1024) >> 6) + 64 + (n & 63); }, [g](int k) { return g[k]; }); continue; } r -= I_UKV;
        if (r < I_OUT) { if (L < 0) continue; const float* g1 = p.ssm_norm + L * 1024; const float* g2 = p.attn_out_norm + L * 1024;
            tr_item(p.w_out + (size_t)L * 2048 * 1024, 2048, 1024, (bf16_t*)(ws + WS_WOUT), 32, scr, r, lane, [](int n) { return n; }, [g1, g2](int k) { return k < 1024 ? g1[k] : g2[k - 1024]; }); continue; } r -= I_OUT;
        if (r < I_MQ) { if (L < 0) continue; const float* g = p.norm_mem_q + L * 1024;
            tr_item(p.w_mq + (size_t)L * 1024 * 1024, 1024, 1024, (bf16_t*)(ws + WS_WMQ), 32, scr, r, lane, [](int n) { return n; }, [g](int k) { return g[k]; }); continue; } r -= I_MQ;
        if (r < I_MO) { if (L < 0) continue;
            tr_item(p.w_mo + (size_t)L * 1024 * 1024, 1024, 1024, (bf16_t*)(ws + WS_WMO), 32, scr, r, lane, [](int n) { return n; }, [](int) { return 1.f; }); continue; } r -= I_MO;
        if (r < I_UP) { if (Lu < 0 || Lu >= DEPTH) continue; const float* g = p.norm_ffn + Lu * 1024;
            tr_item(p.w_up + (size_t)Lu * 1024 * 5632, 1024, 5632, (bf16_t*)(ws + WS_WUP), 176, scr, r, lane, [](int n) { return (n & 128) ? 2816 + 128 * (n >> 8) + (n & 127) : 128 * (n >> 8) + (n & 127); }, [g](int k) { return g[k]; }); continue; } r -= I_UP;
        if (L < 0) continue;
        tr_item(p.w_down + (size_t)L * 2816 * 1024, 2816, 1024, (bf16_t*)(ws + ((L & 1) ? WS_WDN1 : WS_WDN0)), 32, scr, r, lane, [](int n) { return n; }, [](int) { return 1.f; });
    }
}

__device__ __forceinline__ void prologue(const P& p, LAS float* scr, int gw, int NGW, int lane_unused) {
    const int lane = fresh_tid() & 63;
    unsigned char* ws = p.ws; asm volatile("" : "+s"(ws));
    float* rss = (float*)(ws + WS_RSP);
    bf16_t* XB = (bf16_t*)(ws + WS_XB);
    for (int m = gw; m < M; m += NGW) {
        const f32x4* xr = (const f32x4*)(p.x + (size_t)m * 1024) + lane; float ss = 0.f;
#pragma unroll
        for (int j = 0; j < 4; ++j) { const f32x4 v = xr[64 * j]; ss += (v[0] * v[0] + v[1] * v[1]) + (v[2] * v[2] + v[3] * v[3]);
            u32x2 w; w.x = cvt_pk_bf16(v[0], v[1]); w.y = cvt_pk_bf16(v[2], v[3]); *((u32x2*)(XB + (size_t)m * 1024) + lane + 64 * j) = w; }
        ss = wave_sum(ss); if (lane < 16) rss[(size_t)(lane >> 2) * M * 4 + (size_t)m * 4 + (lane & 3)] = (lane == 0) ? ss : 0.f;
    }
    bf16_t* MEMN = (bf16_t*)(ws + WS_MEMN);
    for (int m = gw; m < 2048; m += NGW) {
        const f32x4* xr = (const f32x4*)(p.mem + (size_t)m * 1024) + lane; f32x4 v[4]; float ss = 0.f;
#pragma unroll
        for (int j = 0; j < 4; ++j) { v[j] = xr[64 * j]; ss += (v[j][0] * v[j][0] + v[j][1] * v[j][1]) + (v[j][2] * v[j][2] + v[j][3] * v[j][3]); }
        const float rs = rsqrtf(wave_sum(ss) * (1.f / 1024.f) + EPS);
#pragma unroll
        for (int j = 0; j < 4; ++j) { u32x2 w; w.x = cvt_pk_bf16(v[j][0] * rs, v[j][1] * rs); w.y = cvt_pk_bf16(v[j][2] * rs, v[j][3] * rs); *((u32x2*)(MEMN + (size_t)m * 1024) + lane + 64 * j) = w; }
    }
    float* COS = (float*)(ws + WS_COS); float* SIN = (float*)(ws + WS_SIN);
    for (int i = gw * 64 + lane; i < M * 16; i += NGW * 64) { const int m = i >> 4, k = i & 15;
        const float inv = powf(10000.f, -(float)(2 * k) / 32.f); const float ang = (float)p.pos[m] * inv;
        COS[i] = cosf(ang); SIN[i] = sinf(ang); }
    for (int it = gw; it < 4 * 2 * 512; it += NGW) { const int L = it >> 10, kv = (it >> 9) & 1, r = it & 511; const float* g = p.norm_mem_kv + L * 1024;
        tr_item((kv ? p.w_mv : p.w_mk) + (size_t)L * 1024 * 1024, 1024, 1024, (bf16_t*)(ws + WS_WMKV) + (size_t)(L * 2048 + kv * 1024) * 1024, 32, scr, r, lane, [](int n) { return n; }, [g](int k) { return g[k]; }); }
    convert_layer(p, 0, 0, -1, -1, scr, gw, NGW, lane);
}

__device__ __forceinline__ void pass_l2(const P& p, int L, int gw, int NGW, int lane_unused) {
    const int lane = fresh_tid() & 63;
    unsigned char* ws = p.ws; asm volatile("" : "+s"(ws));
    const bf16_t* XP = (const bf16_t*)(ws + WS_XBCPRE); bf16_t* XO = (bf16_t*)(ws + WS_XBC); const bf16_t* SM = (const bf16_t*)(ws + WS_SM);
    bf16_t* CQN = (bf16_t*)(ws + WS_CQN); bf16_t* CKVN = (bf16_t*)(ws + WS_CKVN); bf16_t* KPE = (bf16_t*)(ws + WS_KPE); float* DT = (float*)(ws + WS_DT);
    const float* COS = (const float*)(ws + WS_COS); const float* SIN = (const float*)(ws + WS_SIN);
    const float* cw = p.ssm_conv_w + (size_t)L * 4 * 2048; const float* cb = p.ssm_conv_b + (size_t)L * 2048;
    for (int blk = gw; blk < M / 8; blk += NGW) {
        const int m0 = blk * 8, t0 = m0 & (SEQ - 1);
#pragma unroll 2
        for (int j = 0; j < 4; ++j) {
            const int c = lane * 8 + 512 * j;
            const f32x4 b0 = *(const f32x4*)(cb + c), b1 = *(const f32x4*)(cb + c + 4);
            f32x4 w0[4], w1[4];
#pragma unroll
            for (int k = 0; k < 4; ++k) { w0[k] = *(const f32x4*)(cw + k * 2048 + c); w1[k] = *(const f32x4*)(cw + k * 2048 + c + 4); }
            u32x4 xr[11];
#pragma unroll
            for (int i = 0; i < 11; ++i) { if (t0 - 3 + i >= 0) xr[i] = *(const u32x4*)(XP + (size_t)(m0 - 3 + i) * 2048 + c); else xr[i] = (u32x4){0u, 0u, 0u, 0u}; }
#pragma unroll
            for (int r = 0; r < 8; ++r) {
                f32x4 a0 = b0, a1 = b1;
#pragma unroll
                for (int k = 0; k < 4; ++k) { const u32x4 v = xr[r + k];
                    a0[0] += w0[k][0] * bflo(v.x); a0[1] += w0[k][1] * bfhi(v.x); a0[2] += w0[k][2] * bflo(v.y); a0[3] += w0[k][3] * bfhi(v.y);
                    a1[0] += w1[k][0] * bflo(v.z); a1[1] += w1[k][1] * bfhi(v.z); a1[2] += w1[k][2] * bflo(v.w); a1[3] += w1[k][3] * bfhi(v.w); }
                u32x4 o; o.x = cvt_pk_bf16(silu_f(a0[0]), silu_f(a0[1])); o.y = cvt_pk_bf16(silu_f(a0[2]), silu_f(a0[3]));
                o.z = cvt_pk_bf16(silu_f(a1[0]), silu_f(a1[1])); o.w = cvt_pk_bf16(silu_f(a1[2]), silu_f(a1[3]));
                *(u32x4*)(XO + (size_t)(m0 + r) * 2048 + c) = o;
            }
        }
    }
    for (int m = gw; m < M; m += NGW) {
        const unsigned* sm = (const unsigned*)(SM + (size_t)m * 768);
        {
            unsigned w[3]; float ss = 0.f;
#pragma unroll
            for (int i = 0; i < 3; ++i) { w[i] = sm[lane + 64 * i]; const float a = bflo(w[i]), b = bfhi(w[i]); ss += a * a + b * b; }
            const float rs = rsqrtf(wave_sum(ss) * (1.f / 384.f) + EPS);
#pragma unroll
            for (int i = 0; i < 3; ++i) ((unsigned*)(CQN + (size_t)m * 384))[lane + 64 * i] = cvt_pk_bf16(bflo(w[i]) * rs, bfhi(w[i]) * rs);
        }
        {
            unsigned w[2]; float ss = 0.f;
#pragma unroll
            for (int i = 0; i < 2; ++i) { w[i] = sm[192 + lane + 64 * i]; const float a = bflo(w[i]), b = bfhi(w[i]); ss += a * a + b * b; }
            const float rs = rsqrtf(wave_sum(ss) * (1.f / 256.f) + EPS);
#pragma unroll
            for (int i = 0; i < 2; ++i) ((unsigned*)(CKVN + (size_t)m * 256))[lane + 64 * i] = cvt_pk_bf16(bflo(w[i]) * rs, bfhi(w[i]) * rs);
        }
        {
            const bf16_t* sr = SM + (size_t)m * 768;
            const float v = bf1(sr[640 + (lane & 31)]); const float pr = __shfl_xor(v, 16); const int i = lane & 15;
            const float c = COS[(size_t)m * 16 + i], s = SIN[(size_t)m * 16 + i];
            const float o = (lane & 16) ? (v * c + pr * s) : (v * c - pr * s);
            if (lane < 32) KPE[(size_t)m * 32 + lane] = tobf(o);
            const float d = bf1(sr[672 + (lane & 15)]) + p.dt_bias[L * 16 + (lane & 15)];
            const float sp = fmaxf(d, 0.f) + __logf(1.f + __expf(-fabsf(d)));
            if (lane < 16) DT[(size_t)m * 16 + lane] = sp;
        }
    }
}

__device__ __forceinline__ void pass_ycnorm(const P& p, int gw, int NGW, int lane_unused) {
    const int lane = fresh_tid() & 63;
    unsigned char* ws = p.ws; asm volatile("" : "+s"(ws));
    bf16_t* YC = (bf16_t*)(ws + WS_YC);
    for (int m0 = gw; m0 < M; m0 += 2 * NGW) {
        u32x4 v[2][4];
#pragma unroll
        for (int q = 0; q < 2; ++q) { const int m = m0 + q * NGW; if (m < M) {
#pragma unroll
            for (int j = 0; j < 4; ++j) v[q][j] = ((const u32x4*)(YC + (size_t)m * 2048))[lane + 64 * j]; } }
#pragma unroll
        for (int q = 0; q < 2; ++q) { const int m = m0 + q * NGW; if (m < M) {
            u32x4* row = (u32x4*)(YC + (size_t)m * 2048); float s[2] = {0.f, 0.f};
#pragma unroll
            for (int j = 0; j < 4; ++j) { const u32x4 w = v[q][j]; float a = 0.f;
                a += bflo(w.x) * bflo(w.x) + bfhi(w.x) * bfhi(w.x); a += bflo(w.y) * bflo(w.y) + bfhi(w.y) * bfhi(w.y);
                a += bflo(w.z) * bflo(w.z) + bfhi(w.z) * bfhi(w.z); a += bflo(w.w) * bflo(w.w) + bfhi(w.w) * bfhi(w.w);
                s[j >> 1] += a; }
            const float r0 = rsqrtf(wave_sum(s[0]) * (1.f / 1024.f) + EPS), r1 = rsqrtf(wave_sum(s[1]) * (1.f / 1024.f) + EPS);
#pragma unroll
            for (int j = 0; j < 4; ++j) { const float r = (j < 2) ? r0 : r1; const u32x4 w = v[q][j]; u32x4 o;
                o.x = cvt_pk_bf16(bflo(w.x) * r, bfhi(w.x) * r); o.y = cvt_pk_bf16(bflo(w.y) * r, bfhi(w.y) * r);
                o.z = cvt_pk_bf16(bflo(w.z) * r, bfhi(w.z) * r); o.w = cvt_pk_bf16(bflo(w.w) * r, bfhi(w.w) * r);
                row[lane + 64 * j] = o; } } }
    }
}

__device__ __forceinline__ void pass_ffnact(const P& p, int L, int half, int gw, int NGW, int lane_unused) {
    const int lane = fresh_tid() & 63;
    unsigned char* ws = p.ws; asm volatile("" : "+s"(ws));
    const bf16_t* U = (const bf16_t*)(ws + WS_U); bf16_t* ACT = (bf16_t*)(ws + WS_ACT) + (size_t)half * 8192 * DFF;
    const float* cw = p.ffn_conv_w + (size_t)L * 3 * 5632; const float* cb = p.ffn_conv_b + (size_t)L * 5632;
    for (int blk = gw; blk < 8192 / 4; blk += NGW) {
        const int m0 = blk * 4, t0 = m0 & (SEQ - 1);
        for (int ch = lane; ch < DFF / 8; ch += 64) {
            const int c = ch * 8;
            const f32x4 bg0 = *(const f32x4*)(cb + c), bg1 = *(const f32x4*)(cb + c + 4), bv0 = *(const f32x4*)(cb + DFF + c), bv1 = *(const f32x4*)(cb + DFF + c + 4);
            f32x4 wg0[3], wg1[3], wv0[3], wv1[3];
#pragma unroll
            for (int k = 0; k < 3; ++k) { const float* wk = cw + k * 5632; wg0[k] = *(const f32x4*)(wk + c); wg1[k] = *(const f32x4*)(wk + c + 4); wv0[k] = *(const f32x4*)(wk + DFF + c); wv1[k] = *(const f32x4*)(wk + DFF + c + 4); }
            u32x4 ug[6], uv[6];
#pragma unroll
            for (int i = 0; i < 6; ++i) { if (t0 - 2 + i >= 0) { const bf16_t* ur = U + (size_t)(m0 - 2 + i) * 5632; ug[i] = *(const u32x4*)(ur + c); uv[i] = *(const u32x4*)(ur + DFF + c); }
                else { ug[i] = (u32x4){0u, 0u, 0u, 0u}; uv[i] = (u32x4){0u, 0u, 0u, 0u}; } }
#pragma unroll
            for (int r = 0; r < 4; ++r) {
                f32x4 g0 = bg0, g1 = bg1, v0 = bv0, v1 = bv1;
#pragma unroll
                for (int k = 0; k < 3; ++k) { const u32x4 a = ug[r + k], b = uv[r + k];
                    g0[0] += wg0[k][0] * bflo(a.x); g0[1] += wg0[k][1] * bfhi(a.x); g0[2] += wg0[k][2] * bflo(a.y); g0[3] += wg0[k][3] * bfhi(a.y);
                    g1[0] += wg1[k][0] * bflo(a.z); g1[1] += wg1[k][1] * bfhi(a.z); g1[2] += wg1[k][2] * bflo(a.w); g1[3] += wg1[k][3] * bfhi(a.w);
                    v0[0] += wv0[k][0] * bflo(b.x); v0[1] += wv0[k][1] * bfhi(b.x); v0[2] += wv0[k][2] * bflo(b.y); v0[3] += wv0[k][3] * bfhi(b.y);
                    v1[0] += wv1[k][0] * bflo(b.z); v1[1] += wv1[k][1] * bfhi(b.z); v1[2] += wv1[k][2] * bflo(b.w); v1[3] += wv1[k][3] * bfhi(b.w); }
                u32x4 o; o.x = cvt_pk_bf16(silu_f(g0[0]) * v0[0], silu_f(g0[1]) * v0[1]); o.y = cvt_pk_bf16(silu_f(g0[2]) * v0[2], silu_f(g0[3]) * v0[3]);
                o.z = cvt_pk_bf16(silu_f(g1[0]) * v1[0], silu_f(g1[1]) * v1[1]); o.w = cvt_pk_bf16(silu_f(g1[2]) * v1[2], silu_f(g1[3]) * v1[3]);
                *(u32x4*)(ACT + (size_t)(m0 + r) * DFF + c) = o;
            }
        }
    }
}

__device__ __forceinline__ void pass_final(const P& p, int gw, int NGW, int lane_unused) {
    const int lane = fresh_tid() & 63;
    const float* rss = (const float*)(p.ws + WS_RSP);
    for (int m = gw; m < M; m += NGW) {
        const float rs = rsqrtf(rss16(rss, m) * (1.f / 1024.f) + EPS);
        f32x4* xr = (f32x4*)(p.out + (size_t)m * 1024) + lane; const f32x4* g = (const f32x4*)p.final_norm + lane;
#pragma unroll
        for (int j = 0; j < 4; ++j) { f32x4 v = xr[64 * j]; v = v * rs * g[64 * j]; xr[64 * j] = v; }
    }
}

typedef short v4i16_t __attribute__((ext_vector_type(4)));
__device__ __forceinline__ s16x4 vtr(const LAS unsigned char* p) { return __builtin_bit_cast(s16x4, __builtin_amdgcn_ds_read_tr16_b64_v4i16((LAS v4i16_t*)p)); }
__device__ __forceinline__ bf16x8 join8(s16x4 lo, s16x4 hi) { return (bf16x8){lo[0], lo[1], lo[2], lo[3], hi[0], hi[1], hi[2], hi[3]}; }
__device__ __forceinline__ bf16x8 pack8(const f32x16& s, int b) {
    u32x4 w; w.x = cvt_pk_bf16(s[b], s[b + 1]); w.y = cvt_pk_bf16(s[b + 2], s[b + 3]); w.z = cvt_pk_bf16(s[b + 4], s[b + 5]); w.w = cvt_pk_bf16(s[b + 6], s[b + 7]);
    return __builtin_bit_cast(bf16x8, w);
}

#define LDS_BARRIER() do { asm volatile("s_waitcnt lgkmcnt(0)" ::: "memory"); __builtin_amdgcn_s_barrier(); asm volatile("" ::: "memory"); } while (0)
template <int DQK, int DV, bool CAUSAL, bool K2>
__device__ __forceinline__ void attn_unit(LAS unsigned char* lds, const bf16_t* Q, int qpitch, const bf16_t* Qp2, int q2pitch, const bf16_t* K, int kpitch, const bf16_t* Kp2, int k2pitch,
                                          const bf16_t* V, int vpitch, bf16_t* O, int opitch, int q0, int NT) {
    constexpr int KP = (DQK + 8) * 2, VP = (DV == 64) ? 192 : 320;
    constexpr int KBUF = 64 * KP, VBUF = 64 * VP, BUF = KBUF + VBUF;
    constexpr int KCH = DQK / 8, VCH = DV / 8, NKC = 64 * KCH, NVC = 64 * VCH;
    constexpr int NKR = (NKC + 511) / 512, NVR = NVC / 512;
    const int tid = fresh_tid(), lane = tid & 63, w = __builtin_amdgcn_readfirstlane(tid >> 6), ql = lane & 31, hi = lane >> 5;
    u32x4 kreg[NKR], vreg[NVR];
    auto gload = [&](int t) {
#pragma unroll
        for (int i = 0; i < NKR; ++i) { const int id = tid + 512 * i;
            if (id < NKC) { const int row = id / KCH, c = id % KCH; const size_t kv = (size_t)(64 * t + row);
                if (K2 && c >= (DQK - 32) / 8) kreg[i] = *(const u32x4*)(Kp2 + kv * k2pitch + (c - (DQK - 32) / 8) * 8);
                else kreg[i] = *(const u32x4*)(K + kv * kpitch + c * 8); } }
#pragma unroll
        for (int i = 0; i < NVR; ++i) { const int id = tid + 512 * i; const int row = id / VCH, c = id % VCH;
            vreg[i] = *(const u32x4*)(V + (size_t)(64 * t + row) * vpitch + c * 8); }
    };
    auto lstore = [&](int b) {
        LAS unsigned char* kb = lds + b * BUF; LAS unsigned char* vb = kb + KBUF;
#pragma unroll
        for (int i = 0; i < NKR; ++i) { const int id = tid + 512 * i; if (id < NKC) { const int row = id / KCH, c = id % KCH; *(LAS u32x4*)(kb + row * KP + c * 16) = kreg[i]; } }
#pragma unroll
        for (int i = 0; i < NVR; ++i) { const int id = tid + 512 * i; const int row = id / VCH, c = id % VCH; *(LAS u32x4*)(vb + row * VP + c * 16) = vreg[i]; }
    };
    gload(0);
    bf16x8 qf[DQK / 16];
#pragma unroll
    for (int d0 = 0; d0 < DQK / 16; ++d0) {
        if (K2 && d0 >= (DQK - 32) / 16) qf[d0] = *(const bf16x8*)(Qp2 + (size_t)(32 * w + ql) * q2pitch + 16 * (d0 - (DQK - 32) / 16) + 8 * hi);
        else qf[d0] = *(const bf16x8*)(Q + (size_t)(32 * w + ql) * qpitch + 16 * d0 + 8 * hi); }
    f32x16 oacc[DV / 32];
#pragma unroll
    for (int i = 0; i < DV / 32; ++i)
#pragma unroll
        for (int r = 0; r < 16; ++r) oacc[i][r] = 0.f;
    float m_run = -INFINITY, l_run = 0.f;
    const int q0w = q0 + 32 * w, qg = q0w + ql;
    lstore(0);
    LDS_BARRIER();
    const int vtoff = (4 * hi + ((lane & 15) >> 2)) * VP + (16 * ((lane >> 4) & 1) + 4 * (lane & 3)) * 2;
    for (int t = 0; t < NT; ++t) {
        if (t + 1 < NT) gload(t + 1);
        const bool active = !CAUSAL || (64 * t <= q0w + 31);
        if (active) {
            const LAS unsigned char* kb = lds + (t & 1) * BUF; const LAS unsigned char* vb = kb + KBUF;
            f32x16 s0, s1;
#pragma unroll
            for (int r = 0; r < 16; ++r) { s0[r] = 0.f; s1[r] = 0.f; }
            if constexpr (DQK <= 128)
            {
                constexpr int ND0 = DQK / 16, GB = (ND0 <= 6) ? ND0 : 2;
#pragma unroll
                for (int g0 = 0; g0 < ND0; g0 += GB) {
                    bf16x8 ka[GB], kc[GB];
#pragma unroll
                    for (int k = 0; k < GB; ++k) { ka[k] = *(const LAS bf16x8*)(kb + ql * KP + (16 * (g0 + k) + 8 * hi) * 2); kc[k] = *(const LAS bf16x8*)(kb + (32 + ql) * KP + (16 * (g0 + k) + 8 * hi) * 2); }
                    __builtin_amdgcn_sched_barrier(0);
#pragma unroll
                    for (int k = 0; k < GB; ++k) { s0 = __builtin_amdgcn_mfma_f32_32x32x16_bf16(ka[k], qf[g0 + k], s0, 0, 0, 0); s1 = __builtin_amdgcn_mfma_f32_32x32x16_bf16(kc[k], qf[g0 + k], s1, 0, 0, 0); }
                    __builtin_amdgcn_sched_barrier(0);
                }
            }
            else {
#pragma unroll
                for (int d0 = 0; d0 < DQK / 16; ++d0) {
                    const bf16x8 a0 = *(const LAS bf16x8*)(kb + ql * KP + (16 * d0 + 8 * hi) * 2);
                    const bf16x8 a1 = *(const LAS bf16x8*)(kb + (32 + ql) * KP + (16 * d0 + 8 * hi) * 2);
                    s0 = __builtin_amdgcn_mfma_f32_32x32x16_bf16(a0, qf[d0], s0, 0, 0, 0);
                    s1 = __builtin_amdgcn_mfma_f32_32x32x16_bf16(a1, qf[d0], s1, 0, 0, 0);
                }
            }
            if (CAUSAL && (64 * t + 63 > q0w)) {
#pragma unroll
                for (int r = 0; r < 16; ++r) { const int kv = 64 * t + crow(r, hi); if (kv > qg) s0[r] = -INFINITY; if (kv + 32 > qg) s1[r] = -INFINITY; }
            }
            float mx = s0[0];
#pragma unroll
            for (int r = 1; r < 16; ++r) mx = fmaxf(mx, s0[r]);
#pragma unroll
            for (int r = 0; r < 16; ++r) mx = fmaxf(mx, s1[r]);
            mx = fmaxf(mx, __shfl_xor(mx, 32));
            const float m_new = fmaxf(m_run, mx);
            const float alpha = __builtin_amdgcn_exp2f(m_run - m_new);
            m_run = m_new;
            float ps = 0.f;
#pragma unroll
            for (int r = 0; r < 16; ++r) { s0[r] = __builtin_amdgcn_exp2f(s0[r] - m_new); s1[r] = __builtin_amdgcn_exp2f(s1[r] - m_new); ps += s0[r] + s1[r]; }
            l_run = l_run * alpha + ps;
            if (__any(alpha != 1.f)) {
#pragma unroll
                for (int i = 0; i < DV / 32; ++i)
#pragma unroll
                    for (int r = 0; r < 16; ++r) oacc[i][r] *= alpha;
            }
            const bf16x8 p00 = pack8(s0, 0), p01 = pack8(s0, 8), p10 = pack8(s1, 0), p11 = pack8(s1, 8);
            if constexpr (DQK <= 128) {
#pragma unroll
            for (int i = 0; i < DV / 32; ++i) {
                const LAS unsigned char* vp = vb + vtoff + i * 64;
                bf16x8 va[4];
#pragma unroll
                for (int k = 0; k < 4; ++k) va[k] = join8(vtr(vp + (16 * k) * VP), vtr(vp + (16 * k + 8) * VP));
                __builtin_amdgcn_sched_barrier(0);
                oacc[i] = __builtin_amdgcn_mfma_f32_32x32x16_bf16(va[0], p00, oacc[i], 0, 0, 0);
                oacc[i] = __builtin_amdgcn_mfma_f32_32x32x16_bf16(va[1], p01, oacc[i], 0, 0, 0);
                oacc[i] = __builtin_amdgcn_mfma_f32_32x32x16_bf16(va[2], p10, oacc[i], 0, 0, 0);
                oacc[i] = __builtin_amdgcn_mfma_f32_32x32x16_bf16(va[3], p11, oacc[i], 0, 0, 0);
                __builtin_amdgcn_sched_barrier(0);
            }
            } else {
#pragma unroll
                for (int i = 0; i < DV / 32; ++i) {
                    const LAS unsigned char* vp = vb + vtoff + i * 64;
                    { const bf16x8 a = join8(vtr(vp + (0) * VP), vtr(vp + (8) * VP)); oacc[i] = __builtin_amdgcn_mfma_f32_32x32x16_bf16(a, p00, oacc[i], 0, 0, 0); }
                    { const bf16x8 a = join8(vtr(vp + (16) * VP), vtr(vp + (24) * VP)); oacc[i] = __builtin_amdgcn_mfma_f32_32x32x16_bf16(a, p01, oacc[i], 0, 0, 0); }
                    { const bf16x8 a = join8(vtr(vp + (32) * VP), vtr(vp + (40) * VP)); oacc[i] = __builtin_amdgcn_mfma_f32_32x32x16_bf16(a, p10, oacc[i], 0, 0, 0); }
                    { const bf16x8 a = join8(vtr(vp + (48) * VP), vtr(vp + (56) * VP)); oacc[i] = __builtin_amdgcn_mfma_f32_32x32x16_bf16(a, p11, oacc[i], 0, 0, 0); }
                }
            }
        }
        if (t + 1 < NT) lstore((t + 1) & 1);
        LDS_BARRIER();
    }
    const float lt = l_run + __shfl_xor(l_run, 32); const float inv = 1.f / lt;
    bf16_t* orow = O + (size_t)(32 * w + ql) * opitch;
#pragma unroll
    for (int i = 0; i < DV / 32; ++i)
#pragma unroll
        for (int rr = 0; rr < 4; ++rr) { u32x2 o; o.x = cvt_pk_bf16(oacc[i][4 * rr] * inv, oacc[i][4 * rr + 1] * inv); o.y = cvt_pk_bf16(oacc[i][4 * rr + 2] * inv, oacc[i][4 * rr + 3] * inv);
            *(u32x2*)(orow + 32 * i + 8 * rr + 4 * hi) = o; }
}

constexpr int SS_BP = 272, SS_XP = 144;
constexpr int SS_B = 0, SS_C = 34816, SS_XD = 69632  , SS_XDD = 88064  , SS_ZI = 106496  , SS_SB = 124928, SS_CS = 142336, SS_DT = 142848;
constexpr int SS_ECS = SS_DT + 512, SS_CSD = SS_DT + 1024;
static_assert(SS_CSD + 512 <= LDS_BYTES - 64, "SSD LDS map");
__device__ __forceinline__ void ssd_unit(const P& p, int L, LAS unsigned char* lds, int b, int h) {
    unsigned char* ws = p.ws; asm volatile("" : "+s"(ws));
    const bf16_t* XBC = (const bf16_t*)(ws + WS_XBC); const bf16_t* Z = (const bf16_t*)(ws + WS_Z); const float* DT = (const float*)(ws + WS_DT); bf16_t* YC = (bf16_t*)(ws + WS_YC);
    const int tid = fresh_tid(), lane = tid & 63, w = __builtin_amdgcn_readfirstlane(tid >> 6), ql = lane & 31, hi = lane >> 5;
    const int g = h >> 2;
    const float Ah = -__expf(p.a_log[L * 16 + h]); const float dsk = p.d_skip[L * 16 + h];
    const int lb = (w < 4) ? w : (7 - w), pb = (w >> 1) & 1;
    LAS float* CS = (LAS float*)(lds + SS_CS); LAS float* DTS = (LAS float*)(lds + SS_DT);
    f32x16 sacc;
#pragma unroll
    for (int r = 0; r < 16; ++r) sacc[r] = 0.f;
    for (int i = tid; i < 64 * SS_BP / 4; i += 512) ((LAS unsigned*)(lds + SS_SB))[i] = 0u;
    u32x4 breg[4], creg[4], xreg[2], zreg[2]; float dreg[2] = {0.f, 0.f};
    auto gload = [&](int c) {
        const size_t m0 = (size_t)b * SEQ + (size_t)c * 128;
#pragma unroll
        for (int i = 0; i < 4; ++i) { const int id = tid + 512 * i, row = id >> 4, c16 = id & 15;
            breg[i] = *(const u32x4*)(XBC + (m0 + row) * 2048 + 1024 + g * 128 + 8 * c16);
            creg[i] = *(const u32x4*)(XBC + (m0 + row) * 2048 + 1536 + g * 128 + 8 * c16); }
#pragma unroll
        for (int i = 0; i < 2; ++i) { const int id = tid + 512 * i, row = id >> 3, c8 = id & 7; xreg[i] = *(const u32x4*)(XBC + (m0 + row) * 2048 + h * 64 + 8 * c8); zreg[i] = *(const u32x4*)(Z + (m0 + row) * 1024 + h * 64 + 8 * c8); }
        if (w == 0) { dreg[0] = DT[(m0 + 2 * lane) * 16 + h]; dreg[1] = DT[(m0 + 2 * lane + 1) * 16 + h]; }
    };
    gload(0);
    const int troff = (((lane & 15) >> 2)) ;
    const int tcol = 16 * ((lane >> 4) & 1) + 4 * (lane & 3);
    for (int c = 0; c < 16; ++c) {
        const size_t m0 = (size_t)b * SEQ + (size_t)c * 128;
        if (w == 0) {
            const float v0 = dreg[0] * Ah, v1 = dreg[1] * Ah; float s = v0 + v1;
#pragma unroll
            for (int o = 1; o < 64; o <<= 1) { const float t = __shfl_up(s, o); if (lane >= o) s += t; }
            CS[2 * lane] = s - v1; CS[2 * lane + 1] = s; DTS[2 * lane] = dreg[0]; DTS[2 * lane + 1] = dreg[1];
            { LAS float* ECS = (LAS float*)(lds + SS_ECS); LAS float* CSD = (LAS float*)(lds + SS_CSD);
              ECS[2 * lane] = __expf(s - v1); ECS[2 * lane + 1] = __expf(s); CSD[2 * lane] = (s - v1) - __logf(dreg[0]); CSD[2 * lane + 1] = s - __logf(dreg[1]); }
        }
#pragma unroll
        for (int i = 0; i < 4; ++i) { const int id = tid + 512 * i, row = id >> 4, c16 = id & 15;
            *(LAS u32x4*)(lds + SS_B + row * SS_BP + c16 * 16) = breg[i]; *(LAS u32x4*)(lds + SS_C + row * SS_BP + c16 * 16) = creg[i]; }
        LDS_BARRIER();
        { const float cend = CS[127];
#pragma unroll
          for (int i = 0; i < 2; ++i) { const int id = tid + 512 * i, row = id >> 3, c8 = id & 7; const float e = DTS[row] * __expf(cend - CS[row]);
              const u32x4 v = xreg[i]; u32x4 o2;
              o2.x = cvt_pk_bf16(bflo(v.x) * e, bfhi(v.x) * e); o2.y = cvt_pk_bf16(bflo(v.y) * e, bfhi(v.y) * e); o2.z = cvt_pk_bf16(bflo(v.z) * e, bfhi(v.z) * e); o2.w = cvt_pk_bf16(bflo(v.w) * e, bfhi(v.w) * e);
              *(LAS u32x4*)(lds + SS_XD + row * SS_XP + c8 * 16) = v; *(LAS u32x4*)(lds + SS_XDD + row * SS_XP + c8 * 16) = o2; *(LAS u32x4*)(lds + SS_ZI + row * SS_XP + c8 * 16) = zreg[i]; } }
        LDS_BARRIER();
        if (c + 1 < 16) gload(c + 1);
        f32x16 yacc, oac;
#pragma unroll
        for (int r = 0; r < 16; ++r) { yacc[r] = 0.f; oac[r] = 0.f; }
        const float cs_l = CS[32 * lb + ql];
        bf16x8 cfr[8];
#pragma unroll
        for (int ks = 0; ks < 8; ++ks) cfr[ks] = *(const LAS bf16x8*)(lds + SS_C + (32 * lb + ql) * SS_BP + (16 * ks + 8 * hi) * 2);
        for (int sb = 0; sb <= lb; ++sb) {
            f32x16 gt;
#pragma unroll
            for (int r = 0; r < 16; ++r) gt[r] = 0.f;
#pragma unroll
            for (int hf = 0; hf < 2; ++hf) {
                bf16x8 fa[4];
#pragma unroll
                for (int k = 0; k < 4; ++k) fa[k] = *(const LAS bf16x8*)(lds + SS_B + (32 * sb + ql) * SS_BP + (16 * (4 * hf + k) + 8 * hi) * 2);
                __builtin_amdgcn_sched_barrier(0);
#pragma unroll
                for (int k = 0; k < 4; ++k) gt = __builtin_amdgcn_mfma_f32_32x32x16_bf16(fa[k], cfr[4 * hf + k], gt, 0, 0, 0);
                __builtin_amdgcn_sched_barrier(0);
            }
            const int lg = 32 * lb + ql;
#pragma unroll
            for (int r = 0; r < 16; ++r) { const int s = 32 * sb + crow(r, hi); const float e = __expf(cs_l - ((const LAS float*)(lds + SS_CSD))[s]); gt[r] = (s <= lg) ? gt[r] * e : 0.f; }
            const bf16x8 w0 = pack8(gt, 0), w1 = pack8(gt, 8);
            const LAS unsigned char* xp = lds + SS_XD + (32 * sb + 4 * hi + troff) * SS_XP + (32 * pb + tcol) * 2;
            { const bf16x8 bx = join8(vtr(xp), vtr(xp + 8 * SS_XP)); yacc = __builtin_amdgcn_mfma_f32_32x32x16_bf16(w0, bx, yacc, 0, 0, 0); }
            { const bf16x8 bx = join8(vtr(xp + 16 * SS_XP), vtr(xp + 24 * SS_XP)); yacc = __builtin_amdgcn_mfma_f32_32x32x16_bf16(w1, bx, yacc, 0, 0, 0); }
        }
#pragma unroll
        for (int hf = 0; hf < 2; ++hf) {
            bf16x8 fs[4];
#pragma unroll
            for (int k = 0; k < 4; ++k) fs[k] = *(const LAS bf16x8*)(lds + SS_SB + (32 * pb + ql) * SS_BP + (16 * (4 * hf + k) + 8 * hi) * 2);
            __builtin_amdgcn_sched_barrier(0);
#pragma unroll
            for (int k = 0; k < 4; ++k) oac = __builtin_amdgcn_mfma_f32_32x32x16_bf16(cfr[4 * hf + k], fs[k], oac, 0, 0, 0);
            __builtin_amdgcn_sched_barrier(0);
        }
#pragma unroll
        for (int r = 0; r < 16; ++r) { const int l = 32 * lb + crow(r, hi); const size_t m = m0 + l; const int col = h * 64 + 32 * pb + ql;
            const float xv = bf1(*(const LAS bf16_t*)(lds + SS_XD + l * SS_XP + (32 * pb + ql) * 2)); const float zv = bf1(*(const LAS bf16_t*)(lds + SS_ZI + l * SS_XP + (32 * pb + ql) * 2));
            const float y = yacc[r] + oac[r] * ((const LAS float*)(lds + SS_ECS))[l] + xv * dsk;
            YC[m * 2048 + col] = tobf(y * silu_f(zv)); }
        { const float dec = __expf(CS[127]);
#pragma unroll
          for (int r = 0; r < 16; ++r) sacc[r] *= dec;
#pragma unroll
          for (int hf = 0; hf < 2; ++hf) {
              bf16x8 fa[4], fb[4];
#pragma unroll
              for (int k = 0; k < 4; ++k) { const int st = 4 * hf + k;
                  const LAS unsigned char* ap = lds + SS_XDD + (16 * st + 8 * hi + troff) * SS_XP + (32 * pb + tcol) * 2;
                  const LAS unsigned char* bp = lds + SS_B + (16 * st + 8 * hi + troff) * SS_BP + (32 * lb + tcol) * 2;
                  fa[k] = join8(vtr(ap), vtr(ap + 4 * SS_XP)); fb[k] = join8(vtr(bp), vtr(bp + 4 * SS_BP)); }
              __builtin_amdgcn_sched_barrier(0);
#pragma unroll
              for (int k = 0; k < 4; ++k) sacc = __builtin_amdgcn_mfma_f32_32x32x16_bf16(fa[k], fb[k], sacc, 0, 0, 0);
              __builtin_amdgcn_sched_barrier(0);
          } }
        LDS_BARRIER();
#pragma unroll
        for (int r = 0; r < 16; ++r) *(LAS bf16_t*)(lds + SS_SB + (32 * pb + crow(r, hi)) * SS_BP + (32 * lb + ql) * 2) = tobf(sacc[r]);
    }
    __syncthreads();
}

#define XB_TMO      128
#define XB_XCNT(j)  (256  + 64 * (j))
#define XB_XSUB(j)  (1280 + 64 * (j))
#define XB_XGEN(j)  (2304 + 64 * (j))
#define XB_TOP      3328
#define XB_TOPGEN   3392
#define XCD_BAR_WORDS 3456
#define XB_SPIN_CAP (1u << 18)

__device__ __forceinline__ unsigned xb_ld(unsigned* p)              { return __hip_atomic_load(p, __ATOMIC_RELAXED, __HIP_MEMORY_SCOPE_AGENT); }
__device__ __forceinline__ unsigned xb_add(unsigned* p, unsigned v) { return __hip_atomic_fetch_add(p, v, __ATOMIC_RELAXED, __HIP_MEMORY_SCOPE_AGENT); }
__device__ __forceinline__ unsigned xb_xcc_id() { return (unsigned)__builtin_amdgcn_s_getreg((3 << 11) | 20) & 0xFu; }
#define XB_SPIN(cond, bar) do { unsigned _sp = 0; while (cond) { __builtin_amdgcn_s_sleep(1); \
    if ((++_sp & 255u) == 0u) { if (xb_ld(&(bar)[XB_TMO])) break; if (_sp > XB_SPIN_CAP) { atomicAdd(&(bar)[XB_TMO], 1u); break; } } } } while (0)

struct XcdBarrier {
    unsigned* bar; unsigned x;
    volatile LAS unsigned* st;
};

__device__ __forceinline__ XcdBarrier xcd_barrier_post(unsigned* bar, volatile LAS unsigned* st) {
    XcdBarrier b; b.bar = bar; b.x = xb_xcc_id(); b.st = st;
    if (threadIdx.x == 0) (void)xb_add(&bar[XB_XCNT(b.x)], 1u);
    return b;
}
__device__ __forceinline__ void xcd_barrier_complete(unsigned* bar, unsigned x, unsigned& nloc, unsigned& nx) {
    const unsigned G = gridDim.x * gridDim.y * gridDim.z;
    unsigned sum, cnt, mine, sp = 0u;
    for (;;) {
        sum = 0u; cnt = 0u; mine = 0u;
#pragma unroll
        for (unsigned j = 0; j < 16; ++j) { const unsigned c = xb_ld(&bar[XB_XCNT(j)]); sum += c; cnt += (c > 0u) ? 1u : 0u; mine = (j == x) ? c : mine; }
        if (sum == G) break;
        __builtin_amdgcn_s_sleep(1);
        if ((++sp & 255u) == 0u) { if (xb_ld(&bar[XB_TMO])) break; if (sp > XB_SPIN_CAP) { atomicAdd(&bar[XB_TMO], 1u); break; } }
    }
    nloc = mine > 0u ? mine : 1u; nx = cnt > 0u ? cnt : 1u;
}

__device__ __forceinline__ void xcd_barrier(const XcdBarrier& b) {
    asm volatile("s_waitcnt vmcnt(0)" ::: "memory");
    __syncthreads();
    if (threadIdx.x == 0) {
        unsigned* bar = b.bar; unsigned bx_ = b.x; asm volatile("" : "+s"(bar), "+s"(bx_));
        __builtin_amdgcn_s_waitcnt(0);
        unsigned nloc = b.st[0], nx = b.st[1];
        if (nloc == 0u) { xcd_barrier_complete(bar, bx_, nloc, nx); b.st[0] = nloc; b.st[1] = nx; }
        const unsigned old = xb_add(&bar[XB_XSUB(bx_)], 1u);
        const unsigned gen = old / nloc;
        if (old + 1u == (gen + 1u) * nloc) {
            __builtin_amdgcn_fence(__ATOMIC_RELEASE, "agent");
            asm volatile("s_waitcnt vmcnt(0)" ::: "memory");
            const unsigned og = xb_add(&bar[XB_TOP], 1u);
            const unsigned tg = og / nx;
            if (og + 1u == (tg + 1u) * nx) xb_add(&bar[XB_TOPGEN], 1u);
            else XB_SPIN(xb_ld(&bar[XB_TOPGEN]) == tg, bar);
            __builtin_amdgcn_fence(__ATOMIC_ACQUIRE, "agent");
            xb_add(&bar[XB_XGEN(bx_)], 1u);
            asm volatile("s_waitcnt vmcnt(0)" ::: "memory");
        } else {
            XB_SPIN(xb_ld(&bar[XB_XGEN(bx_)]) == gen, bar);
            __builtin_amdgcn_fence(__ATOMIC_ACQUIRE, "agent");
            asm volatile("s_waitcnt vmcnt(0)" ::: "memory");
        }
    }
    __syncthreads();
}

__device__ __forceinline__ void my_grid_sync(unsigned* bar, unsigned& gen) {
    asm volatile("s_waitcnt vmcnt(0) lgkmcnt(0)" ::: "memory");
    __syncthreads();
    gen += 1u;
    if (threadIdx.x == 0) {
        __builtin_amdgcn_fence(__ATOMIC_RELEASE, "agent");
        asm volatile("s_waitcnt vmcnt(0)" ::: "memory");
        __hip_atomic_fetch_add(bar, 1u, __ATOMIC_RELAXED, __HIP_MEMORY_SCOPE_AGENT);
        const unsigned target = gen * gridDim.x;
        while (__hip_atomic_load(bar, __ATOMIC_RELAXED, __HIP_MEMORY_SCOPE_AGENT) < target) __builtin_amdgcn_s_sleep(1);
        __builtin_amdgcn_fence(__ATOMIC_ACQUIRE, "agent");
        asm volatile("s_waitcnt vmcnt(0)" ::: "memory");
    }
    __syncthreads();
    asm volatile("buffer_inv sc1\n\ts_waitcnt vmcnt(0)" ::: "memory");
}
#ifdef DUP_SYNC
#define SYNC2() xcd_barrier(xbar)
#else
#define SYNC2() do {} while (0)
#endif
#define GRID_SYNC() do { xcd_barrier(xbar); SYNC2(); ws = p.ws; asm volatile("" : "+s"(ws)); RSS = (float*)(ws + WS_RSP); XB = (bf16_t*)(ws + WS_XB); } while (0)
__global__ void __launch_bounds__(512, 2) trunk_fwd(P p) {
    extern __shared__ __attribute__((aligned(16))) unsigned char lds_raw[];
    cg::grid_group grid = cg::this_grid();
    LAS unsigned char* lds = (LAS unsigned char*)lds_raw;
    const int tid = threadIdx.x, lane = tid & 63, wave = __builtin_amdgcn_readfirstlane(tid >> 6);
    const int G = gridDim.x, gw = blockIdx.x * 8 + wave, NGW = G * 8;
    LAS float* scr = (LAS float*)(lds + wave * 16384);
    const int vcu = (G % 8 == 0) ? ((int)blockIdx.x % 8) * (G / 8) + (int)blockIdx.x / 8 : (int)blockIdx.x;
    unsigned char* ws = p.ws; asm volatile("" : "+s"(ws));
    float* RSS = (float*)(ws + WS_RSP);
    bf16_t* XB = (bf16_t*)(ws + WS_XB);

    volatile LAS unsigned* bst = (volatile LAS unsigned*)(lds + (LDS_BYTES - 64));
    if (tid < 2) bst[tid] = 0u;
    __syncthreads();
    grid.sync();
    XcdBarrier xbar = xcd_barrier_post((unsigned*)(p.ws + WS_RSS), bst);
#ifndef SKIP_PRO
    prologue(p, scr, gw, NGW, lane);
#endif
    GRID_SYNC();
    { EpiRoute E{(bf16_t*)(ws + WS_KMVM), nullptr, nullptr, 8192, 0, 0, 1 << 30, 1 << 30, nullptr, 0.f, 1.f};
      run_gemm(lds, (const bf16_t*)(ws + WS_MEMN), (const bf16_t*)(ws + WS_WMKV), 2048, 8192, 1024, E); }

    for (int L = 0; L < DEPTH; ++L) {
        { EpiRoute E{(bf16_t*)(ws + WS_Z), (bf16_t*)(ws + WS_XBCPRE), (bf16_t*)(ws + WS_SM), 1024, 2048, 768, 4, 12, RSS, 1.f / 1024.f, 1.f};
          run_gemm(lds, XB, (const bf16_t*)(ws + WS_WIN), M, NIN, 1024, E); }
#ifdef DUP_G1
        { EpiRoute E{(bf16_t*)(ws + WS_Z), (bf16_t*)(ws + WS_XBCPRE), (bf16_t*)(ws + WS_SM), 1024, 2048, 768, 4, 12, RSS, 1.f / 1024.f, 1.f};
          run_gemm(lds, XB, (const bf16_t*)(ws + WS_WIN), M, NIN, 1024, E); }
#endif
        GRID_SYNC();
#ifndef SKIP_L2
        pass_l2(p, L, gw, NGW, lane);
#ifdef DUP_PASS
        pass_l2(p, L, gw, NGW, lane);
#endif
#endif
        GRID_SYNC();
#if defined(DBG_STOP) && DBG_STOP == 1
        { for (size_t i = (size_t)blockIdx.x * 512 + threadIdx.x; i < (size_t)M * 1024; i += (size_t)G * 512) { const size_t mm = i >> 10; const int cc = (int)(i & 1023); p.out[i] = bf1(((const bf16_t*)(ws + WS_XBC))[mm * 2048 + cc]) + bf1(((const bf16_t*)(ws + WS_XBC))[mm * 2048 + 1024 + cc]) + bf1(((const bf16_t*)(ws + WS_CQN))[mm * 384 + cc % 384]) + bf1(((const bf16_t*)(ws + WS_CKVN))[mm * 256 + cc % 256]) + bf1(((const bf16_t*)(ws + WS_KPE))[mm * 32 + cc % 32]) + ((const float*)(ws + WS_DT))[mm * 16 + cc % 16] + bf1(((const bf16_t*)(ws + WS_Z))[mm * 1024 + cc]); } return; }
#endif

#ifndef SKIP_SSD
        if (G >= 256) {
            if (blockIdx.x < 128) { const int su = ((int)blockIdx.x & 7) * 16 + ((int)blockIdx.x >> 3); ssd_unit(p, L, lds, su >> 4, su & 15); }
            else {
                { EpiRope E{(bf16_t*)(ws + WS_YC), (bf16_t*)(ws + WS_SM), (const float*)(ws + WS_COS), (const float*)(ws + WS_SIN), 0.10206207261596575f * LOG2E};
                  run_gemm_on(lds, (const bf16_t*)(ws + WS_CQN), (const bf16_t*)(ws + WS_WUQ), M, 1536, 384, E, 128, (int)blockIdx.x - 128); }
                { EpiRoute E{(bf16_t*)(ws + WS_KN), (bf16_t*)(ws + WS_VB), nullptr, 1024, 1024, 0, 4, 1 << 30, nullptr, 0.f, 1.f};
                  run_gemm_on(lds, (const bf16_t*)(ws + WS_CKVN), (const bf16_t*)(ws + WS_WUKV), M, 2048, 256, E, 128, (int)blockIdx.x - 128); }
                convert_layer(p, -1, -1, -1, L, scr, gw - 1024, NGW - 1024, lane); } }
        else { for (int u = blockIdx.x; u < NB * 16; u += G) ssd_unit(p, L, lds, u >> 4, u & 15);
               { EpiRope E{(bf16_t*)(ws + WS_YC), (bf16_t*)(ws + WS_SM), (const float*)(ws + WS_COS), (const float*)(ws + WS_SIN), 0.10206207261596575f * LOG2E};
                 run_gemm(lds, (const bf16_t*)(ws + WS_CQN), (const bf16_t*)(ws + WS_WUQ), M, 1536, 384, E); }
               { EpiRoute E{(bf16_t*)(ws + WS_KN), (bf16_t*)(ws + WS_VB), nullptr, 1024, 1024, 0, 4, 1 << 30, nullptr, 0.f, 1.f};
                 run_gemm(lds, (const bf16_t*)(ws + WS_CKVN), (const bf16_t*)(ws + WS_WUKV), M, 2048, 256, E); }
               convert_layer(p, -1, -1, -1, L, scr, gw, NGW, lane); }
#ifdef DUP_SSD
        for (int u = blockIdx.x; u < NB * 16; u += G) ssd_unit(p, L, lds, u >> 4, u & 15);
#endif
#endif
        GRID_SYNC();
#if defined(DBG_STOP) && DBG_STOP == 2
        { for (size_t i = (size_t)blockIdx.x * 512 + threadIdx.x; i < (size_t)M * 1024; i += (size_t)G * 512) { const size_t mm = i >> 10; const int cc = (int)(i & 1023); p.out[i] = bf1(((const bf16_t*)(ws + WS_YC))[mm * 2048 + cc]); } return; }
#endif

#ifndef SKIP_MLA
#ifdef DUP_MLA
        for (int rep_ = 0; rep_ < 2; ++rep_)
#endif
        { const int v = vcu;
          for (int uu = v; uu < 256; uu += G) { const int bh = uu >> 1, half = uu & 1, b = bh >> 4, h = bh & 15;
            for (int i = 0; i < 4; ++i) { const int qb = half ? ((i == 0) ? 1 : (i == 1) ? 6 : (i == 2) ? 2 : 5) : ((i == 0) ? 0 : (i == 1) ? 7 : (i == 2) ? 3 : 4);
                const size_t r0 = (size_t)b * SEQ;
                attn_unit<96, 64, true, true>(lds, (const bf16_t*)(ws + WS_YC) + (r0 + 256 * qb) * 2048 + 1024 + 64 * h, 2048, (const bf16_t*)(ws + WS_SM) + (r0 + 256 * qb) * 512 + 32 * h, 512,
                                              (const bf16_t*)(ws + WS_KN) + r0 * 1024 + 64 * h, 1024,
                                              (const bf16_t*)(ws + WS_KPE) + r0 * 32, 32, (const bf16_t*)(ws + WS_VB) + r0 * 1024 + 64 * h, 1024,
                                              (bf16_t*)(ws + WS_YC) + (r0 + 256 * qb) * 2048 + 1024 + 64 * h, 2048, 256 * qb, 4 * (qb + 1)); } } }
#endif
        GRID_SYNC();
#if defined(DBG_STOP) && DBG_STOP == 3
        { for (size_t i = (size_t)blockIdx.x * 512 + threadIdx.x; i < (size_t)M * 1024; i += (size_t)G * 512) { const size_t mm = i >> 10; const int cc = (int)(i & 1023); p.out[i] = bf1(((const bf16_t*)(ws + WS_YC))[mm * 2048 + 1024 + cc]); } return; }
#endif

#ifndef SKIP_YCN
        pass_ycnorm(p, gw, NGW, lane);
#endif
        convert_layer(p, L + 1, L + 1, L, -1, scr, gw, NGW, lane);
        GRID_SYNC();
        { EpiRes E{L == 0 ? p.x : p.out, p.out, XB, RSS + (size_t)16 * M};
          run_gemm(lds, (const bf16_t*)(ws + WS_YC), (const bf16_t*)(ws + WS_WOUT), M, 1024, 2048, E); }
        GRID_SYNC();
#if defined(DBG_STOP) && DBG_STOP == 4
        return;
#endif

#if defined(DBG_STOP) && DBG_STOP == 9
        { for (size_t i = (size_t)blockIdx.x * 512 + threadIdx.x; i < (size_t)M * 1024; i += (size_t)G * 512) { const size_t mm = i >> 10; const int cc = (int)(i & 1023); p.out[i] = bf1(XB[mm * 1024 + cc]); } return; }
#endif

#if defined(DBG_STOP) && DBG_STOP == 10
        { for (size_t i = (size_t)blockIdx.x * 512 + threadIdx.x; i < (size_t)M * 1024; i += (size_t)G * 512) { const size_t mm = i >> 10; const int cc = (int)(i & 1023); p.out[i] = (RSS + (size_t)16 * M)[(size_t)(cc & 3) * M * 4 + mm * 4 + ((cc >> 2) & 3)]; } return; }
#endif

        { EpiRoute E{(bf16_t*)(ws + WS_QM), nullptr, nullptr, 1024, 0, 0, 1 << 30, 1 << 30, RSS + (size_t)16 * M, 1.f / 1024.f, 0.0625f * LOG2E};
          run_gemm(lds, XB, (const bf16_t*)(ws + WS_WMQ), M, 1024, 1024, E); }
#ifdef DUP_G6
        { EpiRoute E{(bf16_t*)(ws + WS_QM), nullptr, nullptr, 1024, 0, 0, 1 << 30, 1 << 30, RSS + (size_t)16 * M, 1.f / 1024.f, 0.0625f * LOG2E};
          run_gemm(lds, XB, (const bf16_t*)(ws + WS_WMQ), M, 1024, 1024, E); }
#endif
        GRID_SYNC();
#if defined(DBG_STOP) && DBG_STOP == 7
        { for (size_t i = (size_t)blockIdx.x * 512 + threadIdx.x; i < (size_t)M * 1024; i += (size_t)G * 512) { const size_t mm = i >> 10; const int cc = (int)(i & 1023); p.out[i] = bf1(((const bf16_t*)(ws + WS_QM))[mm * 1024 + cc]); } return; }
#endif

#ifndef SKIP_MEM
        for (int uu = vcu; uu < 512; uu += G) { const int dh = uu & 1, qb = (uu >> 1) & 7, mh = (uu >> 4) & 3, b = uu >> 6;
            const bf16_t* KM = (const bf16_t*)(ws + WS_KMVM) + (size_t)(b * 256) * 8192 + L * 2048 + 256 * mh;
            attn_unit<256, 128, false, false>(lds, (const bf16_t*)(ws + WS_QM) + ((size_t)b * SEQ + 256 * qb) * 1024 + 256 * mh, 1024, nullptr, 0, KM, 8192, nullptr, 0,
                                              KM + 1024 + 128 * dh, 8192, (bf16_t*)(ws + WS_OM) + ((size_t)b * SEQ + 256 * qb) * 1024 + 256 * mh + 128 * dh, 1024, 0, 4); }
#endif
        GRID_SYNC();
#if defined(DBG_STOP) && DBG_STOP == 8
        { for (size_t i = (size_t)blockIdx.x * 512 + threadIdx.x; i < (size_t)M * 1024; i += (size_t)G * 512) { const size_t mm = i >> 10; const int cc = (int)(i & 1023); p.out[i] = bf1(((const bf16_t*)(ws + WS_OM))[mm * 1024 + cc]); } return; }
#endif

        { EpiRes E{p.out, p.out, XB, RSS + (size_t)32 * M};
          run_gemm(lds, (const bf16_t*)(ws + WS_OM), (const bf16_t*)(ws + WS_WMO), M, 1024, 1024, E); }
        GRID_SYNC();
#if defined(DBG_STOP) && DBG_STOP == 5
        return;
#endif

        { EpiGlu E{(bf16_t*)(ws + WS_ACT), RSS + (size_t)32 * M, p.ffn_conv_w + (size_t)L * 3 * 5632, p.ffn_conv_b + (size_t)L * 5632, (float*)(ws + WS_HALO), (float*)(ws + WS_PART), (LAS float*)(lds + 131072)};
          run_gemm(lds, XB, (const bf16_t*)(ws + WS_WUP), M, 5632, 1024, E); }
#ifdef DUP_G8
        { EpiGlu E{(bf16_t*)(ws + WS_ACT), RSS + (size_t)32 * M, p.ffn_conv_w + (size_t)L * 3 * 5632, p.ffn_conv_b + (size_t)L * 5632, (float*)(ws + WS_HALO), (float*)(ws + WS_PART), (LAS float*)(lds + 131072)};
          run_gemm(lds, XB, (const bf16_t*)(ws + WS_WUP), M, 5632, 1024, E); }
#endif
        GRID_SYNC();
        {
          const int nM_ = M / 256, nN_ = 4, nwg_ = nM_ * nN_;
          for (int i_ = 0; (long)i_ * G + (int)blockIdx.x < nwg_; ++i_) { int wg_ = i_ * G + (int)blockIdx.x;
              { const int q_ = nwg_ / 8, r_ = nwg_ % 8, xcd_ = wg_ % 8, off_ = wg_ / 8; wg_ = (xcd_ < r_ ? xcd_ * (q_ + 1) : r_ * (q_ + 1) + (xcd_ - r_) * q_) + off_; }
              const int nig_ = 8 * nN_, gid_ = wg_ / nig_, fm_ = gid_ * 8, gsz_ = (nM_ - fm_) < 8 ? (nM_ - fm_) : 8;
              ffn_fixup(p, L, fm_ + ((wg_ % nig_) % gsz_)); }
          EpiRes E{p.out, p.out, XB, RSS};
          run_gemm(lds, (const bf16_t*)(ws + WS_ACT), (const bf16_t*)(ws + ((L & 1) ? WS_WDN1 : WS_WDN0)), M, 1024, 2816, E); }
        GRID_SYNC();
#if defined(DBG_STOP) && DBG_STOP == 6
        return;
#endif
    }
#ifndef SKIP_FIN
    pass_final(p, gw, NGW, lane);
#endif
}

extern "C" void kernel_launch(void* const* d_in, const int* in_sizes, int n_in, void* d_out, int out_size, void* d_ws, size_t ws_size, hipStream_t stream) {
    static int grid = 0;
    if (grid == 0) {
        if (n_in != 29 || out_size != M * DM || ws_size < WS_END) { fprintf(stderr, "kernel_launch: unexpected shapes (n_in %d out %d ws %zu need %zu)\n", n_in, out_size, ws_size, (size_t)WS_END); grid = -1; return; }
        int dev = 0, cus = 0, per_cu = 0;
        hipGetDevice(&dev);
        hipDeviceGetAttribute(&cus, hipDeviceAttributeMultiprocessorCount, dev);
        hipFuncSetAttribute((const void*)trunk_fwd, hipFuncAttributeMaxDynamicSharedMemorySize, LDS_BYTES);
        hipOccupancyMaxActiveBlocksPerMultiprocessor(&per_cu, (const void*)trunk_fwd, 512, LDS_BYTES);
        if (per_cu < 1) fprintf(stderr, "kernel_launch: occupancy query reports %d\n", per_cu);
        (void)hipGetLastError();
        grid = cus;
    }
    if (grid < 0) return;
    (void)hipMemsetAsync((char*)d_ws + WS_RSS, 0, 16384, stream);
    P a{};
    const void** pp = (const void**)&a;
    for (int i = 0; i < 29; ++i) pp[i] = d_in[i];
    a.out = (float*)d_out; a.ws = (unsigned char*)d_ws;
    void* args[] = {&a};
    hipError_t e = hipLaunchCooperativeKernel((const void*)trunk_fwd, dim3(grid), dim3(512), args, LDS_BYTES, stream);
    if (e != hipSuccess) fprintf(stderr, "cooperative launch failed: %s (grid %d)\n", hipGetErrorString(e), grid);
}
```
